# Optimizing an MI355X kernel written in HIP

```python
import math
import jax, jax.numpy as jnp
from jax import lax
import numpy as np

D_MODEL = 1024
BATCH = 1
SEQ = 16384
DEPTH = 2
DEC_BATCH = 32
DEC_SEQ = 4
PAST_LEN = 16384
PAGE_SIZE = 128

HEAD_DIM = 64
D_ATT = D_MODEL // 2
N_ATT_HEADS = D_ATT // HEAD_DIM
D_RNN = D_MODEL - D_ATT
N_RNN_BLOCKS = 8
RNN_BLOCK = D_RNN // N_RNN_BLOCKS
CONV_WIDTH = 4
LRU_C = 8.0
DILATED_PATTERNS = ((128, 1), (512, 4), (2048, 16))
MAX_WINDOW = max(w for w, _ in DILATED_PATTERNS)
BAND = DILATED_PATTERNS[0][0] // DILATED_PATTERNS[0][1]
ROPE_THETA = 500000.0
ROT_DIM = HEAD_DIM // 4
D_FF = -(-8 * D_MODEL // (3 * 256)) * 256
D_IN = 3 * D_ATT + 2 * D_RNN
RMS_EPS = 1e-6

kernel_name = "hymba_rglru_dilated_swa_decode_step"

F32 = jnp.float32


def _rmsnorm(x, g):
    x32 = x.astype(F32)
    y = x32 * lax.rsqrt(jnp.mean(x32 * x32, axis=-1, keepdims=True) + RMS_EPS)
    return (y * g.astype(F32)).astype(x.dtype)


def _rope_partial(x, pos):
    half = ROT_DIM // 2
    inv = ROPE_THETA ** (-jnp.arange(half, dtype=F32) * 2.0 / ROT_DIM)
    ang = pos.astype(F32)[:, None] * inv[None, :]
    cos = jnp.cos(ang)[None, :, None, :]
    sin = jnp.sin(ang)[None, :, None, :]
    xr = x[..., :ROT_DIM].astype(F32)
    x1, x2 = xr[..., :half], xr[..., half:]
    rot = jnp.concatenate([x1 * cos - x2 * sin, x2 * cos + x1 * sin], axis=-1)
    return jnp.concatenate([rot.astype(x.dtype), x[..., ROT_DIM:]], axis=-1)


def _masked_softmax(s, valid):
    s = jnp.where(valid, s, -jnp.inf)
    m = jnp.max(s, axis=-1, keepdims=True)
    e = jnp.exp(s - m)
    den = jnp.sum(e, axis=-1, keepdims=True)
    return e / den, m[..., 0] + jnp.log(den[..., 0])


def _dilated_band_prompt(q, k, v, dil):
    B, S, H, E = q.shape
    span = dil * BAND
    Sp = -(-S // span) * span
    nb = Sp // span

    def blocks(t):
        t = jnp.pad(t, ((0, 0), (0, Sp - S), (0, 0), (0, 0)))
        return t.reshape(B, nb, BAND, dil, H, E)

    def with_prev(t):
        prev = jnp.pad(t, ((0, 0), (1, 0), (0, 0), (0, 0), (0, 0), (0, 0)))[:, :-1]
        return jnp.concatenate([prev, t], axis=2)

    qb = blocks(q)
    kk, vv = with_prev(blocks(k)), with_prev(blocks(v))
    s = jnp.einsum('bjarhe,bjcrhe->bjrhac', qb, kk) * (1.0 / math.sqrt(E))
    a = jnp.arange(BAND)[:, None]
    c = jnp.arange(2 * BAND)[None, :]
    dist = BAND + a - c
    band_ok = (dist >= 0) & (dist <= BAND)
    j = jnp.arange(nb)[:, None, None]
    valid = band_ok[None] & ((j > 0) | (c >= BAND)[None])
    p, lse = _masked_softmax(s, valid[None, :, None, None])
    o = jnp.einsum('bjrhac,bjcrhe->bjarhe', p, vv).reshape(B, Sp, H, E)[:, :S]
    lse = lse.transpose(0, 1, 4, 2, 3).reshape(B, Sp, H)[:, :S]
    return o, lse


def _dilated_gather_sample(q, kcat, vcat, dil, w_buf):
    B, T, H, E = q.shape
    i = jnp.arange(T)[:, None]
    mm = jnp.arange(BAND + 1)[None, :]
    idx = w_buf + i - dil * mm
    valid = idx >= 0
    idx = jnp.maximum(idx, 0)
    kg = kcat[:, idx]
    vg = vcat[:, idx]
    s = jnp.einsum('bthe,btmhe->bhtm', q, kg) * (1.0 / math.sqrt(E))
    p, lse = _masked_softmax(s, valid[None, None])
    o = jnp.einsum('bhtm,btmhe->bthe', p, vg)
    return o, lse.transpose(0, 2, 1)


def _merge_by_denominator(outs, lses):
    w = jax.nn.softmax(jnp.stack(lses, axis=0), axis=0)
    return jnp.sum(w[..., None] * jnp.stack(outs, axis=0), axis=0)


def _rglru(xc, h0, w_ga, b_ga, w_gx, b_gx, lam):
    B, T, _ = xc.shape
    x32 = xc.astype(F32)
    xb = x32.reshape(B, T, N_RNN_BLOCKS, RNN_BLOCK)
    r = jax.nn.sigmoid(jnp.einsum('btnc,ncd->btnd', xb, w_ga.astype(F32)).reshape(B, T, D_RNN) + b_ga.astype(F32))
    ig = jax.nn.sigmoid(jnp.einsum('btnc,ncd->btnd', xb, w_gx.astype(F32)).reshape(B, T, D_RNN) + b_gx.astype(F32))
    log_a = -LRU_C * r * jax.nn.softplus(-lam.astype(F32))
    a = jnp.exp(log_a)
    b = jnp.sqrt(-jnp.expm1(2.0 * log_a)) * (ig * x32)

    def step(h, ab):
        at, bt = ab
        h = at * h + bt
        return h, h

    h_last, hs = lax.scan(step, h0.astype(F32), (a.swapaxes(0, 1), b.swapaxes(0, 1)))
    return hs.swapaxes(0, 1), h_last


def _layer(x, pos, cache_k, cache_v, conv_state, h0,
           g1, w_in, conv_w, conv_b, w_ga, b_ga, w_gx, b_gx, lam, w_out,
           g2, w_fg, w_fu, w_fd, prompt):
    B, T, _ = x.shape
    hn = _rmsnorm(x, g1)
    z = hn @ w_in
    q, k, v, xr, yg = jnp.split(z, [D_ATT, 2 * D_ATT, 3 * D_ATT, 3 * D_ATT + D_RNN], axis=-1)
    q = _rope_partial(q.reshape(B, T, N_ATT_HEADS, HEAD_DIM), pos)
    k = _rope_partial(k.reshape(B, T, N_ATT_HEADS, HEAD_DIM), pos)
    v = v.reshape(B, T, N_ATT_HEADS, HEAD_DIM)
    q32 = q.astype(F32)
    if prompt:
        res = [_dilated_band_prompt(q32, k.astype(F32), v.astype(F32), d) for _, d in DILATED_PATTERNS]
        keep = min(MAX_WINDOW, T)
        new_k, new_v = k[:, T - keep:], v[:, T - keep:]
    else:
        w_buf = cache_k.shape[1]
        kcat = jnp.concatenate([cache_k, k], axis=1)
        vcat = jnp.concatenate([cache_v, v], axis=1)
        res = [_dilated_gather_sample(q32, kcat.astype(F32), vcat.astype(F32), d, w_buf) for _, d in DILATED_PATTERNS]
        new_k, new_v = kcat[:, T:], vcat[:, T:]
    att = _merge_by_denominator([o for o, _ in res], [l for _, l in res])
    att = att.astype(x.dtype).reshape(B, T, D_ATT)
    xpad = jnp.concatenate([conv_state, xr], axis=1)
    xc = sum(xpad[:, j:j + T] * conv_w[j] for j in range(CONV_WIDTH)) + conv_b
    new_conv = xpad[:, T:]
    hs, h_last = _rglru(xc, h0, w_ga, b_ga, w_gx, b_gx, lam)
    rnn = hs.astype(x.dtype) * jax.nn.gelu(yg, approximate=True)
    x = x + jnp.concatenate([att, rnn], axis=-1) @ w_out
    hf = _rmsnorm(x, g2)
    x = x + (jax.nn.silu(hf @ w_fg) * (hf @ w_fu)) @ w_fd
    return x, new_k, new_v, new_conv, h_last.astype(x.dtype)


def setup_inputs(seed: int = 0) -> dict:
    key = jax.random.key(seed)
    ks = jax.random.split(key, 24)
    w_buf = min(MAX_WINDOW, PAST_LEN)
    nrm = lambda k, shape, s: jax.random.normal(k, shape, F32) * s
    a0 = jax.random.uniform(ks[14], (DEPTH, D_RNN), F32, minval=0.9, maxval=0.999)
    sa = a0 ** (1.0 / LRU_C)
    return {
        "x_prompt": nrm(ks[0], (BATCH, SEQ, D_MODEL), 1.0),
        "x_sample": nrm(ks[1], (DEC_BATCH, DEC_SEQ, D_MODEL), 1.0),
        "cache_k": nrm(ks[2], (DEPTH, DEC_BATCH, w_buf, N_ATT_HEADS, HEAD_DIM), 1.0),
        "cache_v": nrm(ks[3], (DEPTH, DEC_BATCH, w_buf, N_ATT_HEADS, HEAD_DIM), 1.0),
        "state_conv": nrm(ks[4], (DEPTH, DEC_BATCH, CONV_WIDTH - 1, D_RNN), 1.0),
        "state_h": nrm(ks[5], (DEPTH, DEC_BATCH, D_RNN), 0.5),
        "norm1_g": 1.0 + nrm(ks[6], (DEPTH, D_MODEL), 0.01),
        "w_in": nrm(ks[7], (DEPTH, D_MODEL, D_IN), D_MODEL ** -0.5),
        "conv_w": nrm(ks[8], (DEPTH, CONV_WIDTH, D_RNN), CONV_WIDTH ** -0.5),
        "conv_b": nrm(ks[9], (DEPTH, D_RNN), 0.01),
        "w_gate_a": nrm(ks[10], (DEPTH, N_RNN_BLOCKS, RNN_BLOCK, RNN_BLOCK), RNN_BLOCK ** -0.5),
        "b_gate_a": nrm(ks[11], (DEPTH, D_RNN), 0.01),
        "w_gate_x": nrm(ks[12], (DEPTH, N_RNN_BLOCKS, RNN_BLOCK, RNN_BLOCK), RNN_BLOCK ** -0.5),
        "b_gate_x": nrm(ks[13], (DEPTH, D_RNN), 0.01),
        "lru_lambda": jnp.log(sa) - jnp.log1p(-sa),
        "w_out": nrm(ks[15], (DEPTH, D_MODEL, D_MODEL), D_MODEL ** -0.5),
        "norm2_g": 1.0 + nrm(ks[16], (DEPTH, D_MODEL), 0.01),
        "w_ffn_gate": nrm(ks[17], (DEPTH, D_MODEL, D_FF), D_MODEL ** -0.5),
        "w_ffn_up": nrm(ks[18], (DEPTH, D_MODEL, D_FF), D_MODEL ** -0.5),
        "w_ffn_down": nrm(ks[19], (DEPTH, D_FF, D_MODEL), D_FF ** -0.5),
        "final_norm_g": 1.0 + nrm(ks[20], (D_MODEL,), 0.01),
    }


def reference(x_prompt, x_sample, cache_k, cache_v, state_conv, state_h,
              norm1_g, w_in, conv_w, conv_b, w_gate_a, b_gate_a, w_gate_x, b_gate_x,
              lru_lambda, w_out, norm2_g, w_ffn_gate, w_ffn_up, w_ffn_down, final_norm_g):
    B, S, _ = x_prompt.shape
    T = x_sample.shape[1]
    pos_p = jnp.arange(S, dtype=jnp.int32)
    pos_s = PAST_LEN + jnp.arange(T, dtype=jnp.int32)
    xp, xs = x_prompt, x_sample
    pk, pv, pc, ph, sk, sv, sc, sh = [], [], [], [], [], [], [], []
    for l in range(DEPTH):
        w = (norm1_g[l], w_in[l], conv_w[l], conv_b[l], w_gate_a[l], b_gate_a[l],
             w_gate_x[l], b_gate_x[l], lru_lambda[l], w_out[l], norm2_g[l],
             w_ffn_gate[l], w_ffn_up[l], w_ffn_down[l])
        conv0 = jnp.zeros((B, CONV_WIDTH - 1, D_RNN), xp.dtype)
        h0 = jnp.zeros((B, D_RNN), xp.dtype)
        xp, k1, v1, c1, h1 = _layer(xp, pos_p, None, None, conv0, h0, *w, prompt=True)
        xs, k2, v2, c2, h2 = _layer(xs, pos_s, cache_k[l], cache_v[l], state_conv[l], state_h[l], *w, prompt=False)
        pk.append(k1); pv.append(v1); pc.append(c1); ph.append(h1)
        sk.append(k2); sv.append(v2); sc.append(c2); sh.append(h2)
    y_prompt = _rmsnorm(xp, final_norm_g)
    y_sample = _rmsnorm(xs, final_norm_g)
    return (y_prompt, y_sample,
            jnp.stack(pk), jnp.stack(pv), jnp.stack(pc), jnp.stack(ph),
            jnp.stack(sk), jnp.stack(sv), jnp.stack(sc), jnp.stack(sh))
```

```cpp
#define MK_ONE_LAUNCH 1
#include <hip/hip_runtime.h>
#include <cstdio>
#include <cstdint>

namespace pg8 {
#define PG8_LAS __attribute__((address_space(3)))
typedef unsigned short bf16_t;
typedef short bf16x8 __attribute__((ext_vector_type(8)));
typedef float f32x4 __attribute__((ext_vector_type(4)));
typedef unsigned u32x4 __attribute__((ext_vector_type(4)));
constexpr int BM = 256, BK = 64, HALF = 128, HTB = HALF * BK * 2  , STAGE_BYTES = 8 * HTB, NXCD = 8, WGM = 8;

__host__ __device__ __forceinline__ int lds_byte(int r, int c) { const int st = (r >> 4) * 2 + (c >> 5), rr = r & 15, cc = c & 31, ob = rr * 64 + cc * 2; return st * 1024 + (ob ^ (((ob >> 9) & 1) << 5)); }
__host__ __device__ __forceinline__ void stage_rc(int b, int& R, int& C) { const int st = b / 1024, sb = b % 1024, swz = sb ^ (((sb >> 9) & 1) << 5); R = (st >> 1) * 16 + swz / 64; C = (st & 1) * 32 + (swz % 64) / 2; }
__host__ __device__ __forceinline__ int perm32(int rho) { const int n = rho >> 4, i = rho & 15; return 8 * (i >> 2) + 4 * n + (i & 3); }

struct Unit { int pm, pn; };
struct Gemm { const bf16_t* A; const bf16_t* Bt; int M, N, K; };

struct StaticOrder {
    int nM, nN, nwg, G, c;
    __host__ __device__ void init(int M, int N, int G_, int c_) { nM = M / BM; nN = N / BM; nwg = nM * nN; G = G_; c = c_; }
    __host__ __device__ bool next(int i, Unit& u) const {
        const long L = (long)i * G + c; if (L >= nwg) return false;
        int wgid = (int)L; { const int q = nwg / NXCD, r = nwg % NXCD, xcd = wgid % NXCD, off = wgid / NXCD; wgid = (xcd < r ? xcd * (q + 1) : r * (q + 1) + (xcd - r) * q) + off; }
        const int nig = WGM * nN, gid = wgid / nig, fm = gid * WGM, gsz = (nM - fm) < WGM ? (nM - fm) : WGM;
        u.pm = fm + ((wgid % nig) % gsz); u.pn = (wgid % nig) / gsz; return true;
    }
    __device__ __forceinline__ void a_ready(const Unit&) const {}
    __device__ __forceinline__ void done(const Unit&) const {}
};

__device__ __forceinline__ int opaque_tid() { int t = threadIdx.x; asm volatile("" : "+v"(t)); return t; }
__device__ __forceinline__ unsigned cvt_pk_bf16(float lo, float hi) { unsigned r; asm volatile("v_cvt_pk_bf16_f32 %0, %1, %2" : "=v"(r) : "v"(lo), "v"(hi)); return r; }

template <class Epi, class Sched, bool ALIGN_EPI = false, bool SP2 = false>
__device__ __forceinline__ void gemm_phase(PG8_LAS unsigned char* lds, const Gemm g, const Sched& S, const Epi& E) {
    const int tid = opaque_tid(), wid = __builtin_amdgcn_readfirstlane(tid >> 6), lane = tid & 63, wr = wid >> 2, wc = wid & 3, fr = lane & 15, fq = lane >> 4;
    const int K = g.K, nt = K / BK;
    unsigned voffA[2], voffB[2];
#pragma unroll
    for (int i = 0; i < 2; ++i) { int R, C; stage_rc(tid * 16 + i * 8192, R, C); const int Rb = Epi::PERM ? ((R & ~31) + perm32(R & 31)) : R;
        voffA[i] = (unsigned)(R * K + C) * 2u; voffB[i] = (unsigned)(Rb * K + C) * 2u; }
    const unsigned kstep = (unsigned)(BK * 2);
    const unsigned hstep = (unsigned)HALF * K * 2;
    const unsigned tstep = 2 * hstep;
    const __amdgpu_buffer_rsrc_t rsA = __builtin_amdgcn_make_buffer_rsrc((void*)g.A, 0, (int)((unsigned)g.M * (unsigned)K * 2u), 0x00020000);
    const __amdgpu_buffer_rsrc_t rsB = __builtin_amdgcn_make_buffer_rsrc((void*)g.Bt, 0, (int)((unsigned)g.N * (unsigned)K * 2u), 0x00020000);
    const unsigned ldsw = (unsigned)wid * 1024u;
    const int aoff = lds_byte(wr * 64 + fr, fq * 8), boff = lds_byte(wc * 32 + fr, fq * 8);
#define PG8_SA(b, h) (((b) * 2 + (h)) * HTB)
#define PG8_SB(b, h) ((4 + (b) * 2 + (h)) * HTB)
#define PG8_STAGE(bufoff, gbase, voff) do { _Pragma("unroll") for (int _i = 0; _i < 2; ++_i) \
        __builtin_amdgcn_raw_ptr_buffer_load_lds(PG8_RSRC_##voff, (PG8_LAS void*)(lds + (bufoff) + ldsw + _i * 8192), 16, (int)(voff)[_i], (int)(gbase), 0, 0); } while (0)
#define PG8_RSRC_voffA rsA
#define PG8_RSRC_voffB rsB
#define PG8_LDA(dst, b, h) do { _Pragma("unroll") for (int m = 0; m < 4; ++m) _Pragma("unroll") for (int k = 0; k < 2; ++k) dst[m][k] = *(const PG8_LAS bf16x8*)(lds + PG8_SA(b, h) + aoff + m * 2048 + k * 1024); } while (0)
#define PG8_LDB(dst, b, h) do { _Pragma("unroll") for (int n = 0; n < 2; ++n) _Pragma("unroll") for (int k = 0; k < 2; ++k) dst[n][k] = *(const PG8_LAS bf16x8*)(lds + PG8_SB(b, h) + boff + n * 2048 + k * 1024); } while (0)
#define PG8_MMA(ai, bj, At, Bt) do { __builtin_amdgcn_s_setprio(1); _Pragma("unroll") for (int m = 0; m < 4; ++m) _Pragma("unroll") for (int n = 0; n < 2; ++n) _Pragma("unroll") for (int k = 0; k < 2; ++k) \
        acc[ai][bj][m][n] = __builtin_amdgcn_mfma_f32_16x16x32_bf16(Bt[n][k], At[m][k], acc[ai][bj][m][n], 0, 0, 0); __builtin_amdgcn_s_setprio(0); } while (0)
#define PG8_WAIT_V(n) asm volatile("s_waitcnt vmcnt(" #n ")" ::: "memory")
#define PG8_WAIT_L(n) asm volatile("s_waitcnt lgkmcnt(" #n ")" ::: "memory")
#define PG8_BAR __builtin_amdgcn_s_barrier()
#define PG8_SCHED __builtin_amdgcn_sched_barrier(0)
    Unit cur, nxt; int ui = 0;
    if (!S.next(0, cur)) return;
    f32x4 acc[2][2][4][2];
#pragma unroll
    for (int a = 0; a < 2; ++a)
#pragma unroll
        for (int b = 0; b < 2; ++b)
#pragma unroll
            for (int m = 0; m < 4; ++m)
#pragma unroll
                for (int n = 0; n < 2; ++n) acc[a][b][m][n] = (f32x4){0.f, 0.f, 0.f, 0.f};
    bf16x8 At[4][2], B0[2][2], B1[2][2];
    unsigned cA = (unsigned)cur.pm * tstep, cB = (unsigned)cur.pn * tstep;
    S.a_ready(cur);
    if constexpr (SP2) {
        PG8_STAGE(PG8_SB(0, 0), cB, voffB); PG8_STAGE(PG8_SB(0, 1), cB + hstep, voffB); PG8_STAGE(PG8_SA(0, 0), cA, voffA); PG8_STAGE(PG8_SA(0, 1), cA + hstep, voffA);
        if (wr == 1) PG8_BAR;
        PG8_WAIT_V(2); PG8_BAR;
        PG8_STAGE(PG8_SB(1, 0), cB + kstep, voffB); PG8_STAGE(PG8_SA(1, 0), cA + kstep, voffA); PG8_STAGE(PG8_SB(1, 1), cB + hstep + kstep, voffB);
        PG8_WAIT_V(6); PG8_BAR;
    } else {
        PG8_STAGE(PG8_SB(0, 0), cB, voffB); PG8_STAGE(PG8_SA(0, 0), cA, voffA); PG8_STAGE(PG8_SB(0, 1), cB + hstep, voffB); PG8_STAGE(PG8_SA(0, 1), cA + hstep, voffA);
        if (wr == 1) PG8_BAR;
        PG8_WAIT_V(4); PG8_BAR;
        PG8_STAGE(PG8_SB(1, 0), cB + kstep, voffB); PG8_STAGE(PG8_SA(1, 0), cA + kstep, voffA); PG8_STAGE(PG8_SB(1, 1), cB + hstep + kstep, voffB);
        PG8_WAIT_V(6); PG8_BAR;
    }
    for (;;) {
        const bool has_next = S.next(ui + 1, nxt);
        const unsigned nA = has_next ? (unsigned)nxt.pm * tstep : cA, nB = has_next ? (unsigned)nxt.pn * tstep : cB;
        for (int t = 0; t < nt; t += 2) {
            const bool last = (t == nt - 2);
            const unsigned a1 = cA + (unsigned)(t + 1) * kstep;
            const unsigned a2 = last ? nA : cA + (unsigned)(t + 2) * kstep, b2 = last ? nB : cB + (unsigned)(t + 2) * kstep;
            const unsigned a3 = a2 + kstep, b3 = b2 + kstep;
            if (last && has_next) S.a_ready(nxt);
            if constexpr (SP2) {
            PG8_LDB(B0, 0, 0); PG8_LDB(B1, 0, 1); PG8_SCHED; PG8_LDA(At, 0, 0); PG8_STAGE(PG8_SA(1, 1), a1 + hstep, voffA);
            PG8_WAIT_V(8); PG8_WAIT_L(0); PG8_BAR; PG8_MMA(0, 0, At, B0); PG8_MMA(0, 1, At, B1); PG8_BAR; PG8_SCHED;
            PG8_LDA(At, 0, 1); PG8_STAGE(PG8_SB(0, 0), b2, voffB); PG8_STAGE(PG8_SB(0, 1), b2 + hstep, voffB); PG8_STAGE(PG8_SA(0, 0), a2, voffA);
            PG8_WAIT_V(8); PG8_WAIT_L(0); PG8_BAR; PG8_MMA(1, 0, At, B0); PG8_MMA(1, 1, At, B1); PG8_BAR; PG8_SCHED;
            PG8_LDB(B0, 1, 0); PG8_LDB(B1, 1, 1); PG8_SCHED; PG8_LDA(At, 1, 0); PG8_STAGE(PG8_SA(0, 1), a2 + hstep, voffA);
            PG8_WAIT_V(8); PG8_WAIT_L(0); PG8_BAR; PG8_MMA(0, 0, At, B0); PG8_MMA(0, 1, At, B1); PG8_BAR; PG8_SCHED;
            PG8_LDA(At, 1, 1); PG8_STAGE(PG8_SB(1, 0), b3, voffB); PG8_STAGE(PG8_SB(1, 1), b3 + hstep, voffB); PG8_STAGE(PG8_SA(1, 0), a3, voffA);
            PG8_WAIT_V(8); PG8_WAIT_L(0); PG8_BAR; PG8_MMA(1, 0, At, B0); PG8_MMA(1, 1, At, B1); PG8_BAR; PG8_SCHED;
            } else {
            PG8_LDB(B0, 0, 0); PG8_SCHED; PG8_LDA(At, 0, 0); PG8_STAGE(PG8_SA(1, 1), a1 + hstep, voffA);
            PG8_WAIT_L(8); PG8_BAR; PG8_WAIT_L(0); PG8_MMA(0, 0, At, B0); PG8_BAR; PG8_SCHED;
            PG8_LDB(B1, 0, 1); PG8_STAGE(PG8_SB(0, 0), b2, voffB);
            PG8_BAR; PG8_WAIT_L(0); PG8_MMA(0, 1, At, B1); PG8_BAR;
            PG8_LDA(At, 0, 1); PG8_STAGE(PG8_SA(0, 0), a2, voffA);
            PG8_BAR; PG8_WAIT_L(0); PG8_MMA(1, 0, At, B0); PG8_BAR; PG8_SCHED;
            PG8_STAGE(PG8_SB(0, 1), b2 + hstep, voffB);
            PG8_WAIT_V(6); PG8_BAR; PG8_MMA(1, 1, At, B1); PG8_BAR;
            PG8_LDB(B0, 1, 0); PG8_SCHED; PG8_LDA(At, 1, 0); PG8_STAGE(PG8_SA(0, 1), a2 + hstep, voffA);
            PG8_WAIT_L(8); PG8_BAR; PG8_WAIT_L(0); PG8_MMA(0, 0, At, B0); PG8_BAR; PG8_SCHED;
            PG8_LDB(B1, 1, 1); PG8_STAGE(PG8_SB(1, 0), b3, voffB);
            PG8_BAR; PG8_WAIT_L(0); PG8_MMA(0, 1, At, B1); PG8_BAR;
            PG8_LDA(At, 1, 1); PG8_STAGE(PG8_SA(1, 0), a3, voffA);
            PG8_BAR; PG8_WAIT_L(0); PG8_MMA(1, 0, At, B0); PG8_BAR; PG8_SCHED;
            PG8_STAGE(PG8_SB(1, 1), b3 + hstep, voffB);
            PG8_WAIT_V(6); PG8_BAR; PG8_MMA(1, 1, At, B1); PG8_BAR;
            }
        }
        if constexpr (ALIGN_EPI) { if (wr == 0) PG8_BAR; }
        if constexpr (!Epi::AFTER_DRAIN) { E(acc, cur, wr, wc, fr, fq, ui); S.done(cur); }
        if (!has_next) break;
#pragma unroll
        for (int a = 0; a < 2; ++a)
#pragma unroll
            for (int b = 0; b < 2; ++b)
#pragma unroll
                for (int m = 0; m < 4; ++m)
#pragma unroll
                    for (int n = 0; n < 2; ++n) acc[a][b][m][n] = (f32x4){0.f, 0.f, 0.f, 0.f};
        cur = nxt; cA = nA; cB = nB; ++ui;
        if constexpr (ALIGN_EPI) { if (wr == 1) PG8_BAR; }
    }
    PG8_WAIT_V(0);
    if constexpr (!ALIGN_EPI) { if (wr == 0) PG8_BAR; }
    PG8_BAR;
#undef PG8_SA
#undef PG8_SB
#undef PG8_STAGE
#undef PG8_RSRC_voffA
#undef PG8_RSRC_voffB
#undef PG8_LDA
#undef PG8_LDB
#undef PG8_MMA
#undef PG8_WAIT_V
#undef PG8_WAIT_L
#undef PG8_BAR
#undef PG8_SCHED
}
}

#define LAS __attribute__((address_space(3)))
#define GAS __attribute__((address_space(1)))
typedef unsigned short bf16_t;
typedef short bf16x8 __attribute__((ext_vector_type(8)));
typedef short s16x4 __attribute__((ext_vector_type(4)));
typedef float f32x4 __attribute__((ext_vector_type(4)));
typedef float f32x16 __attribute__((ext_vector_type(16)));
typedef unsigned u32x4 __attribute__((ext_vector_type(4)));
typedef unsigned u32x2 __attribute__((ext_vector_type(2)));

constexpr int MP = 16384;
constexpr int MS = 128;
constexpr int MROWS = MP + MS;
constexpr int MTOT = 16640;
constexpr int DM = 1024, DIN = 2560, DA = 512, DR = 512, DFF = 2816, NGU = 2 * DFF;
constexpr int NH = 8, HD = 64, WBUF = 2048, NB = 32, NT = 4, NLAYER = 2;
constexpr int ROPE_ROWS = MP + NT;
constexpr float RMS_EPS = 1e-6f;
constexpr float QSCALE = 0.18033688011112042f;

constexpr size_t O_YP = 0, O_YS = 16777216, O_PK = 16908288, O_PV = 19005440, O_PC = 21102592, O_PH = 21105664,
                 O_SK = 21106688, O_SV = 88215552, O_SC = 155324416, O_SH = 155422720, O_END = 155455488;

constexpr size_t MiB = 1u << 20;
constexpr size_t WS_CTL = 0, CTL_ZERO_BYTES = 1 * MiB;
constexpr size_t WS_ROPE = 1 * MiB;
constexpr size_t WS_WGT = 3 * MiB;
constexpr size_t WS_SP = WS_WGT + 512 * 1024;
constexpr size_t WS_AGGA = WS_WGT + 768 * 1024;
constexpr size_t WS_AGGH = WS_WGT + 1024 * 1024;
constexpr size_t WS_CARRY = WS_WGT + 1280 * 1024;
constexpr size_t WS_W = 5 * MiB, W_LAYER = 24 * MiB;
constexpr size_t W_IN = 0, W_OUT = 5242880, W_GU = 7340032, W_FD = 18874368;
constexpr size_t WS_SSQP = 53 * MiB, SSQP_STRIDE = 1114112;
constexpr size_t WS_QS = 59 * MiB;
constexpr size_t WS_XRS = WS_QS + 512 * 1024;
constexpr size_t WS_LSE = 60 * MiB;
constexpr size_t WS_XBA = 62 * MiB;
constexpr size_t WS_XBB = 95 * MiB;
constexpr size_t WS_X = 128 * MiB;
constexpr size_t WS_Q = 193 * MiB, WS_K = 210 * MiB, WS_V = 227 * MiB, WS_XR = 244 * MiB, WS_GY = 261 * MiB, WS_HL = 278 * MiB, WS_CA = 295 * MiB;
constexpr size_t WS_OG = 312 * MiB, OG_STRIDE = 16 * MiB;
constexpr size_t WS_MIX = 360 * MiB;
constexpr size_t WS_H = 393 * MiB;
constexpr size_t WS_END = 483 * MiB;

constexpr int CW_BAR = 4096;
constexpr int CW_RG = 16384;

constexpr int LDS_BYTES = 155648;
constexpr int MISC_OFF = 150 * 1024;

struct Args { const float* in[21]; float* out; unsigned char* ws; int ph_lo, ph_hi; };
typedef const volatile __attribute__((address_space(4))) Args* KArgsPtr;
__device__ __forceinline__ KArgsPtr kargs() { return (KArgsPtr)__builtin_amdgcn_kernarg_segment_ptr(); }
#define LOAD_ARGS(a) Args a; { KArgsPtr k_ = kargs(); _Pragma("unroll") for (int i_ = 0; i_ < 21; ++i_) a.in[i_] = (const float*)k_->in[i_]; a.out = (float*)k_->out; a.ws = (unsigned char*)k_->ws; a.ph_lo = 0; a.ph_hi = 0; }
__device__ __forceinline__ bool phase_on(int k) { KArgsPtr k_ = kargs(); const int lo = k_->ph_lo, hi = k_->ph_hi; return lo <= k && k < hi; }

__device__ __forceinline__ unsigned f2bf(float f) { unsigned u = __builtin_bit_cast(unsigned, f); return (u + 0x7fffu + ((u >> 16) & 1u)) >> 16; }
__device__ __forceinline__ unsigned pk2(float lo, float hi) { return f2bf(lo) | (f2bf(hi) << 16); }
__device__ __forceinline__ float bf2f(unsigned short b) { return __builtin_bit_cast(float, (unsigned)b << 16); }
__device__ __forceinline__ unsigned cvtpk(float lo, float hi) { return pg8::cvt_pk_bf16(lo, hi); }
__device__ __forceinline__ float fexp2(float x) { return __builtin_amdgcn_exp2f(x); }
__device__ __forceinline__ float frcp(float x) { return __builtin_amdgcn_rcpf(x); }
__device__ __forceinline__ float sigmoidf_(float x) { return frcp(1.0f + fexp2(-1.4426950408889634f * x)); }
__device__ __forceinline__ float gelu_tanh(float x) {
    const float u = x * (1.0f + 0.044715f * x * x);
    return x * frcp(1.0f + fexp2(-2.3022081565f * u));
}
#define LDS_WAIT() asm volatile("s_waitcnt lgkmcnt(0)" ::: "memory")
#define VM_WAIT() asm volatile("s_waitcnt vmcnt(0)" ::: "memory")

using pg8::Unit;
__device__ __forceinline__ float row_rstd(const float* ssqp, int row) {
    const f32x4* p = (const f32x4*)(ssqp + (size_t)row * 16);
    const f32x4 a = p[0], b = p[1], c = p[2], d = p[3];
    const f32x4 s = (a + b) + (c + d);
    const float ss = (s[0] + s[1]) + (s[2] + s[3]);
    return 1.0f / sqrtf(ss * (1.0f / DM) + RMS_EPS);
}

constexpr int RSTD_OFF = 131072, RSTD_MAX_UNITS = 8;
template <class Sched>
__device__ __forceinline__ void fill_rstd_table(LAS unsigned char* lds, const float* ssqp, const Sched& S) {
    const int tid = pg8::opaque_tid();
    Unit u;
    for (int i = 0; i < RSTD_MAX_UNITS && S.next(i, u); ++i) {
        const int row = u.pm * 256 + (tid >> 1);
        const f32x4* p = (const f32x4*)(ssqp + (size_t)row * 16) + (tid & 1) * 2;
        const f32x4 s = p[0] + p[1];
        float ss = (s[0] + s[1]) + (s[2] + s[3]);
        ss += __shfl_xor(ss, 1);
        if ((tid & 1) == 0) ((LAS float*)(lds + RSTD_OFF))[i * 256 + (tid >> 1)] = 1.0f / sqrtf(ss * (1.0f / DM) + RMS_EPS);
    }
    LDS_WAIT();
    __syncthreads();
}

struct EpiG1 {
    static constexpr bool PERM = true, AFTER_DRAIN = false;
    LAS unsigned char* lds; unsigned char* ws; float* out; int l;
    __device__ __forceinline__ void operator()(const f32x4 (&acc)[2][2][4][2], const Unit& u, int wr, int wc, int fr, int fq, int ui) const {
        const int sect = u.pn >> 1;
        const LAS float* rtab = (const LAS float*)(lds + RSTD_OFF) + ui * 256;
        const bool samp = (u.pm == MP / 256);
        const bool dorope = (sect <= 1) && ((wc & 1) == 0);
        const bool rl = dorope && (fq < 2);
        const int cbase = (u.pn & 1) * 256 + wc * 32;
        const int ca0 = cbase + (rl ? 4 * fq : 8 * fq), ca1 = cbase + (rl ? 8 + 4 * fq : 8 * fq + 4);
        const float* rope = (const float*)(ws + WS_ROPE) + 4 * (fq & 1);
        bf16_t* bdst = (bf16_t*)(ws + (sect == 0 ? WS_Q : sect == 1 ? WS_K : sect == 2 ? WS_V : sect == 3 ? WS_XR : WS_GY));
        float* pdst = out + (sect == 1 ? O_PK + (size_t)l * WBUF * 512 : sect == 2 ? O_PV + (size_t)l * WBUF * 512 : O_PC + (size_t)l * 3 * 512);
        const int prow0 = (sect == 3) ? (MP - 3) : (MP - WBUF);
        const bool has_p = (sect >= 1 && sect <= 3);
        float* sdst = (sect == 0) ? (float*)(ws + WS_QS) : (sect == 3) ? (float*)(ws + WS_XRS) : out + (sect == 1 ? O_SK : O_SV) + (size_t)l * NB * WBUF * 512;
        const float qs_ = (sect == 0) ? QSCALE : 1.0f;
#pragma unroll
        for (int ai = 0; ai < 2; ++ai) {
            if (samp && ai == 1) continue;
#pragma unroll
            for (int m = 0; m < 4; ++m) {
                const int rloc = ai * 128 + wr * 64 + m * 16 + fr, row = u.pm * 256 + rloc;
                const float rs = rtab[rloc];
                f32x4 cs = {1.f, 1.f, 1.f, 1.f}, sn = {0.f, 0.f, 0.f, 0.f};
                if (dorope) {
                    const int pos = samp ? (MP + (row & 3)) : row;
                    const float* rp = rope + (size_t)pos * 16;
                    cs = *(const f32x4*)rp; sn = *(const f32x4*)(rp + 8);
                }
#pragma unroll
                for (int bj = 0; bj < 2; ++bj) {
                    f32x4 v0 = acc[ai][bj][m][0] * rs, v1 = acc[ai][bj][m][1] * rs;
                    if (rl) { const f32x4 x1 = v0, x2 = v1; v0 = x1 * cs - x2 * sn; v1 = x2 * cs + x1 * sn; }
                    if (sect == 4) {
#pragma unroll
                        for (int e = 0; e < 4; ++e) { v0[e] = gelu_tanh(v0[e]); v1[e] = gelu_tanh(v1[e]); }
                    }
                    if (!samp || sect == 4) {
                        u32x2 w0, w1; w0.x = cvtpk(v0[0] * qs_, v0[1] * qs_); w0.y = cvtpk(v0[2] * qs_, v0[3] * qs_); w1.x = cvtpk(v1[0] * qs_, v1[1] * qs_); w1.y = cvtpk(v1[2] * qs_, v1[3] * qs_);
                        bf16_t* bp = bdst + (size_t)row * 512 + 128 * bj;
                        if (dorope) { *(u32x2*)(bp + ca0) = w0; *(u32x2*)(bp + ca1) = w1; }
                        else { *(u32x4*)(bp + ca0) = (u32x4){w0.x, w0.y, w1.x, w1.y}; }
                        if (has_p && row >= prow0) { float* o = pdst + (size_t)(row - prow0) * 512 + 128 * bj; *(f32x4*)(o + ca0) = v0; *(f32x4*)(o + ca1) = v1; }
                    } else {
                        const int s = row - MP;
                        const size_t srow = (sect == 1 || sect == 2) ? ((size_t)(s >> 2) * WBUF + (WBUF - NT) + (s & 3)) : (size_t)s;
                        float* o = sdst + srow * 512 + 128 * bj; *(f32x4*)(o + ca0) = v0; *(f32x4*)(o + ca1) = v1;
                    }
                }
                if (m & 1) asm volatile("" ::: "memory");
            }
        }
    }
};

struct EpiRes {
    static constexpr bool PERM = true, AFTER_DRAIN = false;
    const float* xin_p; const float* xin_s;
    float* X; bf16_t* XB; float* ssqp_out;
    __device__ __forceinline__ void operator()(const f32x4 (&acc)[2][2][4][2], const Unit& u, int wr, int wc, int fr, int fq, int ui) const {
        const int cb = u.pn * 256 + wc * 32 + 8 * fq;
        const bool samp = (u.pm == MP / 256);
#pragma unroll
        for (int ai = 0; ai < 2; ++ai) {
            if (samp && ai == 1) continue;
#pragma unroll
            for (int m = 0; m < 4; ++m) {
                const int row = u.pm * 256 + ai * 128 + wr * 64 + m * 16 + fr;
                const float* xr_ = samp ? (xin_s + (size_t)(row - MP) * DM) : (xin_p + (size_t)row * DM);
                float ss = 0.f;
#pragma unroll
                for (int bj = 0; bj < 2; ++bj) {
                    const int c0 = cb + 128 * bj;
                    const f32x4 a0 = *(const f32x4*)(xr_ + c0), a1 = *(const f32x4*)(xr_ + c0 + 4);
                    const f32x4 v0 = acc[ai][bj][m][0] + a0, v1 = acc[ai][bj][m][1] + a1;
                    float* xo = X + (size_t)row * DM + c0; *(f32x4*)xo = v0; *(f32x4*)(xo + 4) = v1;
                    u32x4 w; w.x = cvtpk(v0[0], v0[1]); w.y = cvtpk(v0[2], v0[3]); w.z = cvtpk(v1[0], v1[1]); w.w = cvtpk(v1[2], v1[3]);
                    *(u32x4*)(XB + (size_t)row * DM + c0) = w;
                    ss += (v0[0] * v0[0] + v0[1] * v0[1]) + (v0[2] * v0[2] + v0[3] * v0[3]) + (v1[0] * v1[0] + v1[1] * v1[1]) + (v1[2] * v1[2] + v1[3] * v1[3]);
                }
                ss += __shfl_xor(ss, 16); ss += __shfl_xor(ss, 32);
                if (fq == 0) ssqp_out[(size_t)row * 16 + u.pn * 4 + wc] = ss;
                if (m & 1) asm volatile("" ::: "memory");
            }
        }
    }
};

struct EpiG3 {
    static constexpr bool PERM = true, AFTER_DRAIN = false;
    LAS unsigned char* lds; bf16_t* H;
    __device__ __forceinline__ void operator()(const f32x4 (&acc)[2][2][4][2], const Unit& u, int wr, int wc, int fr, int fq, int ui) const {
        const int c0 = u.pn * 128 + wc * 32 + 8 * fq;
        const LAS float* rtab = (const LAS float*)(lds + RSTD_OFF) + ui * 256;
        const bool samp = (u.pm == MP / 256);
#pragma unroll
        for (int ai = 0; ai < 2; ++ai) {
            if (samp && ai == 1) continue;
#pragma unroll
            for (int m = 0; m < 4; ++m) {
                const int row = u.pm * 256 + ai * 128 + wr * 64 + m * 16 + fr;
                const float rs = rtab[ai * 128 + wr * 64 + m * 16 + fr];
                float hv[8];
#pragma unroll
                for (int n = 0; n < 2; ++n)
#pragma unroll
                    for (int e = 0; e < 4; ++e) { const float g = acc[ai][0][m][n][e] * rs, up = acc[ai][1][m][n][e] * rs; hv[4 * n + e] = g * up * sigmoidf_(g); }
                u32x4 w; w.x = cvtpk(hv[0], hv[1]); w.y = cvtpk(hv[2], hv[3]); w.z = cvtpk(hv[4], hv[5]); w.w = cvtpk(hv[6], hv[7]);
                *(u32x4*)(H + (size_t)row * DFF + c0) = w;
            }
        }
    }
};

#define XB_TMO      128
#define XB_XCNT(j)  (256  + 64 * (j))
#define XB_XSUB(j)  (1280 + 64 * (j))
#define XB_XGEN(j)  (2304 + 64 * (j))
#define XB_TOP      3328
#define XB_TOPGEN   3392
#define XCD_BAR_WORDS 3456
#define XB_SPIN_CAP (1u << 18)
__device__ __forceinline__ unsigned xb_ld(unsigned* p)              { return __hip_atomic_load(p, __ATOMIC_RELAXED, __HIP_MEMORY_SCOPE_AGENT); }
__device__ __forceinline__ unsigned xb_add(unsigned* p, unsigned v) { return __hip_atomic_fetch_add(p, v, __ATOMIC_RELAXED, __HIP_MEMORY_SCOPE_AGENT); }
__device__ __forceinline__ unsigned xb_xcc_id() { return (unsigned)__builtin_amdgcn_s_getreg((3 << 11) | 20) & 0xFu; }
#define XB_SPIN(cond, bar) do { unsigned _sp = 0; while (cond) { __builtin_amdgcn_s_sleep(1); \
    if ((++_sp & 255u) == 0u) { if (xb_ld(&(bar)[XB_TMO])) break; if (_sp > XB_SPIN_CAP) { atomicAdd(&(bar)[XB_TMO], 1u); break; } } } } while (0)
struct XcdBarrier { unsigned* bar; unsigned x; volatile LAS unsigned* st; };
__device__ __forceinline__ XcdBarrier xcd_barrier_post(unsigned* bar, volatile LAS unsigned* st) {
    XcdBarrier b; b.bar = bar; b.x = xb_xcc_id(); b.st = st;
    if (threadIdx.x == 0) (void)xb_add(&bar[XB_XCNT(b.x)], 1u);
    return b;
}
__device__ __forceinline__ void xcd_barrier_complete(unsigned* bar, unsigned x, unsigned& nloc, unsigned& nx) {
    const unsigned G = gridDim.x * gridDim.y * gridDim.z;
    unsigned sum, cnt, mine, sp = 0u;
    for (;;) {
        sum = 0u; cnt = 0u; mine = 0u;
#pragma unroll
        for (unsigned j = 0; j < 16; ++j) { const unsigned c = xb_ld(&bar[XB_XCNT(j)]); sum += c; cnt += (c > 0u) ? 1u : 0u; mine = (j == x) ? c : mine; }
        if (sum == G) break;
        __builtin_amdgcn_s_sleep(1);
        if ((++sp & 255u) == 0u) { if (xb_ld(&bar[XB_TMO])) break; if (sp > XB_SPIN_CAP) { atomicAdd(&bar[XB_TMO], 1u); break; } }
    }
    nloc = mine > 0u ? mine : 1u; nx = cnt > 0u ? cnt : 1u;
}
__device__ __forceinline__ void xcd_barrier(const XcdBarrier& b) {
    asm volatile("s_waitcnt vmcnt(0)" ::: "memory");
    __syncthreads();
    if (threadIdx.x == 0) {
        unsigned* bar = b.bar;
        __builtin_amdgcn_s_waitcnt(0);
        unsigned nloc = b.st[0], nx = b.st[1];
        if (nloc == 0u) { xcd_barrier_complete(bar, b.x, nloc, nx); b.st[0] = nloc; b.st[1] = nx; }
        const unsigned old = xb_add(&bar[XB_XSUB(b.x)], 1u);
        const unsigned gen = old / nloc;
        if (old + 1u == (gen + 1u) * nloc) {
            __builtin_amdgcn_fence(__ATOMIC_RELEASE, "agent");
            asm volatile("s_waitcnt vmcnt(0)" ::: "memory");
            const unsigned og = xb_add(&bar[XB_TOP], 1u);
            const unsigned tg = og / nx;
            if (og + 1u == (tg + 1u) * nx) xb_add(&bar[XB_TOPGEN], 1u);
            else XB_SPIN(xb_ld(&bar[XB_TOPGEN]) == tg, bar);
            __builtin_amdgcn_fence(__ATOMIC_ACQUIRE, "agent");
            xb_add(&bar[XB_XGEN(b.x)], 1u);
            asm volatile("s_waitcnt vmcnt(0)" ::: "memory");
        } else {
            XB_SPIN(xb_ld(&bar[XB_XGEN(b.x)]) == gen, bar);
            __builtin_amdgcn_fence(__ATOMIC_ACQUIRE, "agent");
            asm volatile("s_waitcnt vmcnt(0)" ::: "memory");
        }
    }
    __syncthreads();
}

__device__ __forceinline__ float wave_sum(float v) {
#pragma unroll
    for (int o = 1; o < 64; o <<= 1) v += __shfl_xor(v, o);
    return v;
}
__device__ __forceinline__ float wave_max(float v) {
#pragma unroll
    for (int o = 1; o < 64; o <<= 1) v = fmaxf(v, __shfl_xor(v, o));
    return v;
}
__device__ __forceinline__ void transpose_item(const float* W, int K, int N, bf16_t* WT, int item, const float* g, int rowmode, LAS float* scr, int lane) {
    const int nblk = N / 32, kb = item / nblk, nb = item % nblk, k0 = 64 * kb, n0 = 32 * nb;
#pragma unroll 8
    for (int i = 0; i < 32; ++i) { const int kk = 2 * i + (lane >> 5); float v = W[(size_t)(k0 + kk) * N + n0 + (lane & 31)]; if (g) v *= g[k0 + kk]; scr[kk * 33 + (lane & 31)] = v; }
    LDS_WAIT(); asm volatile("" ::: "memory");
    const int c = lane & 7;
#pragma unroll
    for (int j = 0; j < 4; ++j) { const int n = (lane >> 3) + 8 * j; const LAS float* s = scr + (8 * c) * 33 + n;
        u32x4 o; o.x = pk2(s[0 * 33], s[1 * 33]); o.y = pk2(s[2 * 33], s[3 * 33]); o.z = pk2(s[4 * 33], s[5 * 33]); o.w = pk2(s[6 * 33], s[7 * 33]);
        const int nn = n0 + n; int row;
        if (rowmode == 0) row = nn;
        else if (rowmode == 3) { const int d = nn & 63; row = (nn < 1024 && d < 16) ? ((nn & ~15) + 8 * ((d >> 2) & 1) + 4 * (d >> 3) + (d & 3)) : nn; }
        else row = 256 * (nn >> 7) + (nn & 127) + (rowmode == 2 ? 128 : 0);
        *(u32x4*)(WT + (size_t)row * K + k0 + 8 * c) = o; }
    LDS_WAIT(); asm volatile("" ::: "memory");
}
__device__ __forceinline__ void xrow_to_bf16(const float* xrow, bf16_t* orow, float* ssq16, int lane) {
    f32x4 v[4]; float s = 0.f;
    if (xrow) {
        const f32x4* xr = (const f32x4*)xrow + lane;
#pragma unroll
        for (int j = 0; j < 4; ++j) { v[j] = xr[64 * j]; s += (v[j].x * v[j].x + v[j].y * v[j].y) + (v[j].z * v[j].z + v[j].w * v[j].w); }
    } else {
#pragma unroll
        for (int j = 0; j < 4; ++j) v[j] = (f32x4){0.f, 0.f, 0.f, 0.f};
    }
    s = wave_sum(s);
    unsigned long long* o8 = (unsigned long long*)orow + lane;
#pragma unroll
    for (int j = 0; j < 4; ++j) o8[64 * j] = (unsigned long long)pk2(v[j].x, v[j].y) | ((unsigned long long)pk2(v[j].z, v[j].w) << 32);
    if (lane < 16) ssq16[lane] = (lane == 0) ? s : 0.f;
}
__device__ __forceinline__ void sincos_d(double x, float& c, float& s) {
    const double k = __builtin_rint(x * 0.6366197723675814);
    double r = __builtin_fma(-k, 1.5707963267948966, x); r = __builtin_fma(-k, 6.123233995736766e-17, r);
    const int q = ((int)k) & 3;
    const double r2 = r * r;
    double sp = -7.6471637318198164759e-13; sp = sp * r2 + 1.6059043836821614599e-10; sp = sp * r2 - 2.5052108385441718775e-08; sp = sp * r2 + 2.7557319223985890653e-06;
    sp = sp * r2 - 1.9841269841269841270e-04; sp = sp * r2 + 8.3333333333333333333e-03; sp = sp * r2 - 1.6666666666666666667e-01; const double sn = r + r * r2 * sp;
    double cp = 4.7794773323873852974e-14; cp = cp * r2 - 1.1470745597729724714e-11; cp = cp * r2 + 2.0876756987868098979e-09; cp = cp * r2 - 2.7557319223985890653e-07;
    cp = cp * r2 + 2.4801587301587301587e-05; cp = cp * r2 - 1.3888888888888888889e-03; cp = cp * r2 + 4.1666666666666666667e-02; cp = cp * r2 - 0.5; const double cn = 1.0 + r2 * cp;
    const double sv = (q == 0) ? sn : (q == 1) ? cn : (q == 2) ? -sn : -cn;
    const double cv = (q == 0) ? cn : (q == 1) ? -sn : (q == 2) ? -cn : sn;
    c = (float)cv; s = (float)sv;
}

__device__ __forceinline__ void phase_prologue(const Args& a, LAS unsigned char* lds) {
    const int tid = pg8::opaque_tid(), lane = tid & 63, wave = __builtin_amdgcn_readfirstlane(tid >> 6);
    const int G = gridDim.x, gw = blockIdx.x * 8 + wave, NGW = G * 8;
    LAS float* scr = (LAS float*)(lds + wave * 16384);
    unsigned char* ws = a.ws;
    constexpr int I_IN = (DM / 64) * (DIN / 32), I_OUT = (DM / 64) * (DM / 32), I_F = (DM / 64) * (DFF / 32), I_D = (DFF / 64) * (DM / 32);
    constexpr int I_LAYER = I_IN + I_OUT + 2 * I_F + I_D;
    for (int it = gw; it < NLAYER * I_LAYER; it += NGW) {
        const int l = it / I_LAYER; int r = it % I_LAYER;
        unsigned char* wl = ws + WS_W + (size_t)l * W_LAYER;
        if (r < I_IN) { transpose_item(a.in[7] + (size_t)l * DM * DIN, DM, DIN, (bf16_t*)(wl + W_IN), r, a.in[6] + l * DM, 3, scr, lane); continue; } r -= I_IN;
        if (r < I_OUT) { transpose_item(a.in[15] + (size_t)l * DM * DM, DM, DM, (bf16_t*)(wl + W_OUT), r, nullptr, 0, scr, lane); continue; } r -= I_OUT;
        if (r < I_F) { transpose_item(a.in[17] + (size_t)l * DM * DFF, DM, DFF, (bf16_t*)(wl + W_GU), r, a.in[16] + l * DM, 1, scr, lane); continue; } r -= I_F;
        if (r < I_F) { transpose_item(a.in[18] + (size_t)l * DM * DFF, DM, DFF, (bf16_t*)(wl + W_GU), r, a.in[16] + l * DM, 2, scr, lane); continue; } r -= I_F;
        transpose_item(a.in[19] + (size_t)l * DFF * DM, DFF, DM, (bf16_t*)(wl + W_FD), r, nullptr, 0, scr, lane);
    }
    {
        bf16_t* XBA = (bf16_t*)(ws + WS_XBA); float* ssq0 = (float*)(ws + WS_SSQP);
        for (int m = gw; m < MTOT; m += NGW) {
            const float* xr = (m < MP) ? (a.in[0] + (size_t)m * DM) : (m < MROWS) ? (a.in[1] + (size_t)(m - MP) * DM) : nullptr;
            xrow_to_bf16(xr, XBA + (size_t)m * DM, ssq0 + (size_t)m * 16, lane);
        }
    }
    const int gt = blockIdx.x * 512 + tid, NGT = G * 512;
    {
        float* rope = (float*)(ws + WS_ROPE);
        for (int e = gt; e < ROPE_ROWS * 8; e += NGT) {
            const int pos = e >> 3, i = e & 7;
            const double inv = (i == 0) ? 1.0 : (i == 1) ? 0.19392274474868576 : (i == 2) ? 0.03760603093086393 : (i == 3) ? 0.007292664737217109 :
                               (i == 4) ? 0.001414213562373095 : (i == 5) ? 0.0002742481756762073 : (i == 6) ? 5.318295896944988e-05 : 1.031338537721246e-05;
            float c, s; sincos_d((double)pos * inv, c, s);
            rope[(size_t)pos * 16 + i] = c; rope[(size_t)pos * 16 + 8 + i] = s;
        }
    }
    {
        bf16_t* wgt = (bf16_t*)(ws + WS_WGT);
        for (int e = gt; e < NLAYER * 2 * 8 * 64 * 64; e += NGT) {
            const int c = e & 63, d = (e >> 6) & 63, n = (e >> 12) & 7, gate = (e >> 15) & 1, l = e >> 16;
            const float* src = a.in[gate ? 12 : 10] + (size_t)((l * 8 + n) * 64 + c) * 64 + d;
            wgt[e] = (bf16_t)f2bf(*src);
        }
        float* sp = (float*)(ws + WS_SP);
        for (int e = gt; e < NLAYER * DR; e += NGT) { const float lam = a.in[14][e]; const float y = expf(-lam); sp[e] = (y < 0.03f) ? y * (1.0f - y * (0.5f - y * (0.33333333f - y * (0.25f - 0.2f * y)))) : logf(1.0f + y); }
    }
}

__device__ __forceinline__ void phase_copy(const Args& a) {
    constexpr size_t BLK4 = (size_t)(WBUF - NT) * 512 / 4;
    constexpr size_t TOT4 = (size_t)NLAYER * NB * BLK4;
    const size_t gt = (size_t)blockIdx.x * 512 + pg8::opaque_tid(), NGT = (size_t)gridDim.x * 512;
    for (int kv = 0; kv < 2; ++kv) {
        const f32x4* src = (const f32x4*)a.in[2 + kv];
        f32x4* dst = (f32x4*)(a.out + (kv ? O_SV : O_SK));
        for (size_t i = gt; i < TOT4; i += 4 * NGT) {
            f32x4 v[4]; size_t so[4], dofs[4];
#pragma unroll
            for (int j = 0; j < 4; ++j) { const size_t idx = i + j * NGT; const size_t blk = idx / BLK4, off = idx % BLK4; so[j] = blk * ((size_t)WBUF * 128) + NT * 128 + off; dofs[j] = blk * ((size_t)WBUF * 128) + off; }
#pragma unroll
            for (int j = 0; j < 4; ++j) if (i + j * NGT < TOT4) v[j] = __builtin_nontemporal_load(src + so[j]);
#pragma unroll
            for (int j = 0; j < 4; ++j) if (i + j * NGT < TOT4) __builtin_nontemporal_store(v[j], dst + dofs[j]);
        }
    }
}

namespace att {
constexpr int KCH = 6144;
constexpr int K_OFF = 0, V_OFF = 8 * KCH, VHALF = 384 * 64, WS_OFF = V_OFF + 2 * VHALF, OST_OFF = WS_OFF + 8 * 256, LDS_END = OST_OFF + 8 * 4096;
static_assert(LDS_END <= MISC_OFF, "attention LDS map");
typedef short v4i16_t __attribute__((ext_vector_type(4)));
__device__ __forceinline__ s16x4 vtr(const LAS unsigned char* p) { return __builtin_bit_cast(s16x4, __builtin_amdgcn_ds_read_tr16_b64_v4i16((LAS v4i16_t*)p)); }
__device__ __forceinline__ int crow(int r, int hi) { return (r & 3) + 8 * (r >> 2) + 4 * hi; }

__device__ __forceinline__ void unit(LAS unsigned char* lds, const bf16_t* Q, const bf16_t* K, const bf16_t* V, bf16_t* O, float* LSE, int dsh, int r, int jb, int h) {
    const int tid = pg8::opaque_tid(), lane = tid & 63, r32 = lane & 31, hi = lane >> 5;
    const int w = __builtin_amdgcn_readfirstlane(tid >> 6);
    const int i0 = jb * 256, kb = i0 - 128;
#pragma unroll
    for (int t = 0; t < 6; ++t) {
        int idx = kb + 64 * t + lane; idx = idx < 0 ? 0 : idx;
        const size_t tok = ((size_t)idx << dsh) + r;
        __builtin_amdgcn_global_load_lds((const unsigned*)(K + tok * 512 + h * 64 + w * 8), (LAS unsigned*)(lds + K_OFF + w * KCH + t * 1024), 16, 0, 0);
    }
#pragma unroll
    for (int t = 0; t < 6; ++t) {
        const int p = w * 6 + t, dh = p / 24, rg = p % 24;
        int idx = kb + 16 * rg + (lane >> 2); idx = idx < 0 ? 0 : idx;
        const size_t tok = ((size_t)idx << dsh) + r;
        __builtin_amdgcn_global_load_lds((const unsigned*)(V + tok * 512 + h * 64 + dh * 32 + (lane & 3) * 8), (LAS unsigned*)(lds + V_OFF + dh * VHALF + rg * 1024), 16, 0, 0);
    }
    const size_t qtok = ((size_t)(i0 + 32 * w + r32) << dsh) + r;
    bf16x8 qr[4];
#pragma unroll
    for (int d0 = 0; d0 < 4; ++d0) qr[d0] = *(const bf16x8*)(Q + qtok * 512 + h * 64 + d0 * 16 + hi * 8);
    VM_WAIT();
    __syncthreads();
    f32x16 p[5];
#pragma unroll
    for (int s = 0; s < 5; ++s) {
        const LAS unsigned char* kp = lds + K_OFF + hi * KCH + (32 * (w + s) + r32) * 16;
        f32x16 acc = {0.f, 0.f, 0.f, 0.f, 0.f, 0.f, 0.f, 0.f, 0.f, 0.f, 0.f, 0.f, 0.f, 0.f, 0.f, 0.f};
#pragma unroll
        for (int d0 = 0; d0 < 4; ++d0) { const bf16x8 kf = *(const LAS bf16x8*)(kp + d0 * 2 * KCH); acc = __builtin_amdgcn_mfma_f32_32x32x16_bf16(kf, qr[d0], acc, 0, 0, 0); }
        p[s] = acc;
    }
    const float NEG = -INFINITY;
#pragma unroll
    for (int rr = 0; rr < 16; ++rr) { const int kk = crow(rr, hi); if (kk < r32) p[0][rr] = NEG; if (kk > r32) p[4][rr] = NEG; }
    if (jb == 0) {
#pragma unroll
        for (int s = 0; s < 4; ++s) if (w + s <= 3) {
#pragma unroll
            for (int rr = 0; rr < 16; ++rr) p[s][rr] = NEG; }
    }
    float mx = p[4][0];
#pragma unroll
    for (int s = 0; s < 5; ++s)
#pragma unroll
        for (int rr = 0; rr < 16; ++rr) mx = fmaxf(mx, p[s][rr]);
    mx = fmaxf(mx, __shfl_xor(mx, 32));
    float ls = 0.f;
#pragma unroll
    for (int s = 0; s < 5; ++s)
#pragma unroll
        for (int rr = 0; rr < 16; ++rr) { const float e = fexp2(p[s][rr] - mx); p[s][rr] = e; ls += e; }
    ls += __shfl_xor(ls, 32);
    f32x16 o[2];
    o[0] = (f32x16){0.f, 0.f, 0.f, 0.f, 0.f, 0.f, 0.f, 0.f, 0.f, 0.f, 0.f, 0.f, 0.f, 0.f, 0.f, 0.f}; o[1] = o[0];
    const LAS unsigned char* vb = lds + V_OFF + ((lane >> 4) & 1) * 32 + (lane & 3) * 8 + (4 * hi + ((lane & 15) >> 2)) * 64;
#pragma unroll
    for (int s = 0; s < 5; ++s)
#pragma unroll
        for (int ks = 0; ks < 2; ++ks) {
            u32x4 pw; pw.x = cvtpk(p[s][8 * ks + 0], p[s][8 * ks + 1]); pw.y = cvtpk(p[s][8 * ks + 2], p[s][8 * ks + 3]); pw.z = cvtpk(p[s][8 * ks + 4], p[s][8 * ks + 5]); pw.w = cvtpk(p[s][8 * ks + 6], p[s][8 * ks + 7]);
            const bf16x8 pa = __builtin_bit_cast(bf16x8, pw);
            const LAS unsigned char* vrow = vb + (32 * (w + s) + 16 * ks) * 64;
#pragma unroll
            for (int d0 = 0; d0 < 2; ++d0) {
                const s16x4 lo = vtr(vrow + d0 * VHALF), hh = vtr(vrow + d0 * VHALF + 512);
                const bf16x8 vf = {lo[0], lo[1], lo[2], lo[3], hh[0], hh[1], hh[2], hh[3]};
                o[d0] = __builtin_amdgcn_mfma_f32_32x32x16_bf16(pa, vf, o[d0], 0, 0, 0);
            }
        }
    LAS float* wsf = (LAS float*)(lds + WS_OFF) + w * 64;
    if (hi == 0) wsf[r32] = ls;
    LDS_WAIT();
    LAS bf16_t* stg = (LAS bf16_t*)(lds + OST_OFF) + w * 2048;
#pragma unroll
    for (int rr = 0; rr < 16; ++rr) {
        const int orow = crow(rr, hi); const float rl = frcp(wsf[orow]);
        stg[orow * 64 + r32] = (bf16_t)f2bf(o[0][rr] * rl); stg[orow * 64 + 32 + r32] = (bf16_t)f2bf(o[1][rr] * rl);
    }
    LDS_WAIT();
#pragma unroll
    for (int i = 0; i < 4; ++i) {
        const int row = i * 8 + (lane >> 3), ch = lane & 7;
        const u32x4 v = *(const LAS u32x4*)(stg + row * 64 + ch * 8);
        const size_t tok = ((size_t)(i0 + 32 * w + row) << dsh) + r;
        *(u32x4*)(O + tok * 512 + h * 64 + ch * 8) = v;
    }
    if (hi == 0) LSE[qtok * 8 + h] = mx + __builtin_amdgcn_logf(ls);
    LDS_WAIT();
    __syncthreads();
}
}

namespace rg {
constexpr int XC_STRIDE = 1040;
constexpr int XC_BYTES = 64 * XC_STRIDE;
__device__ __forceinline__ int crow(int r, int hi) { return (r & 3) + 8 * (r >> 2) + 4 * hi; }
__device__ __forceinline__ float expm1_(float x) {
    const float p = x * (1.0f + x * (0.5f + x * (0.16666667f + x * (0.041666668f + x * (0.008333334f + x * 0.0013888889f)))));
    return (x > -0.25f) ? p : (expf(x) - 1.0f);
}
__device__ __forceinline__ void task(LAS unsigned char* lds, const Args& a, int l, int tk) {
    const int tid = pg8::opaque_tid(), lane = tid & 63, r32 = lane & 31, hi = lane >> 5;
    const int w = __builtin_amdgcn_readfirstlane(tid >> 6);
    unsigned char* ws = a.ws;
    const bf16_t* XR = (const bf16_t*)(ws + WS_XR);
    bf16_t* HL = (bf16_t*)(ws + WS_HL); bf16_t* CA = (bf16_t*)(ws + WS_CA);
    const bf16_t* WT = (const bf16_t*)(ws + WS_WGT) + (size_t)l * (2 * 8 * 64 * 64);
    const float* cw = a.in[8] + l * 4 * DR; const float* cbias = a.in[9] + l * DR;
    const float* bga = a.in[11] + l * DR; const float* bgx = a.in[13] + l * DR; const float* sp = (const float*)(ws + WS_SP) + l * DR;
    float runH[2] = {0.f, 0.f}, runA[2] = {1.f, 1.f};
    const int tg = tid >> 6, cg = tid & 63;
    for (int chunk = 0; chunk < 4; ++chunk) {
        const int t0 = tk * 256 + chunk * 64;
        __syncthreads();
        {
            float cwj[4][8], cbv[8];
#pragma unroll
            for (int j = 0; j < 4; ++j) { const f32x4 x0 = *(const f32x4*)(cw + j * DR + cg * 8), x1 = *(const f32x4*)(cw + j * DR + cg * 8 + 4);
#pragma unroll
                for (int e = 0; e < 4; ++e) { cwj[j][e] = x0[e]; cwj[j][4 + e] = x1[e]; } }
            { const f32x4 x0 = *(const f32x4*)(cbias + cg * 8), x1 = *(const f32x4*)(cbias + cg * 8 + 4);
#pragma unroll
                for (int e = 0; e < 4; ++e) { cbv[e] = x0[e]; cbv[4 + e] = x1[e]; } }
            u32x4 raw[11];
#pragma unroll
            for (int j = 0; j < 11; ++j) { const int t = t0 + 8 * tg - 3 + j; raw[j] = (t >= 0) ? *(const u32x4*)(XR + (size_t)t * 512 + cg * 8) : (u32x4){0u, 0u, 0u, 0u}; }
#pragma unroll
            for (int tt = 0; tt < 8; ++tt) {
                float xc[8];
#pragma unroll
                for (int e = 0; e < 8; ++e) xc[e] = cbv[e];
#pragma unroll
                for (int j = 0; j < 4; ++j) {
                    const u32x4 rw = raw[tt + j];
#pragma unroll
                    for (int e2 = 0; e2 < 4; ++e2) { const unsigned wv = rw[e2]; xc[2 * e2] += cwj[j][2 * e2] * __builtin_bit_cast(float, wv << 16); xc[2 * e2 + 1] += cwj[j][2 * e2 + 1] * __builtin_bit_cast(float, wv & 0xffff0000u); }
                }
                u32x4 o; o.x = cvtpk(xc[0], xc[1]); o.y = cvtpk(xc[2], xc[3]); o.z = cvtpk(xc[4], xc[5]); o.w = cvtpk(xc[6], xc[7]);
                *(LAS u32x4*)(lds + (8 * tg + tt) * XC_STRIDE + cg * 16) = o;
            }
        }
        LDS_WAIT();
        __syncthreads();
#pragma unroll
        for (int nt = 0; nt < 2; ++nt) {
            const int c = 64 * w + 32 * nt + r32;
            f32x16 ar[2], ab[2];
#pragma unroll
            for (int mt = 0; mt < 2; ++mt) { ar[mt] = (f32x16){0.f, 0.f, 0.f, 0.f, 0.f, 0.f, 0.f, 0.f, 0.f, 0.f, 0.f, 0.f, 0.f, 0.f, 0.f, 0.f}; ab[mt] = ar[mt]; }
#pragma unroll
            for (int ks = 0; ks < 4; ++ks) {
                const bf16x8 ba = *(const bf16x8*)(WT + ((size_t)(0 * 8 + w) * 64 + 32 * nt + r32) * 64 + 16 * ks + 8 * hi);
                const bf16x8 bx = *(const bf16x8*)(WT + ((size_t)(1 * 8 + w) * 64 + 32 * nt + r32) * 64 + 16 * ks + 8 * hi);
#pragma unroll
                for (int mt = 0; mt < 2; ++mt) {
                    const bf16x8 af = *(const LAS bf16x8*)(lds + (32 * mt + r32) * XC_STRIDE + (64 * w + 16 * ks + 8 * hi) * 2);
                    ar[mt] = __builtin_amdgcn_mfma_f32_32x32x16_bf16(af, ba, ar[mt], 0, 0, 0);
                    ab[mt] = __builtin_amdgcn_mfma_f32_32x32x16_bf16(af, bx, ab[mt], 0, 0, 0);
                }
            }
            const float vbga = bga[c], vbgx = bgx[c], vsp = sp[c];
            LAS bf16_t* stg = (LAS bf16_t*)(lds + XC_BYTES) + w * 4096;
            LAS bf16_t* stgw = stg + 4 * hi * 32 + r32;
#pragma unroll
            for (int mt = 0; mt < 2; ++mt)
#pragma unroll
                for (int rr = 0; rr < 16; ++rr) {
                    const int tkn = 32 * mt + crow(rr, hi);
                    const float xcv = bf2f(*(const LAS bf16_t*)(lds + tkn * XC_STRIDE + c * 2));
                    const float rg_ = sigmoidf_(ar[mt][rr] + vbga), ig_ = sigmoidf_(ab[mt][rr] + vbgx);
                    const float la = -8.0f * rg_ * vsp;
                    const float av = expf(la);
                    const float bv = sqrtf(-expm1_(2.0f * la)) * (ig_ * xcv);
                    ar[mt][rr] = av; ab[mt][rr] = bv;
                }
            float GA[8], GH[8];
#pragma unroll
            for (int mt = 0; mt < 2; ++mt)
#pragma unroll
                for (int k = 0; k < 4; ++k) {
                    float A = 1.f, H = 0.f;
#pragma unroll
                    for (int e = 0; e < 4; ++e) { const float av = ar[mt][4 * k + e], bv = ab[mt][4 * k + e]; H = av * H + bv; A = A * av; ar[mt][4 * k + e] = A; ab[mt][4 * k + e] = H; }
                    GA[mt * 4 + k] = A; GH[mt * 4 + k] = H;
                }
            float OA[8], OH[8];
#pragma unroll
            for (int q = 0; q < 8; ++q) { OA[q] = __shfl_xor(GA[q], 32); OH[q] = __shfl_xor(GH[q], 32); }
            float curH = runH[nt], curA = runA[nt];
#pragma unroll
            for (int mt = 0; mt < 2; ++mt)
#pragma unroll
                for (int k = 0; k < 4; ++k) {
                    const int q = mt * 4 + k;
                    const float ga0 = hi ? OA[q] : GA[q], gh0 = hi ? OH[q] : GH[q];
                    const float ga1 = hi ? GA[q] : OA[q], gh1 = hi ? GH[q] : OH[q];
                    const float midH = gh0 + ga0 * curH, midA = curA * ga0;
                    const float cinH = hi ? midH : curH, cinA = hi ? midA : curA;
#pragma unroll
                    for (int e = 0; e < 4; ++e) {
                        const float Al = ar[mt][4 * k + e], Hl = ab[mt][4 * k + e];
                        const float hv = Hl + Al * cinH, cav = Al * cinA;
                        stgw[(32 * mt + 8 * k + e) * 32] = (bf16_t)f2bf(hv); stgw[2048 + (32 * mt + 8 * k + e) * 32] = (bf16_t)f2bf(cav);
                    }
                    curH = gh1 + ga1 * midH; curA = midA * ga1;
                }
            runH[nt] = curH; runA[nt] = curA;
            LDS_WAIT();
#pragma unroll
            for (int i = 0; i < 4; ++i) {
                const int row = i * 16 + (lane >> 2), seg = lane & 3;
                const u32x4 vh = *(const LAS u32x4*)(stg + row * 32 + seg * 8), vc = *(const LAS u32x4*)(stg + 2048 + row * 32 + seg * 8);
                const size_t off = (size_t)(t0 + row) * 512 + 64 * w + 32 * nt + seg * 8;
                *(u32x4*)(HL + off) = vh; *(u32x4*)(CA + off) = vc;
            }
            LDS_WAIT();
        }
    }
    float* AGGA = (float*)(ws + WS_AGGA) + (size_t)l * 64 * DR; float* AGGH = (float*)(ws + WS_AGGH) + (size_t)l * 64 * DR; float* CARRY = (float*)(ws + WS_CARRY) + (size_t)l * 64 * DR;
    if (hi == 0) {
#pragma unroll
        for (int nt = 0; nt < 2; ++nt) { const int c = 64 * w + 32 * nt + r32; AGGA[(size_t)tk * DR + c] = runA[nt]; AGGH[(size_t)tk * DR + c] = runH[nt]; }
    }
    VM_WAIT();
    __syncthreads();
    volatile LAS unsigned* flag = (volatile LAS unsigned*)(lds + MISC_OFF + 64);
    if (tid == 0) {
        __builtin_amdgcn_fence(__ATOMIC_RELEASE, "agent");
        asm volatile("s_waitcnt vmcnt(0)" ::: "memory");
        const unsigned old = __hip_atomic_fetch_add((unsigned*)(ws + WS_CTL) + CW_RG + 64 * l, 1u, __ATOMIC_RELAXED, __HIP_MEMORY_SCOPE_AGENT);
        const unsigned last = (old == 63u) ? 1u : 0u;
        if (last) { __builtin_amdgcn_fence(__ATOMIC_ACQUIRE, "agent"); asm volatile("s_waitcnt vmcnt(0)" ::: "memory"); }
        flag[0] = last;
    }
    LDS_WAIT();
    __syncthreads();
    if (flag[0]) {
        float h = 0.f;
        for (int j0 = 0; j0 < 64; j0 += 16) {
            float va[16], vh[16];
#pragma unroll
            for (int j = 0; j < 16; ++j) { va[j] = __builtin_nontemporal_load(AGGA + (size_t)(j0 + j) * DR + tid); vh[j] = __builtin_nontemporal_load(AGGH + (size_t)(j0 + j) * DR + tid); }
#pragma unroll
            for (int j = 0; j < 16; ++j) { CARRY[(size_t)(j0 + j) * DR + tid] = h; h = vh[j] + va[j] * h; }
        }
        a.out[O_PH + (size_t)l * DR + tid] = h;
    }
    __syncthreads();
}
}

__device__ __forceinline__ void phase_fin(const Args& a, int l) {
    unsigned char* ws = a.ws;
    const bf16_t* OG = (const bf16_t*)(ws + WS_OG); const float* LSE = (const float*)(ws + WS_LSE);
    const bf16_t* HL = (const bf16_t*)(ws + WS_HL); const bf16_t* CA = (const bf16_t*)(ws + WS_CA); const bf16_t* GY = (const bf16_t*)(ws + WS_GY);
    const float* CARRY = (const float*)(ws + WS_CARRY) + (size_t)l * 64 * DR;
    bf16_t* MIX = (bf16_t*)(ws + WS_MIX);
    const size_t gt = (size_t)blockIdx.x * 512 + pg8::opaque_tid(), NGT = (size_t)gridDim.x * 512;
    for (size_t it = gt; it < (size_t)MP * 128; it += NGT) {
        const int tok = (int)(it >> 7), grp = (int)(it & 127);
#ifdef DBG_NO_ATT
        if (grp < 64) { *(u32x4*)(MIX + (size_t)tok * DM + grp * 8) = (u32x4){0u, 0u, 0u, 0u}; continue; }
#endif
#ifdef DBG_NO_RNN
        if (grp >= 64) { *(u32x4*)(MIX + (size_t)tok * DM + grp * 8) = (u32x4){0u, 0u, 0u, 0u}; continue; }
#endif
        if (grp < 64) {
            const int h = grp >> 3;
            const float l0 = LSE[(size_t)tok * 8 + h], l1 = LSE[(size_t)MP * 8 + (size_t)tok * 8 + h], l2 = LSE[(size_t)2 * MP * 8 + (size_t)tok * 8 + h];
            const float m = fmaxf(l0, fmaxf(l1, l2));
            float w0 = fexp2(l0 - m), w1 = fexp2(l1 - m), w2 = fexp2(l2 - m);
            const float inv = frcp(w0 + w1 + w2); w0 *= inv; w1 *= inv; w2 *= inv;
            const size_t off = (size_t)tok * 512 + grp * 8;
            const u32x4 o0 = *(const u32x4*)(OG + off), o1 = *(const u32x4*)(OG + (OG_STRIDE / 2) + off), o2 = *(const u32x4*)(OG + 2 * (OG_STRIDE / 2) + off);
            u32x4 r;
#pragma unroll
            for (int e = 0; e < 4; ++e) {
                const float lo = w0 * __builtin_bit_cast(float, o0[e] << 16) + w1 * __builtin_bit_cast(float, o1[e] << 16) + w2 * __builtin_bit_cast(float, o2[e] << 16);
                const float hh = w0 * __builtin_bit_cast(float, o0[e] & 0xffff0000u) + w1 * __builtin_bit_cast(float, o1[e] & 0xffff0000u) + w2 * __builtin_bit_cast(float, o2[e] & 0xffff0000u);
                r[e] = cvtpk(lo, hh);
            }
            *(u32x4*)(MIX + (size_t)tok * DM + grp * 8) = r;
        } else {
            const int cg = grp - 64;
            const size_t off = (size_t)tok * 512 + cg * 8;
            const u32x4 hl = *(const u32x4*)(HL + off), ca = *(const u32x4*)(CA + off), gy = *(const u32x4*)(GY + off);
            const float* cp = CARRY + (size_t)(tok >> 8) * DR + cg * 8;
            const f32x4 c0 = *(const f32x4*)cp, c1 = *(const f32x4*)(cp + 4);
            u32x4 r;
#pragma unroll
            for (int e = 0; e < 4; ++e) {
                const float clo = (e < 2) ? c0[2 * e] : c1[2 * e - 4], chi = (e < 2) ? c0[2 * e + 1] : c1[2 * e - 3];
                const float lo = (__builtin_bit_cast(float, hl[e] << 16) + __builtin_bit_cast(float, ca[e] << 16) * clo) * __builtin_bit_cast(float, gy[e] << 16);
                const float hh = (__builtin_bit_cast(float, hl[e] & 0xffff0000u) + __builtin_bit_cast(float, ca[e] & 0xffff0000u) * chi) * __builtin_bit_cast(float, gy[e] & 0xffff0000u);
                r[e] = cvtpk(lo, hh);
            }
            *(u32x4*)(MIX + (size_t)tok * DM + 512 + cg * 8) = r;
        }
    }
}

__device__ __forceinline__ void dbg_zero_sample_mix(const Args& a, int lo_col, int hi_col) {
    bf16_t* MIX = (bf16_t*)(a.ws + WS_MIX);
    for (size_t i = (size_t)blockIdx.x * 512 + threadIdx.x; i < (size_t)MS * DM; i += (size_t)gridDim.x * 512) { const int c = (int)(i & 1023); if (c >= lo_col && c < hi_col) MIX[(size_t)MP * DM + i] = 0; }
}
__device__ __forceinline__ void sattn_task(LAS unsigned char* ldsw, const Args& a, int l, int task, int lane) {
    const int h = task & 7, t = (task >> 3) & 3, b = task >> 5, s = b * 4 + t;
    unsigned char* ws = a.ws;
    LAS float* qsh = (LAS float*)ldsw; LAS float* psh = qsh + 64;
    qsh[lane] = ((const float*)(ws + WS_QS))[(size_t)s * 512 + h * 64 + lane] * 0.125f;
    LDS_WAIT();
    const size_t cbase = ((size_t)(l * NB + b) * WBUF) * 512 + h * 64;
    const float* ck = a.in[2] + cbase; const float* cv = a.in[3] + cbase;
    const float* nk = a.out + O_SK + cbase + (size_t)(WBUF - NT) * 512; const float* nv = a.out + O_SV + cbase + (size_t)(WBUF - NT) * 512;
#pragma unroll 1
    for (int i = 0; i < 7; ++i) {
        int g, m; bool valid = true;
        if (i < 6) { g = i >> 1; m = lane + 64 * (i & 1); } else { g = lane; m = 128; valid = lane < 3; if (!valid) g = 0; }
        const int j = WBUF + t - (m << (2 * g));
        const float* kr = (j >= WBUF) ? (nk + (size_t)(j - WBUF) * 512) : (ck + (size_t)j * 512);
        float acc = 0.f;
#pragma unroll
        for (int d = 0; d < 16; ++d) { const f32x4 kv = *(const f32x4*)(kr + 4 * d); const f32x4 qv = *(const LAS f32x4*)(qsh + 4 * d); acc += (kv[0] * qv[0] + kv[1] * qv[1]) + (kv[2] * qv[2] + kv[3] * qv[3]); }
        psh[valid ? (g * 129 + m) : (387 + lane)] = valid ? acc : -INFINITY;
    }
    LDS_WAIT();
    float mx = -INFINITY;
#pragma unroll
    for (int i = 0; i < 7; ++i) { const int sl = lane + 64 * i; if (sl < 387) mx = fmaxf(mx, psh[sl]); }
    mx = wave_max(mx);
    float sum = 0.f;
#pragma unroll
    for (int i = 0; i < 7; ++i) { const int sl = lane + 64 * i; if (sl < 387) { const float e = expf(psh[sl] - mx); psh[sl] = e; sum += e; } }
    sum = wave_sum(sum);
    LDS_WAIT();
    float acc = 0.f;
#pragma unroll
    for (int g = 0; g < 3; ++g) {
#pragma unroll 8
        for (int m = 0; m <= 128; ++m) {
            const int j = WBUF + t - (m << (2 * g));
            const float* vr = (j >= WBUF) ? (nv + (size_t)(j - WBUF) * 512) : (cv + (size_t)j * 512);
            acc += psh[g * 129 + m] * vr[lane];
        }
    }
    ((bf16_t*)(ws + WS_MIX))[(size_t)(MP + s) * DM + h * 64 + lane] = (bf16_t)f2bf(acc / sum);
    LDS_WAIT();
}

__device__ __forceinline__ void srglru_task(LAS unsigned char* lds, const Args& a, int l, int b) {
    const int c = pg8::opaque_tid();
    unsigned char* ws = a.ws;
    const float* xrs = (const float*)(ws + WS_XRS) + (size_t)b * 4 * DR;
    const float* sconv = a.in[4] + (size_t)(l * NB + b) * 3 * DR;
    float xp[7];
#pragma unroll
    for (int j = 0; j < 3; ++j) xp[j] = sconv[j * DR + c];
#pragma unroll
    for (int j = 0; j < 4; ++j) xp[3 + j] = xrs[j * DR + c];
    const float* cw = a.in[8] + l * 4 * DR;
    const float w0 = cw[c], w1 = cw[DR + c], w2 = cw[2 * DR + c], w3 = cw[3 * DR + c], cb = a.in[9][l * DR + c];
    float xc[4];
    LAS float* xcs = (LAS float*)lds;
    __syncthreads();
#pragma unroll
    for (int t = 0; t < 4; ++t) { xc[t] = w0 * xp[t] + w1 * xp[t + 1] + w2 * xp[t + 2] + w3 * xp[t + 3] + cb; xcs[t * DR + c] = xc[t]; }
    LDS_WAIT();
    __syncthreads();
    const int n = c >> 6, d = c & 63;
    const float* wa = a.in[10] + (size_t)(l * 8 + n) * 4096 + d; const float* wx = a.in[12] + (size_t)(l * 8 + n) * 4096 + d;
    float pa[4] = {0.f, 0.f, 0.f, 0.f}, px[4] = {0.f, 0.f, 0.f, 0.f};
#pragma unroll 8
    for (int k = 0; k < 64; ++k) {
        const float va = wa[k * 64], vx = wx[k * 64];
#pragma unroll
        for (int t = 0; t < 4; ++t) { const float xv = xcs[t * DR + n * 64 + k]; pa[t] += xv * va; px[t] += xv * vx; }
    }
    const float vbga = a.in[11][l * DR + c], vbgx = a.in[13][l * DR + c], vsp = ((const float*)(ws + WS_SP))[l * DR + c];
    float h = a.in[5][(size_t)(l * NB + b) * DR + c];
    const bf16_t* GY = (const bf16_t*)(ws + WS_GY); bf16_t* MIX = (bf16_t*)(ws + WS_MIX);
#pragma unroll
    for (int t = 0; t < 4; ++t) {
        const float rg_ = 1.0f / (1.0f + expf(-(pa[t] + vbga))), ig_ = 1.0f / (1.0f + expf(-(px[t] + vbgx)));
        const float la = -8.0f * rg_ * vsp;
        const float av = expf(la), bv = sqrtf(-rg::expm1_(2.0f * la)) * (ig_ * xc[t]);
        h = av * h + bv;
        const size_t row = (size_t)MP + b * 4 + t;
        MIX[row * DM + 512 + c] = (bf16_t)f2bf(h * bf2f(GY[row * 512 + c]));
    }
    a.out[O_SH + (size_t)(l * NB + b) * DR + c] = h;
#pragma unroll
    for (int j = 0; j < 3; ++j) a.out[O_SC + ((size_t)(l * NB + b) * 3 + j) * DR + c] = xp[4 + j];
    __syncthreads();
}

__device__ __forceinline__ void phase_final(const Args& a) {
    unsigned char* ws = a.ws;
    const int tid = pg8::opaque_tid(), lane = tid & 63, wave = tid >> 6;
    const int gw = blockIdx.x * 8 + wave, NGW = gridDim.x * 8;
    const float* X = (const float*)(ws + WS_X); const float* ssqp = (const float*)(ws + WS_SSQP + 4 * SSQP_STRIDE);
    const float* gf = a.in[20];
    f32x4 gv[4];
#pragma unroll
    for (int j = 0; j < 4; ++j) gv[j] = *((const f32x4*)gf + lane + 64 * j);
    for (int m = gw; m < MROWS; m += NGW) {
        const float rs = row_rstd(ssqp, m);
        const f32x4* xr = (const f32x4*)(X + (size_t)m * DM) + lane;
        f32x4* o = (f32x4*)(a.out + ((m < MP) ? (O_YP + (size_t)m * DM) : (O_YS + (size_t)(m - MP) * DM))) + lane;
#pragma unroll
        for (int j = 0; j < 4; ++j) o[64 * j] = xr[64 * j] * rs * gv[j];
    }
}

constexpr int N_PHASES = 14;
#ifndef MK_ONE_LAUNCH
#define MK_ONE_LAUNCH 0
#endif

__global__ void __launch_bounds__(512, 2) mk_fwd(Args a_unused) {
    extern __shared__ __attribute__((aligned(16))) unsigned char lds_raw[];
    LAS unsigned char* lds = (LAS unsigned char*)lds_raw;
    { const int tid0 = threadIdx.x; for (int u = tid0; u < (LDS_BYTES - MISC_OFF) / 4; u += 512) ((LAS unsigned*)(lds + MISC_OFF))[u] = 0u; }
    __syncthreads();
#ifndef PHM
#define PHM 0xfff
#endif
#define PM(b) ((PHM >> (b)) & 1)
#define IN(k) phase_on(k)
#if MK_ONE_LAUNCH
    { XcdBarrier b0 = xcd_barrier_post((unsigned*)((unsigned char*)kargs()->ws + WS_CTL) + CW_BAR, (volatile LAS unsigned*)(lds + MISC_OFF + 32)); (void)b0; }
#define SEAM(k) do { if (IN(k) && IN((k) + 1)) { XcdBarrier b_; b_.bar = (unsigned*)((unsigned char*)kargs()->ws + WS_CTL) + CW_BAR; b_.x = xb_xcc_id(); b_.st = (volatile LAS unsigned*)(lds + MISC_OFF + 32); xcd_barrier(b_); } } while (0)
#else
#define SEAM(k) do { } while (0)
#endif

    if (PM(0) && IN(0)) { LOAD_ARGS(a); phase_prologue(a, lds); phase_copy(a); SEAM(0); }

    for (int l = 0; l < NLAYER; ++l) {
        const int pb = 1 + 6 * l;
        if (PM(1) && IN(pb)) {
            LOAD_ARGS(a); unsigned char* ws = a.ws; unsigned char* wl = ws + WS_W + (size_t)l * W_LAYER; const int G = gridDim.x;
            const float* ssq_n1 = (const float*)(ws + WS_SSQP + (size_t)(l == 0 ? 0 : 2) * SSQP_STRIDE);
            pg8::Gemm g{(const bf16_t*)(ws + WS_XBA), (const bf16_t*)(wl + W_IN), MTOT, DIN, DM}; pg8::StaticOrder S; S.init(MTOT, DIN, G, (int)blockIdx.x);
            fill_rstd_table(lds, ssq_n1, S);
            EpiG1 E{lds, ws, a.out, l};
            pg8::gemm_phase<EpiG1, pg8::StaticOrder, true, true>(lds, g, S, E);
            SEAM(pb);
        }
        if (PM(2) && IN(pb + 1)) {
            LOAD_ARGS(a); unsigned char* ws = a.ws; const int G = gridDim.x;
            if (PM(8) && (int)blockIdx.x < 64) rg::task(lds, a, l, (int)blockIdx.x);
            else if (PM(9) && (int)blockIdx.x >= 64 && (int)blockIdx.x < 64 + NB) srglru_task(lds, a, l, (int)blockIdx.x - 64);
            __syncthreads();
            if (PM(10)) for (int u = blockIdx.x; u < 1536; u += G) {
                const int g = u >> 9, rem = u & 511, h = rem & 7, rj = rem >> 3;
                const int dsh = 2 * g, bpc = 64 >> dsh, r = rj / bpc, jb = rj % bpc;
                att::unit(lds, (const bf16_t*)(ws + WS_Q), (const bf16_t*)(ws + WS_K), (const bf16_t*)(ws + WS_V),
                          (bf16_t*)(ws + WS_OG + (size_t)g * OG_STRIDE), (float*)(ws + WS_LSE) + (size_t)g * MP * 8, dsh, r, jb, h);
            }
            __syncthreads();
            if (PM(11)) { const int tl = pg8::opaque_tid(); const int wv = __builtin_amdgcn_readfirstlane(tl >> 6); for (int t = blockIdx.x * 8 + wv; t < NB * NT * NH; t += G * 8) sattn_task(lds + wv * 4096, a, l, t, tl & 63); }
            SEAM(pb + 1);
        }
#ifdef DBG_ZERO_MIX
        if (PM(3) && IN(pb + 2)) { LOAD_ARGS(a); u32x4* mz = (u32x4*)(a.ws + WS_MIX); for (size_t i = (size_t)blockIdx.x * 512 + threadIdx.x; i < (size_t)MTOT * DM / 8; i += (size_t)gridDim.x * 512) mz[i] = (u32x4){0u, 0u, 0u, 0u}; SEAM(pb + 2); }
#else
        if (PM(3) && IN(pb + 2)) { LOAD_ARGS(a); phase_fin(a, l);
#ifdef DBG_NO_SATT
            dbg_zero_sample_mix(a, 0, 512);
#endif
#ifdef DBG_NO_SRG
            dbg_zero_sample_mix(a, 512, 1024);
#endif
            SEAM(pb + 2); }
#endif
        if (PM(4) && IN(pb + 3)) {
            LOAD_ARGS(a); unsigned char* ws = a.ws; unsigned char* wl = ws + WS_W + (size_t)l * W_LAYER; const int G = gridDim.x;
            float* ssq_n2 = (float*)(ws + WS_SSQP + (size_t)(l == 0 ? 1 : 3) * SSQP_STRIDE);
            pg8::Gemm g{(const bf16_t*)(ws + WS_MIX), (const bf16_t*)(wl + W_OUT), MTOT, DM, DM}; pg8::StaticOrder S; S.init(MTOT, DM, G, (int)blockIdx.x);
            const float* X = (const float*)(ws + WS_X);
            EpiRes E{l == 0 ? a.in[0] : X, l == 0 ? a.in[1] : X + (size_t)MP * DM, (float*)(ws + WS_X), (bf16_t*)(ws + WS_XBB), ssq_n2};
            pg8::gemm_phase<EpiRes, pg8::StaticOrder, true, true>(lds, g, S, E);
            SEAM(pb + 3);
        }
        if (PM(5) && IN(pb + 4)) {
            LOAD_ARGS(a); unsigned char* ws = a.ws; unsigned char* wl = ws + WS_W + (size_t)l * W_LAYER; const int G = gridDim.x;
            const float* ssq_n2 = (const float*)(ws + WS_SSQP + (size_t)(l == 0 ? 1 : 3) * SSQP_STRIDE);
            pg8::Gemm g{(const bf16_t*)(ws + WS_XBB), (const bf16_t*)(wl + W_GU), MTOT, NGU, DM}; pg8::StaticOrder S; S.init(MTOT, NGU, G, (int)blockIdx.x);
            fill_rstd_table(lds, ssq_n2, S);
            EpiG3 E{lds, (bf16_t*)(ws + WS_H)};
            pg8::gemm_phase<EpiG3, pg8::StaticOrder, true, true>(lds, g, S, E);
            SEAM(pb + 4);
        }
        if (PM(6) && IN(pb + 5)) {
            LOAD_ARGS(a); unsigned char* ws = a.ws; unsigned char* wl = ws + WS_W + (size_t)l * W_LAYER; const int G = gridDim.x;
            float* ssq_nx = (float*)(ws + WS_SSQP + (size_t)(l == 0 ? 2 : 4) * SSQP_STRIDE);
            pg8::Gemm g{(const bf16_t*)(ws + WS_H), (const bf16_t*)(wl + W_FD), MTOT, DM, DFF}; pg8::StaticOrder S; S.init(MTOT, DM, G, (int)blockIdx.x);
            const float* X = (const float*)(ws + WS_X);
            EpiRes E{X, X + (size_t)MP * DM, (float*)(ws + WS_X), (bf16_t*)(ws + WS_XBA), ssq_nx};
            pg8::gemm_phase<EpiRes, pg8::StaticOrder, true, true>(lds, g, S, E);
            SEAM(pb + 5);
        }
    }
    if (PM(7) && IN(13)) { LOAD_ARGS(a); phase_final(a); }
#undef IN
#undef SEAM
}

extern "C" void kernel_launch(void* const* d_in, const int* in_sizes, int n_in, void* d_out, int out_size, void* d_ws, size_t ws_size, hipStream_t stream) {
    static int grid = 0;
    if (grid == 0) {
        if (n_in != 21 || (size_t)out_size != O_END || ws_size < WS_END) { fprintf(stderr, "kernel_launch: unexpected shapes (n_in %d, out %d, ws %zu); nothing launched\n", n_in, out_size, ws_size); grid = -1; return; }
        int dev = 0, cus = 0, per_cu = 0;
        if (hipGetDevice(&dev) != hipSuccess || hipDeviceGetAttribute(&cus, hipDeviceAttributeMultiprocessorCount, dev) != hipSuccess) { grid = -1; return; }
        if (hipFuncSetAttribute((const void*)mk_fwd, hipFuncAttributeMaxDynamicSharedMemorySize, LDS_BYTES) != hipSuccess) { fprintf(stderr, "kernel_launch: hipFuncSetAttribute failed\n"); grid = -1; return; }
        if (hipOccupancyMaxActiveBlocksPerMultiprocessor(&per_cu, (const void*)mk_fwd, 512, LDS_BYTES) != hipSuccess || per_cu < 1) { fprintf(stderr, "kernel_launch: occupancy query says %d blocks per CU\n", per_cu); }
        (void)hipGetLastError();
        grid = cus;
    }
    if (grid < 0) return;
    hipMemsetAsync((char*)d_ws + WS_CTL, 0, CTL_ZERO_BYTES, stream);
    Args a{};
    for (int i = 0; i < 21; ++i) a.in[i] = (const float*)d_in[i];
    a.out = (float*)d_out; a.ws = (unsigned char*)d_ws;
#if MK_ONE_LAUNCH
    a.ph_lo = 0; a.ph_hi = N_PHASES;
    hipLaunchKernelGGL(mk_fwd, dim3(grid), dim3(512), LDS_BYTES, stream, a);
#else
    for (int p = 0; p < N_PHASES; ++p) { a.ph_lo = p; a.ph_hi = p + 1; hipLaunchKernelGGL(mk_fwd, dim3(grid), dim3(512), LDS_BYTES, stream, a); }
#endif
}
```

```cpp
#define MK_ONE_LAUNCH 1
#include <hip/hip_runtime.h>
#include <cstdio>
#include <cstdint>

namespace pg8 {
#define PG8_LAS __attribute__((address_space(3)))
typedef unsigned short bf16_t;
typedef short bf16x8 __attribute__((ext_vector_type(8)));
typedef float f32x4 __attribute__((ext_vector_type(4)));
typedef unsigned u32x4 __attribute__((ext_vector_type(4)));
constexpr int BM = 256, BK = 64, HALF = 128, HTB = HALF * BK * 2  , STAGE_BYTES = 8 * HTB, NXCD = 8, WGM = 8;

__host__ __device__ __forceinline__ int lds_byte(int r, int c) { const int st = (r >> 4) * 2 + (c >> 5), rr = r & 15, cc = c & 31, ob = rr * 64 + cc * 2; return st * 1024 + (ob ^ (((ob >> 9) & 1) << 5)); }
__host__ __device__ __forceinline__ void stage_rc(int b, int& R, int& C) { const int st = b / 1024, sb = b % 1024, swz = sb ^ (((sb >> 9) & 1) << 5); R = (st >> 1) * 16 + swz / 64; C = (st & 1) * 32 + (swz % 64) / 2; }
__host__ __device__ __forceinline__ int perm32(int rho) { const int n = rho >> 4, i = rho & 15; return 8 * (i >> 2) + 4 * n + (i & 3); }

struct Unit { int pm, pn; };
struct Gemm { const bf16_t* A; const bf16_t* Bt; int M, N, K; };

struct StaticOrder {
    int nM, nN, nwg, G, c;
    __host__ __device__ void init(int M, int N, int G_, int c_) { nM = M / BM; nN = N / BM; nwg = nM * nN; G = G_; c = c_; }
    __host__ __device__ bool next(int i, Unit& u) const {
        const long L = (long)i * G + c; if (L >= nwg) return false;
        int wgid = (int)L; { const int q = nwg / NXCD, r = nwg % NXCD, xcd = wgid % NXCD, off = wgid / NXCD; wgid = (xcd < r ? xcd * (q + 1) : r * (q + 1) + (xcd - r) * q) + off; }
        const int nig = WGM * nN, gid = wgid / nig, fm = gid * WGM, gsz = (nM - fm) < WGM ? (nM - fm) : WGM;
        u.pm = fm + ((wgid % nig) % gsz); u.pn = (wgid % nig) / gsz; return true;
    }
    __device__ __forceinline__ void a_ready(const Unit&) const {}
    __device__ __forceinline__ void done(const Unit&) const {}
};

__device__ __forceinline__ int opaque_tid() { int t = threadIdx.x; asm volatile("" : "+v"(t)); return t; }
__device__ __forceinline__ unsigned cvt_pk_bf16(float lo, float hi) { unsigned r; asm volatile("v_cvt_pk_bf16_f32 %0, %1, %2" : "=v"(r) : "v"(lo), "v"(hi)); return r; }

struct NoBg { struct Regs {}; __device__ __forceinline__ void begin(Regs&) const {} __device__ __forceinline__ void end(Regs&) const {} };
template <class Epi, class Sched, bool ALIGN_EPI = false, bool SP2 = false, class Bg = NoBg>
__device__ __forceinline__ void gemm_phase(PG8_LAS unsigned char* lds, const Gemm g, const Sched& S, const Epi& E, const Bg& B = Bg()) {
    const int tid = opaque_tid(), wid = __builtin_amdgcn_readfirstlane(tid >> 6), lane = tid & 63, wr = wid >> 2, wc = wid & 3, fr = lane & 15, fq = lane >> 4;
    const int K = g.K, nt = K / BK;
    unsigned voffA[2], voffB[2];
#pragma unroll
    for (int i = 0; i < 2; ++i) { int R, C; stage_rc(tid * 16 + i * 8192, R, C); const int Rb = Epi::PERM ? ((R & ~31) + perm32(R & 31)) : R;
        voffA[i] = (unsigned)(R * K + C) * 2u; voffB[i] = (unsigned)(Rb * K + C) * 2u; }
    const unsigned kstep = (unsigned)(BK * 2);
    const unsigned hstep = (unsigned)HALF * K * 2;
    const unsigned tstep = 2 * hstep;
    const __amdgpu_buffer_rsrc_t rsA = __builtin_amdgcn_make_buffer_rsrc((void*)g.A, 0, (int)((unsigned)g.M * (unsigned)K * 2u), 0x00020000);
    const __amdgpu_buffer_rsrc_t rsB = __builtin_amdgcn_make_buffer_rsrc((void*)g.Bt, 0, (int)((unsigned)g.N * (unsigned)K * 2u), 0x00020000);
    const unsigned ldsw = (unsigned)wid * 1024u;
    const int aoff = lds_byte(wr * 64 + fr, fq * 8), boff = lds_byte(wc * 32 + fr, fq * 8);
#define PG8_SA(b, h) (((b) * 2 + (h)) * HTB)
#define PG8_SB(b, h) ((4 + (b) * 2 + (h)) * HTB)
#define PG8_STAGE(bufoff, gbase, voff) do { _Pragma("unroll") for (int _i = 0; _i < 2; ++_i) \
        __builtin_amdgcn_raw_ptr_buffer_load_lds(PG8_RSRC_##voff, (PG8_LAS void*)(lds + (bufoff) + ldsw + _i * 8192), 16, (int)(voff)[_i], (int)(gbase), 0, 0); } while (0)
#define PG8_RSRC_voffA rsA
#define PG8_RSRC_voffB rsB
#define PG8_LDA(dst, b, h) do { _Pragma("unroll") for (int m = 0; m < 4; ++m) _Pragma("unroll") for (int k = 0; k < 2; ++k) dst[m][k] = *(const PG8_LAS bf16x8*)(lds + PG8_SA(b, h) + aoff + m * 2048 + k * 1024); } while (0)
#define PG8_LDB(dst, b, h) do { _Pragma("unroll") for (int n = 0; n < 2; ++n) _Pragma("unroll") for (int k = 0; k < 2; ++k) dst[n][k] = *(const PG8_LAS bf16x8*)(lds + PG8_SB(b, h) + boff + n * 2048 + k * 1024); } while (0)
#define PG8_MMA(ai, bj, At, Bt) do { __builtin_amdgcn_s_setprio(1); _Pragma("unroll") for (int m = 0; m < 4; ++m) _Pragma("unroll") for (int n = 0; n < 2; ++n) _Pragma("unroll") for (int k = 0; k < 2; ++k) \
        acc[ai][bj][m][n] = __builtin_amdgcn_mfma_f32_16x16x32_bf16(Bt[n][k], At[m][k], acc[ai][bj][m][n], 0, 0, 0); __builtin_amdgcn_s_setprio(0); } while (0)
#define PG8_WAIT_V(n) asm volatile("s_waitcnt vmcnt(" #n ")" ::: "memory")
#define PG8_WAIT_L(n) asm volatile("s_waitcnt lgkmcnt(" #n ")" ::: "memory")
#define PG8_BAR __builtin_amdgcn_s_barrier()
#define PG8_SCHED __builtin_amdgcn_sched_barrier(0)
    Unit cur, nxt; int ui = 0;
    if (!S.next(0, cur)) return;
    f32x4 acc[2][2][4][2];
#pragma unroll
    for (int a = 0; a < 2; ++a)
#pragma unroll
        for (int b = 0; b < 2; ++b)
#pragma unroll
            for (int m = 0; m < 4; ++m)
#pragma unroll
                for (int n = 0; n < 2; ++n) acc[a][b][m][n] = (f32x4){0.f, 0.f, 0.f, 0.f};
    bf16x8 At[4][2], B0[2][2], B1[2][2];
    unsigned cA = (unsigned)cur.pm * tstep, cB = (unsigned)cur.pn * tstep;
    S.a_ready(cur);
    if constexpr (SP2) {
        PG8_STAGE(PG8_SB(0, 0), cB, voffB); PG8_STAGE(PG8_SB(0, 1), cB + hstep, voffB); PG8_STAGE(PG8_SA(0, 0), cA, voffA); PG8_STAGE(PG8_SA(0, 1), cA + hstep, voffA);
        if (wr == 1) PG8_BAR;
        PG8_WAIT_V(2); PG8_BAR;
        PG8_STAGE(PG8_SB(1, 0), cB + kstep, voffB); PG8_STAGE(PG8_SA(1, 0), cA + kstep, voffA); PG8_STAGE(PG8_SB(1, 1), cB + hstep + kstep, voffB);
        PG8_WAIT_V(6); PG8_BAR;
    } else {
        PG8_STAGE(PG8_SB(0, 0), cB, voffB); PG8_STAGE(PG8_SA(0, 0), cA, voffA); PG8_STAGE(PG8_SB(0, 1), cB + hstep, voffB); PG8_STAGE(PG8_SA(0, 1), cA + hstep, voffA);
        if (wr == 1) PG8_BAR;
        PG8_WAIT_V(4); PG8_BAR;
        PG8_STAGE(PG8_SB(1, 0), cB + kstep, voffB); PG8_STAGE(PG8_SA(1, 0), cA + kstep, voffA); PG8_STAGE(PG8_SB(1, 1), cB + hstep + kstep, voffB);
        PG8_WAIT_V(6); PG8_BAR;
    }
    for (;;) {
        const bool has_next = S.next(ui + 1, nxt);
        const unsigned nA = has_next ? (unsigned)nxt.pm * tstep : cA, nB = has_next ? (unsigned)nxt.pn * tstep : cB;
        for (int t = 0; t < nt; t += 2) {
            const bool last = (t == nt - 2);
            const unsigned a1 = cA + (unsigned)(t + 1) * kstep;
            const unsigned a2 = last ? nA : cA + (unsigned)(t + 2) * kstep, b2 = last ? nB : cB + (unsigned)(t + 2) * kstep;
            const unsigned a3 = a2 + kstep, b3 = b2 + kstep;
            if (last && has_next) S.a_ready(nxt);
            if constexpr (SP2) {
            PG8_LDB(B0, 0, 0); PG8_LDB(B1, 0, 1); PG8_SCHED; PG8_LDA(At, 0, 0); PG8_STAGE(PG8_SA(1, 1), a1 + hstep, voffA);
            PG8_WAIT_V(8); PG8_WAIT_L(0); PG8_BAR; PG8_MMA(0, 0, At, B0); PG8_MMA(0, 1, At, B1); PG8_BAR; PG8_SCHED;
            PG8_LDA(At, 0, 1); PG8_STAGE(PG8_SB(0, 0), b2, voffB); PG8_STAGE(PG8_SB(0, 1), b2 + hstep, voffB); PG8_STAGE(PG8_SA(0, 0), a2, voffA);
            PG8_WAIT_V(8); PG8_WAIT_L(0); PG8_BAR; PG8_MMA(1, 0, At, B0); PG8_MMA(1, 1, At, B1); PG8_BAR; PG8_SCHED;
            PG8_LDB(B0, 1, 0); PG8_LDB(B1, 1, 1); PG8_SCHED; PG8_LDA(At, 1, 0); PG8_STAGE(PG8_SA(0, 1), a2 + hstep, voffA);
            PG8_WAIT_V(8); PG8_WAIT_L(0); PG8_BAR; PG8_MMA(0, 0, At, B0); PG8_MMA(0, 1, At, B1); PG8_BAR; PG8_SCHED;
            PG8_LDA(At, 1, 1); PG8_STAGE(PG8_SB(1, 0), b3, voffB); PG8_STAGE(PG8_SB(1, 1), b3 + hstep, voffB); PG8_STAGE(PG8_SA(1, 0), a3, voffA);
            PG8_WAIT_V(8); PG8_WAIT_L(0); PG8_BAR; PG8_MMA(1, 0, At, B0); PG8_MMA(1, 1, At, B1); PG8_BAR; PG8_SCHED;
            } else {
            PG8_LDB(B0, 0, 0); PG8_SCHED; PG8_LDA(At, 0, 0); PG8_STAGE(PG8_SA(1, 1), a1 + hstep, voffA);
            PG8_WAIT_L(8); PG8_BAR; PG8_WAIT_L(0); PG8_MMA(0, 0, At, B0); PG8_BAR; PG8_SCHED;
            PG8_LDB(B1, 0, 1); PG8_STAGE(PG8_SB(0, 0), b2, voffB);
            PG8_BAR; PG8_WAIT_L(0); PG8_MMA(0, 1, At, B1); PG8_BAR;
            PG8_LDA(At, 0, 1); PG8_STAGE(PG8_SA(0, 0), a2, voffA);
            PG8_BAR; PG8_WAIT_L(0); PG8_MMA(1, 0, At, B0); PG8_BAR; PG8_SCHED;
            PG8_STAGE(PG8_SB(0, 1), b2 + hstep, voffB);
            PG8_WAIT_V(6); PG8_BAR; PG8_MMA(1, 1, At, B1); PG8_BAR;
            PG8_LDB(B0, 1, 0); PG8_SCHED; PG8_LDA(At, 1, 0); PG8_STAGE(PG8_SA(0, 1), a2 + hstep, voffA);
            PG8_WAIT_L(8); PG8_BAR; PG8_WAIT_L(0); PG8_MMA(0, 0, At, B0); PG8_BAR; PG8_SCHED;
            PG8_LDB(B1, 1, 1); PG8_STAGE(PG8_SB(1, 0), b3, voffB);
            PG8_BAR; PG8_WAIT_L(0); PG8_MMA(0, 1, At, B1); PG8_BAR;
            PG8_LDA(At, 1, 1); PG8_STAGE(PG8_SA(1, 0), a3, voffA);
            PG8_BAR; PG8_WAIT_L(0); PG8_MMA(1, 0, At, B0); PG8_BAR; PG8_SCHED;
            PG8_STAGE(PG8_SB(1, 1), b3 + hstep, voffB);
            PG8_WAIT_V(6); PG8_BAR; PG8_MMA(1, 1, At, B1); PG8_BAR;
            }
        }
        if constexpr (ALIGN_EPI) { if (wr == 0) PG8_BAR; }
        if constexpr (!Epi::AFTER_DRAIN) { typename Bg::Regs bgr; E(acc, cur, wr, wc, fr, fq, ui, B, bgr); B.end(bgr); S.done(cur); }
        if (!has_next) break;
#pragma unroll
        for (int a = 0; a < 2; ++a)
#pragma unroll
            for (int b = 0; b < 2; ++b)
#pragma unroll
                for (int m = 0; m < 4; ++m)
#pragma unroll
                    for (int n = 0; n < 2; ++n) acc[a][b][m][n] = (f32x4){0.f, 0.f, 0.f, 0.f};
        cur = nxt; cA = nA; cB = nB; ++ui;
        if constexpr (ALIGN_EPI) { if (wr == 1) PG8_BAR; }
    }
    PG8_WAIT_V(0);
    if constexpr (!ALIGN_EPI) { if (wr == 0) PG8_BAR; }
    PG8_BAR;
#undef PG8_SA
#undef PG8_SB
#undef PG8_STAGE
#undef PG8_RSRC_voffA
#undef PG8_RSRC_voffB
#undef PG8_LDA
#undef PG8_LDB
#undef PG8_MMA
#undef PG8_WAIT_V
#undef PG8_WAIT_L
#undef PG8_BAR
#undef PG8_SCHED
}
}

#define LAS __attribute__((address_space(3)))
#define GAS __attribute__((address_space(1)))
typedef unsigned short bf16_t;
typedef short bf16x8 __attribute__((ext_vector_type(8)));
typedef short s16x4 __attribute__((ext_vector_type(4)));
typedef float f32x4 __attribute__((ext_vector_type(4)));
typedef float f32x16 __attribute__((ext_vector_type(16)));
typedef unsigned u32x4 __attribute__((ext_vector_type(4)));
typedef unsigned u32x2 __attribute__((ext_vector_type(2)));

constexpr int MP = 16384;
constexpr int MS = 128;
constexpr int MROWS = MP + MS;
constexpr int MTOT = 16640;
constexpr int DM = 1024, DIN = 2560, DA = 512, DR = 512, DFF = 2816, NGU = 2 * DFF;
constexpr int NH = 8, HD = 64, WBUF = 2048, NB = 32, NT = 4, NLAYER = 2;
constexpr int ROPE_ROWS = MP + NT;
constexpr float RMS_EPS = 1e-6f;
constexpr float QSCALE = 0.18033688011112042f;

constexpr size_t O_YP = 0, O_YS = 16777216, O_PK = 16908288, O_PV = 19005440, O_PC = 21102592, O_PH = 21105664,
                 O_SK = 21106688, O_SV = 88215552, O_SC = 155324416, O_SH = 155422720, O_END = 155455488;

constexpr size_t MiB = 1u << 20;
constexpr size_t WS_CTL = 0, CTL_ZERO_BYTES = 1 * MiB;
constexpr size_t WS_ROPE = 1 * MiB;
constexpr size_t WS_WGT = 3 * MiB;
constexpr size_t WS_SP = WS_WGT + 512 * 1024;
constexpr size_t WS_W = 5 * MiB, W_LAYER = 24 * MiB;
constexpr size_t W_IN = 0, W_OUT = 5242880, W_GU = 7340032, W_FD = 18874368;
constexpr size_t WS_SSQP = 53 * MiB, SSQP_STRIDE = 1114112;
constexpr size_t WS_QS = 59 * MiB;
constexpr size_t WS_XRS = WS_QS + 512 * 1024;
constexpr size_t WS_LSE = 60 * MiB;
constexpr size_t WS_XBA = 62 * MiB;
constexpr size_t WS_XBB = 95 * MiB;
constexpr size_t WS_X = 128 * MiB;
constexpr size_t WS_Q = 193 * MiB, WS_K = 210 * MiB, WS_V = 227 * MiB, WS_XR = 244 * MiB, WS_GY = 261 * MiB, WS_HL = 278 * MiB, WS_CA = 295 * MiB;
constexpr size_t WS_OG = 312 * MiB, OG_STRIDE = 16 * MiB;
constexpr size_t WS_MIX = 360 * MiB;
constexpr size_t WS_H = 393 * MiB;
constexpr size_t WS_AGGA = 483 * MiB, WS_AGGH = 484 * MiB, WS_CARRY = 485 * MiB;
constexpr size_t WS_ACC = 486 * MiB;
constexpr size_t WS_XP = 491 * MiB;
constexpr size_t WS_END = 556 * MiB;

constexpr int CW_BAR = 4096;
constexpr int CW_RG = 16384;

constexpr int LDS_BYTES = 155648;
constexpr int MISC_OFF = 150 * 1024;

struct Args { const float* in[21]; float* out; unsigned char* ws; int ph_lo, ph_hi; };
typedef const volatile __attribute__((address_space(4))) Args* KArgsPtr;
__device__ __forceinline__ KArgsPtr kargs() { return (KArgsPtr)__builtin_amdgcn_kernarg_segment_ptr(); }
#define LOAD_ARGS(a) Args a; { KArgsPtr k_ = kargs(); _Pragma("unroll") for (int i_ = 0; i_ < 21; ++i_) a.in[i_] = (const float*)k_->in[i_]; a.out = (float*)k_->out; a.ws = (unsigned char*)k_->ws; a.ph_lo = 0; a.ph_hi = 0; }
__device__ __forceinline__ bool phase_on(int k) { KArgsPtr k_ = kargs(); const int lo = k_->ph_lo, hi = k_->ph_hi; return lo <= k && k < hi; }

__device__ __forceinline__ unsigned f2bf(float f) { unsigned u = __builtin_bit_cast(unsigned, f); return (u + 0x7fffu + ((u >> 16) & 1u)) >> 16; }
__device__ __forceinline__ unsigned pk2(float lo, float hi) { return f2bf(lo) | (f2bf(hi) << 16); }
__device__ __forceinline__ float bf2f(unsigned short b) { return __builtin_bit_cast(float, (unsigned)b << 16); }
__device__ __forceinline__ unsigned cvtpk(float lo, float hi) { return pg8::cvt_pk_bf16(lo, hi); }
__device__ __forceinline__ float fexp2(float x) { return __builtin_amdgcn_exp2f(x); }
__device__ __forceinline__ float frcp(float x) { return __builtin_amdgcn_rcpf(x); }
__device__ __forceinline__ float sigmoidf_(float x) { return frcp(1.0f + fexp2(-1.4426950408889634f * x)); }
__device__ __forceinline__ float gelu_tanh(float x) {
    const float u = x * (1.0f + 0.044715f * x * x);
    return x * frcp(1.0f + fexp2(-2.3022081565f * u));
}
#define LDS_WAIT() asm volatile("s_waitcnt lgkmcnt(0)" ::: "memory")
#define VM_WAIT() asm volatile("s_waitcnt vmcnt(0)" ::: "memory")

using pg8::Unit;
__device__ __forceinline__ float row_rstd(const float* ssqp, int row) {
    const f32x4* p = (const f32x4*)(ssqp + (size_t)row * 16);
    const f32x4 a = p[0], b = p[1], c = p[2], d = p[3];
    const f32x4 s = (a + b) + (c + d);
    const float ss = (s[0] + s[1]) + (s[2] + s[3]);
    return 1.0f / sqrtf(ss * (1.0f / DM) + RMS_EPS);
}

constexpr int RSTD_OFF = 131072, RSTD_MAX_UNITS = 8;
template <class Sched>
__device__ __forceinline__ void fill_rstd_table(LAS unsigned char* lds, const float* ssqp  , const Sched& S) {
    const int tid = pg8::opaque_tid();
    Unit u;
    for (int i = 0; i < RSTD_MAX_UNITS && S.next(i, u); ++i) {
        const int row = u.pm * 256 + (tid >> 1);
        const f32x4* p = (const f32x4*)(ssqp + (size_t)row * 16) + (tid & 1) * 2;
        const f32x4 s = p[0] + p[1];
        float ss = (s[0] + s[1]) + (s[2] + s[3]);
        ss += __shfl_xor(ss, 1);
        if ((tid & 1) == 0) ((LAS float*)(lds + RSTD_OFF))[i * 256 + (tid >> 1)] = 1.0f / sqrtf(ss * (1.0f / DM) + RMS_EPS);
    }
    LDS_WAIT();
    __syncthreads();
}

struct PanelOrder {
    int j, R, nN;
    __device__ __forceinline__ bool next(int i, Unit& u) const { const int id = j + i * R; if (j < 0 || id >= nN) return false; u.pm = 0; u.pn = id; return true; }
    __device__ __forceinline__ void a_ready(const Unit&) const {}
    __device__ __forceinline__ void done(const Unit&) const {}
};

struct EpiG1 {
    static constexpr bool PERM = true, AFTER_DRAIN = false;
    LAS unsigned char* lds; unsigned char* ws; float* out; int l; int row0; bool samp;
    template <class Bg> __device__ __forceinline__ void operator()(const f32x4 (&acc)[2][2][4][2], const Unit& u, int wr, int wc, int fr, int fq, int ui, const Bg& B, typename Bg::Regs& bgr) const {
        const int sect = u.pn >> 1;
        const LAS float* rtab = (const LAS float*)(lds + RSTD_OFF) + ui * 256;
        const bool dorope = (sect <= 1) && ((wc & 1) == 0);
        const bool rl = dorope && (fq < 2);
        const int cbase = (u.pn & 1) * 256 + wc * 32;
        const int ca0 = cbase + (rl ? 4 * fq : 8 * fq), ca1 = cbase + (rl ? 8 + 4 * fq : 8 * fq + 4);
        const float* rope = (const float*)(ws + WS_ROPE) + 4 * (fq & 1);
        bf16_t* bdst = (bf16_t*)(ws + (sect == 0 ? WS_Q : sect == 1 ? WS_K : sect == 2 ? WS_V : sect == 3 ? WS_XR : WS_GY));
        float* pdst = out + (sect == 1 ? O_PK + (size_t)l * WBUF * 512 : sect == 2 ? O_PV + (size_t)l * WBUF * 512 : O_PC + (size_t)l * 3 * 512);
        const int prow0 = (sect == 3) ? (MP - 3) : (MP - WBUF);
        const bool has_p = (sect >= 1 && sect <= 3);
        float* sdst = (sect == 0) ? (float*)(ws + WS_QS) : (sect == 3) ? (float*)(ws + WS_XRS) : out + (sect == 1 ? O_SK : O_SV) + (size_t)l * NB * WBUF * 512;
        const float qs_ = (sect == 0) ? QSCALE : 1.0f;
#pragma unroll
        for (int ai = 0; ai < 2; ++ai) {
            if (ai == 1) { asm volatile("" ::: "memory"); B.begin(bgr); }
            if (samp && ai == 1) continue;
#pragma unroll
            for (int m = 0; m < 4; ++m) {
                const int rloc = ai * 128 + wr * 64 + m * 16 + fr, row = row0 + u.pm * 256 + rloc;
                const float rs = rtab[rloc];
                f32x4 cs = {1.f, 1.f, 1.f, 1.f}, sn = {0.f, 0.f, 0.f, 0.f};
                if (dorope) {
                    const int pos = samp ? (MP + (row & 3)) : row;
                    const float* rp = rope + (size_t)pos * 16;
                    cs = *(const f32x4*)rp; sn = *(const f32x4*)(rp + 8);
                }
#pragma unroll
                for (int bj = 0; bj < 2; ++bj) {
                    f32x4 v0 = acc[ai][bj][m][0] * rs, v1 = acc[ai][bj][m][1] * rs;
                    if (rl) { const f32x4 x1 = v0, x2 = v1; v0 = x1 * cs - x2 * sn; v1 = x2 * cs + x1 * sn; }
                    if (sect == 4) {
#pragma unroll
                        for (int e = 0; e < 4; ++e) { v0[e] = gelu_tanh(v0[e]); v1[e] = gelu_tanh(v1[e]); }
                    }
                    if (!samp || sect == 4) {
                        u32x2 w0, w1; w0.x = cvtpk(v0[0] * qs_, v0[1] * qs_); w0.y = cvtpk(v0[2] * qs_, v0[3] * qs_); w1.x = cvtpk(v1[0] * qs_, v1[1] * qs_); w1.y = cvtpk(v1[2] * qs_, v1[3] * qs_);
                        bf16_t* bp = bdst + (size_t)row * 512 + 128 * bj;
                        if (dorope) { *(u32x2*)(bp + ca0) = w0; *(u32x2*)(bp + ca1) = w1; }
                        else { *(u32x4*)(bp + ca0) = (u32x4){w0.x, w0.y, w1.x, w1.y}; }
                        if (has_p && row >= prow0) { float* o = pdst + (size_t)(row - prow0) * 512 + 128 * bj; *(f32x4*)(o + ca0) = v0; *(f32x4*)(o + ca1) = v1; }
                    } else {
                        const int s = row - MP;
                        const size_t srow = (sect == 1 || sect == 2) ? ((size_t)(s >> 2) * WBUF + (WBUF - NT) + (s & 3)) : (size_t)s;
                        float* o = sdst + srow * 512 + 128 * bj; *(f32x4*)(o + ca0) = v0; *(f32x4*)(o + ca1) = v1;
                    }
                }
                if (m & 1) asm volatile("" ::: "memory");
            }
        }
    }
};

struct EpiRes {
    static constexpr bool PERM = true, AFTER_DRAIN = false;
    const float* xin_p; const float* xin_s;
    const bf16_t* XBin; bf16_t* XBout; float* ssqp_out; int row0; bool samp;
    template <class Bg> __device__ __forceinline__ void operator()(const f32x4 (&acc)[2][2][4][2], const Unit& u, int wr, int wc, int fr, int fq, int ui, const Bg& B, typename Bg::Regs& bgr) const {
        const int cb = u.pn * 256 + wc * 32 + 8 * fq;
#pragma unroll
        for (int ai = 0; ai < 2; ++ai) {
            if (ai == 1) { asm volatile("" ::: "memory"); B.begin(bgr); }
            if (samp && ai == 1) continue;
#pragma unroll
            for (int m = 0; m < 4; ++m) {
                const int row = row0 + u.pm * 256 + ai * 128 + wr * 64 + m * 16 + fr;
                float ss = 0.f;
#pragma unroll
                for (int bj = 0; bj < 2; ++bj) {
                    const int c0 = cb + 128 * bj;
                    f32x4 a0, a1;
                    if (xin_p) { const float* xr_ = samp ? (xin_s + (size_t)(row - MP) * DM) : (xin_p + (size_t)row * DM); a0 = *(const f32x4*)(xr_ + c0); a1 = *(const f32x4*)(xr_ + c0 + 4); }
                    else { const u32x4 xw = *(const u32x4*)(XBin + (size_t)row * DM + c0);
                        a0 = (f32x4){__builtin_bit_cast(float, xw.x << 16), __builtin_bit_cast(float, xw.x & 0xffff0000u), __builtin_bit_cast(float, xw.y << 16), __builtin_bit_cast(float, xw.y & 0xffff0000u)};
                        a1 = (f32x4){__builtin_bit_cast(float, xw.z << 16), __builtin_bit_cast(float, xw.z & 0xffff0000u), __builtin_bit_cast(float, xw.w << 16), __builtin_bit_cast(float, xw.w & 0xffff0000u)}; }
                    const f32x4 v0 = acc[ai][bj][m][0] + a0, v1 = acc[ai][bj][m][1] + a1;
                    u32x4 w; w.x = cvtpk(v0[0], v0[1]); w.y = cvtpk(v0[2], v0[3]); w.z = cvtpk(v1[0], v1[1]); w.w = cvtpk(v1[2], v1[3]);
                    *(u32x4*)(XBout + (size_t)row * DM + c0) = w;
                    ss += (v0[0] * v0[0] + v0[1] * v0[1]) + (v0[2] * v0[2] + v0[3] * v0[3]) + (v1[0] * v1[0] + v1[1] * v1[1]) + (v1[2] * v1[2] + v1[3] * v1[3]);
                }
                ss += __shfl_xor(ss, 16); ss += __shfl_xor(ss, 32);
                if (fq == 0) ssqp_out[(size_t)row * 16 + u.pn * 4 + wc] = ss;
                if (m & 1) asm volatile("" ::: "memory");
            }
        }
    }
};

struct EpiG3 {
    static constexpr bool PERM = true, AFTER_DRAIN = false;
    LAS unsigned char* lds; bf16_t* H; int row0; bool samp;
    template <class Bg> __device__ __forceinline__ void operator()(const f32x4 (&acc)[2][2][4][2], const Unit& u, int wr, int wc, int fr, int fq, int ui, const Bg& B, typename Bg::Regs& bgr) const {
        const int c0 = u.pn * 128 + wc * 32 + 8 * fq;
        const LAS float* rtab = (const LAS float*)(lds + RSTD_OFF) + ui * 256;
#pragma unroll
        for (int ai = 0; ai < 2; ++ai) {
            if (ai == 1) { asm volatile("" ::: "memory"); B.begin(bgr); }
            if (samp && ai == 1) continue;
#pragma unroll
            for (int m = 0; m < 4; ++m) {
                const int row = row0 + u.pm * 256 + ai * 128 + wr * 64 + m * 16 + fr;
                const float rs = rtab[ai * 128 + wr * 64 + m * 16 + fr];
                float hv[8];
#pragma unroll
                for (int n = 0; n < 2; ++n)
#pragma unroll
                    for (int e = 0; e < 4; ++e) { const float g = acc[ai][0][m][n][e] * rs, up = acc[ai][1][m][n][e] * rs; hv[4 * n + e] = g * up * sigmoidf_(g); }
                u32x4 w; w.x = cvtpk(hv[0], hv[1]); w.y = cvtpk(hv[2], hv[3]); w.z = cvtpk(hv[4], hv[5]); w.w = cvtpk(hv[6], hv[7]);
                *(u32x4*)(H + (size_t)row * DFF + c0) = w;
                asm volatile("" ::: "memory");
            }
        }
    }
};

#define XB_TMO      128
#define XB_XCNT(j)  (256  + 64 * (j))
#define XB_XSUB(j)  (1280 + 64 * (j))
#define XB_XGEN(j)  (2304 + 64 * (j))
#define XB_TOP      3328
#define XB_TOPGEN   3392
#define XCD_BAR_WORDS 3456
#define XB_SPIN_CAP (1u << 18)
__device__ __forceinline__ unsigned xb_ld(unsigned* p)              { return __hip_atomic_load(p, __ATOMIC_RELAXED, __HIP_MEMORY_SCOPE_AGENT); }
__device__ __forceinline__ unsigned xb_add(unsigned* p, unsigned v) { return __hip_atomic_fetch_add(p, v, __ATOMIC_RELAXED, __HIP_MEMORY_SCOPE_AGENT); }
__device__ __forceinline__ unsigned xb_xcc_id() { return (unsigned)__builtin_amdgcn_s_getreg((3 << 11) | 20) & 0xFu; }
#define XB_SPIN(cond, bar) do { unsigned _sp = 0; while (cond) { __builtin_amdgcn_s_sleep(1); \
    if ((++_sp & 255u) == 0u) { if (xb_ld(&(bar)[XB_TMO])) break; if (_sp > XB_SPIN_CAP) { atomicAdd(&(bar)[XB_TMO], 1u); break; } } } } while (0)
struct XcdBarrier { unsigned* bar; unsigned x; volatile LAS unsigned* st; };
__device__ __forceinline__ XcdBarrier xcd_barrier_post(unsigned* bar, volatile LAS unsigned* st) {
    XcdBarrier b; b.bar = bar; b.x = xb_xcc_id(); b.st = st;
    if (threadIdx.x == 0) (void)xb_add(&bar[XB_XCNT(b.x)], 1u);
    return b;
}
__device__ __forceinline__ void xcd_barrier_complete(unsigned* bar, unsigned x, unsigned& nloc, unsigned& nx) {
    const unsigned G = gridDim.x * gridDim.y * gridDim.z;
    unsigned sum, cnt, mine, sp = 0u;
    for (;;) {
        sum = 0u; cnt = 0u; mine = 0u;
#pragma unroll
        for (unsigned j = 0; j < 16; ++j) { const unsigned c = xb_ld(&bar[XB_XCNT(j)]); sum += c; cnt += (c > 0u) ? 1u : 0u; mine = (j == x) ? c : mine; }
        if (sum == G) break;
        __builtin_amdgcn_s_sleep(1);
        if ((++sp & 255u) == 0u) { if (xb_ld(&bar[XB_TMO])) break; if (sp > XB_SPIN_CAP) { atomicAdd(&bar[XB_TMO], 1u); break; } }
    }
    nloc = mine > 0u ? mine : 1u; nx = cnt > 0u ? cnt : 1u;
}
__device__ __forceinline__ void xcd_barrier(const XcdBarrier& b) {
    asm volatile("s_waitcnt vmcnt(0)" ::: "memory");
    __syncthreads();
    if (threadIdx.x == 0) {
        unsigned* bar = b.bar;
        __builtin_amdgcn_s_waitcnt(0);
        unsigned nloc = b.st[0], nx = b.st[1];
        if (nloc == 0u) { xcd_barrier_complete(bar, b.x, nloc, nx); b.st[0] = nloc; b.st[1] = nx; }
        const unsigned old = xb_add(&bar[XB_XSUB(b.x)], 1u);
        const unsigned gen = old / nloc;
        if (old + 1u == (gen + 1u) * nloc) {
            __builtin_amdgcn_fence(__ATOMIC_RELEASE, "agent");
            asm volatile("s_waitcnt vmcnt(0)" ::: "memory");
            const unsigned og = xb_add(&bar[XB_TOP], 1u);
            const unsigned tg = og / nx;
            if (og + 1u == (tg + 1u) * nx) xb_add(&bar[XB_TOPGEN], 1u);
            else XB_SPIN(xb_ld(&bar[XB_TOPGEN]) == tg, bar);
            __builtin_amdgcn_fence(__ATOMIC_ACQUIRE, "agent");
            xb_add(&bar[XB_XGEN(b.x)], 1u);
            asm volatile("s_waitcnt vmcnt(0)" ::: "memory");
        } else {
            XB_SPIN(xb_ld(&bar[XB_XGEN(b.x)]) == gen, bar);
            __builtin_amdgcn_fence(__ATOMIC_ACQUIRE, "agent");
            asm volatile("s_waitcnt vmcnt(0)" ::: "memory");
        }
    }
    __syncthreads();
}

__device__ __forceinline__ float wave_sum(float v) {
#pragma unroll
    for (int o = 1; o < 64; o <<= 1) v += __shfl_xor(v, o);
    return v;
}
__device__ __forceinline__ float wave_max(float v) {
#pragma unroll
    for (int o = 1; o < 64; o <<= 1) v = fmaxf(v, __shfl_xor(v, o));
    return v;
}
__device__ __forceinline__ void transpose_item(const float* W, int K, int N, bf16_t* WT, int item, const float* g, int rowmode, LAS float* scr, int lane) {
    const int nblk = N / 32, kb = item / nblk, nb = item % nblk, k0 = 64 * kb, n0 = 32 * nb;
#pragma unroll 8
    for (int i = 0; i < 32; ++i) { const int kk = 2 * i + (lane >> 5); float v = W[(size_t)(k0 + kk) * N + n0 + (lane & 31)]; if (g) v *= g[k0 + kk]; scr[kk * 33 + (lane & 31)] = v; }
    LDS_WAIT(); asm volatile("" ::: "memory");
    const int c = lane & 7;
#pragma unroll
    for (int j = 0; j < 4; ++j) { const int n = (lane >> 3) + 8 * j; const LAS float* s = scr + (8 * c) * 33 + n;
        u32x4 o; o.x = pk2(s[0 * 33], s[1 * 33]); o.y = pk2(s[2 * 33], s[3 * 33]); o.z = pk2(s[4 * 33], s[5 * 33]); o.w = pk2(s[6 * 33], s[7 * 33]);
        const int nn = n0 + n; int row;
        if (rowmode == 0) row = nn;
        else if (rowmode == 3) { const int d = nn & 63; row = (nn < 1024 && d < 16) ? ((nn & ~15) + 8 * ((d >> 2) & 1) + 4 * (d >> 3) + (d & 3)) : nn; }
        else row = 256 * (nn >> 7) + (nn & 127) + (rowmode == 2 ? 128 : 0);
        *(u32x4*)(WT + (size_t)row * K + k0 + 8 * c) = o; }
    LDS_WAIT(); asm volatile("" ::: "memory");
}
__device__ __forceinline__ void xrow_to_bf16(const float* xrow, bf16_t* orow, float* ssq16, int lane) {
    f32x4 v[4]; float s = 0.f;
    if (xrow) {
        const f32x4* xr = (const f32x4*)xrow + lane;
#pragma unroll
        for (int j = 0; j < 4; ++j) { v[j] = xr[64 * j]; s += (v[j].x * v[j].x + v[j].y * v[j].y) + (v[j].z * v[j].z + v[j].w * v[j].w); }
    } else {
#pragma unroll
        for (int j = 0; j < 4; ++j) v[j] = (f32x4){0.f, 0.f, 0.f, 0.f};
    }
    s = wave_sum(s);
    unsigned long long* o8 = (unsigned long long*)orow + lane;
#pragma unroll
    for (int j = 0; j < 4; ++j) o8[64 * j] = (unsigned long long)pk2(v[j].x, v[j].y) | ((unsigned long long)pk2(v[j].z, v[j].w) << 32);
    if (lane < 16) ssq16[lane] = (lane == 0) ? s : 0.f;
}
__device__ __forceinline__ void sincos_d(double x, float& c, float& s) {
    const double k = __builtin_rint(x * 0.6366197723675814);
    double r = __builtin_fma(-k, 1.5707963267948966, x); r = __builtin_fma(-k, 6.123233995736766e-17, r);
    const int q = ((int)k) & 3;
    const double r2 = r * r;
    double sp = -7.6471637318198164759e-13; sp = sp * r2 + 1.6059043836821614599e-10; sp = sp * r2 - 2.5052108385441718775e-08; sp = sp * r2 + 2.7557319223985890653e-06;
    sp = sp * r2 - 1.9841269841269841270e-04; sp = sp * r2 + 8.3333333333333333333e-03; sp = sp * r2 - 1.6666666666666666667e-01; const double sn = r + r * r2 * sp;
    double cp = 4.7794773323873852974e-14; cp = cp * r2 - 1.1470745597729724714e-11; cp = cp * r2 + 2.0876756987868098979e-09; cp = cp * r2 - 2.7557319223985890653e-07;
    cp = cp * r2 + 2.4801587301587301587e-05; cp = cp * r2 - 1.3888888888888888889e-03; cp = cp * r2 + 4.1666666666666666667e-02; cp = cp * r2 - 0.5; const double cn = 1.0 + r2 * cp;
    const double sv = (q == 0) ? sn : (q == 1) ? cn : (q == 2) ? -sn : -cn;
    const double cv = (q == 0) ? cn : (q == 1) ? -sn : (q == 2) ? -cn : sn;
    c = (float)cv; s = (float)sv;
}

__device__ __forceinline__ void phase_prologue(const Args& a, LAS unsigned char* lds) {
    const int tid = pg8::opaque_tid(), lane = tid & 63, wave = __builtin_amdgcn_readfirstlane(tid >> 6);
    const int G = gridDim.x, gw = blockIdx.x * 8 + wave, NGW = G * 8;
    LAS float* scr = (LAS float*)(lds + wave * 16384);
    unsigned char* ws = a.ws;
    constexpr int I_IN = (DM / 64) * (DIN / 32), I_OUT = (DM / 64) * (DM / 32), I_F = (DM / 64) * (DFF / 32), I_D = (DFF / 64) * (DM / 32);
    constexpr int I_LAYER = I_IN + I_OUT + 2 * I_F + I_D;
    for (int it = gw; it < NLAYER * I_LAYER; it += NGW) {
        const int l = it / I_LAYER; int r = it % I_LAYER;
        unsigned char* wl = ws + WS_W + (size_t)l * W_LAYER;
        if (r < I_IN) { transpose_item(a.in[7] + (size_t)l * DM * DIN, DM, DIN, (bf16_t*)(wl + W_IN), r, a.in[6] + l * DM, 3, scr, lane); continue; } r -= I_IN;
        if (r < I_OUT) { transpose_item(a.in[15] + (size_t)l * DM * DM, DM, DM, (bf16_t*)(wl + W_OUT), r, nullptr, 0, scr, lane); continue; } r -= I_OUT;
        if (r < I_F) { transpose_item(a.in[17] + (size_t)l * DM * DFF, DM, DFF, (bf16_t*)(wl + W_GU), r, a.in[16] + l * DM, 1, scr, lane); continue; } r -= I_F;
        if (r < I_F) { transpose_item(a.in[18] + (size_t)l * DM * DFF, DM, DFF, (bf16_t*)(wl + W_GU), r, a.in[16] + l * DM, 2, scr, lane); continue; } r -= I_F;
        transpose_item(a.in[19] + (size_t)l * DFF * DM, DFF, DM, (bf16_t*)(wl + W_FD), r, nullptr, 0, scr, lane);
    }
    {
        bf16_t* XBA = (bf16_t*)(ws + WS_XBA); float* ssq0 = (float*)(ws + WS_SSQP);
        for (int m = gw; m < MTOT; m += NGW) {
            const float* xr = (m < MP) ? (a.in[0] + (size_t)m * DM) : (m < MROWS) ? (a.in[1] + (size_t)(m - MP) * DM) : nullptr;
            xrow_to_bf16(xr, XBA + (size_t)m * DM, ssq0 + (size_t)m * 16, lane);
        }
    }
    const int gt = blockIdx.x * 512 + tid, NGT = G * 512;
    {
        float* rope = (float*)(ws + WS_ROPE);
        for (int e = gt; e < ROPE_ROWS * 8; e += NGT) {
            const int pos = e >> 3, i = e & 7;
            const double inv = (i == 0) ? 1.0 : (i == 1) ? 0.19392274474868576 : (i == 2) ? 0.03760603093086393 : (i == 3) ? 0.007292664737217109 :
                               (i == 4) ? 0.001414213562373095 : (i == 5) ? 0.0002742481756762073 : (i == 6) ? 5.318295896944988e-05 : 1.031338537721246e-05;
            float c, s; sincos_d((double)pos * inv, c, s);
            rope[(size_t)pos * 16 + i] = c; rope[(size_t)pos * 16 + 8 + i] = s;
        }
    }
    {
        bf16_t* wgt = (bf16_t*)(ws + WS_WGT);
        for (int e = gt; e < NLAYER * 2 * 8 * 64 * 64; e += NGT) {
            const int c = e & 63, d = (e >> 6) & 63, n = (e >> 12) & 7, gate = (e >> 15) & 1, l = e >> 16;
            const float* src = a.in[gate ? 12 : 10] + (size_t)((l * 8 + n) * 64 + c) * 64 + d;
            wgt[e] = (bf16_t)f2bf(*src);
        }
        float* sp = (float*)(ws + WS_SP);
        for (int e = gt; e < NLAYER * DR; e += NGT) { const float lam = a.in[14][e]; const float y = expf(-lam); sp[e] = (y < 0.03f) ? y * (1.0f - y * (0.5f - y * (0.33333333f - y * (0.25f - 0.2f * y)))) : logf(1.0f + y); }
    }
}

namespace cpy {
constexpr unsigned CPB = (unsigned)(WBUF - NT) * 2048u / 8192u;
constexpr unsigned NPIECE = 2u * NLAYER * NB * CPB;
constexpr unsigned NCHUNKS = NPIECE / 2u;
static_assert((WBUF - NT) * 2048 % 8192 == 0 && NPIECE % 2 == 0, "copy chunking");
constexpr int CW_COPYQ = 20480;
constexpr int LDS_NEXT = MISC_OFF + 128;
struct Bg {
    const float* ck; const float* cv; float* out; unsigned* q; LAS unsigned char* lds;
    struct Regs { f32x4 v[16]; unsigned id, nxt; };
    __device__ __forceinline__ void addr(unsigned p, const char*& src, char*& dst) const {
        const unsigned t = p / (NLAYER * NB * CPB), r = p - t * (NLAYER * NB * CPB), blk = r / CPB, k = r - blk * CPB;
        src = (const char*)(t ? cv : ck) + (size_t)blk * (WBUF * 2048u) + NT * 2048u + (size_t)k * 8192u;
        dst = (char*)(out + (t ? O_SV : O_SK)) + (size_t)blk * (WBUF * 2048u) + (size_t)k * 8192u;
    }
    __device__ __forceinline__ void init() const {}
    __device__ __forceinline__ void begin(Regs& r) const {
        const int tid = pg8::opaque_tid(), lane = tid & 63, w = __builtin_amdgcn_readfirstlane(tid >> 6);
        const unsigned k = (unsigned)__builtin_amdgcn_readfirstlane(((volatile LAS unsigned*)(lds + LDS_NEXT))[w]);
        r.id = (blockIdx.x * 8u + (unsigned)w) + k * (gridDim.x * 8u); r.nxt = k + 1u;
        if (r.id < NCHUNKS) {
#pragma unroll
            for (int h = 0; h < 2; ++h) { const char* s; char* d; addr(2u * r.id + h, s, d);
#pragma unroll
                for (int i = 0; i < 8; ++i) r.v[8 * h + i] = __builtin_nontemporal_load((const f32x4*)(s + i * 1024) + lane); }
        }
    }
    __device__ __forceinline__ void end(Regs& r) const {
        const int tid = pg8::opaque_tid(), lane = tid & 63, w = __builtin_amdgcn_readfirstlane(tid >> 6);
        if (r.id < NCHUNKS) {
#pragma unroll
            for (int h = 0; h < 2; ++h) { const char* s; char* d; addr(2u * r.id + h, s, d);
#pragma unroll
                for (int i = 0; i < 8; ++i) __builtin_nontemporal_store(r.v[8 * h + i], (f32x4*)(d + i * 1024) + lane); }
            if (lane == 0) ((LAS unsigned*)(lds + LDS_NEXT))[w] = r.nxt;
        }
    }
    __device__ __forceinline__ void drain() const {
        Regs r;
        for (;;) { begin(r); if (r.id >= NCHUNKS) break; end(r); LDS_WAIT(); }
    }
};
}

namespace att {
constexpr int KCH = 6144;
constexpr int K_OFF = 0, V_OFF = 8 * KCH, VHALF = 384 * 64, WS_OFF = V_OFF + 2 * VHALF, OST_OFF = WS_OFF + 8 * 256, LDS_END = OST_OFF + 8 * 4096;
static_assert(LDS_END <= MISC_OFF, "attention LDS map");
typedef short v4i16_t __attribute__((ext_vector_type(4)));
__device__ __forceinline__ s16x4 vtr(const LAS unsigned char* p) { return __builtin_bit_cast(s16x4, __builtin_amdgcn_ds_read_tr16_b64_v4i16((LAS v4i16_t*)p)); }
__device__ __forceinline__ int crow(int r, int hi) { return (r & 3) + 8 * (r >> 2) + 4 * hi; }

template <class Bg> __device__ __forceinline__ void unit(LAS unsigned char* lds, const bf16_t* Q, const bf16_t* K, const bf16_t* V, bf16_t* O, float* LSE, int dsh, int r, int jb, int h, const Bg& B) {
    const int tid = pg8::opaque_tid(), lane = tid & 63, r32 = lane & 31, hi = lane >> 5;
    const int w = __builtin_amdgcn_readfirstlane(tid >> 6);
    const int i0 = jb * 256, kb = i0 - 128;
#pragma unroll
    for (int t = 0; t < 6; ++t) {
        int idx = kb + 64 * t + lane; idx = idx < 0 ? 0 : idx;
        const size_t tok = ((size_t)idx << dsh) + r;
        __builtin_amdgcn_global_load_lds((const unsigned*)(K + tok * 512 + h * 64 + w * 8), (LAS unsigned*)(lds + K_OFF + w * KCH + t * 1024), 16, 0, 0);
    }
#pragma unroll
    for (int t = 0; t < 6; ++t) {
        const int p = w * 6 + t, dh = p / 24, rg = p % 24;
        int idx = kb + 16 * rg + (lane >> 2); idx = idx < 0 ? 0 : idx;
        const size_t tok = ((size_t)idx << dsh) + r;
        __builtin_amdgcn_global_load_lds((const unsigned*)(V + tok * 512 + h * 64 + dh * 32 + (lane & 3) * 8), (LAS unsigned*)(lds + V_OFF + dh * VHALF + rg * 1024), 16, 0, 0);
    }
    const size_t qtok = ((size_t)(i0 + 32 * w + r32) << dsh) + r;
    bf16x8 qr[4];
#pragma unroll
    for (int d0 = 0; d0 < 4; ++d0) qr[d0] = *(const bf16x8*)(Q + qtok * 512 + h * 64 + d0 * 16 + hi * 8);
    VM_WAIT();
    __syncthreads();
    typename Bg::Regs bgr; B.begin(bgr);
    f32x16 p[5];
#pragma unroll
    for (int s = 0; s < 5; ++s) {
        const LAS unsigned char* kp = lds + K_OFF + hi * KCH + (32 * (w + s) + r32) * 16;
        f32x16 acc = {0.f, 0.f, 0.f, 0.f, 0.f, 0.f, 0.f, 0.f, 0.f, 0.f, 0.f, 0.f, 0.f, 0.f, 0.f, 0.f};
#pragma unroll
        for (int d0 = 0; d0 < 4; ++d0) { const bf16x8 kf = *(const LAS bf16x8*)(kp + d0 * 2 * KCH); acc = __builtin_amdgcn_mfma_f32_32x32x16_bf16(kf, qr[d0], acc, 0, 0, 0); }
        p[s] = acc;
    }
    const float NEG = -INFINITY;
#pragma unroll
    for (int rr = 0; rr < 16; ++rr) { const int kk = crow(rr, hi); if (kk < r32) p[0][rr] = NEG; if (kk > r32) p[4][rr] = NEG; }
    if (jb == 0) {
#pragma unroll
        for (int s = 0; s < 4; ++s) if (w + s <= 3) {
#pragma unroll
            for (int rr = 0; rr < 16; ++rr) p[s][rr] = NEG; }
    }
    float mx = p[4][0];
#pragma unroll
    for (int s = 0; s < 5; ++s)
#pragma unroll
        for (int rr = 0; rr < 16; ++rr) mx = fmaxf(mx, p[s][rr]);
    mx = fmaxf(mx, __shfl_xor(mx, 32));
    float ls = 0.f;
#pragma unroll
    for (int s = 0; s < 5; ++s)
#pragma unroll
        for (int rr = 0; rr < 16; ++rr) { const float e = fexp2(p[s][rr] - mx); p[s][rr] = e; ls += e; }
    ls += __shfl_xor(ls, 32);
    f32x16 o[2];
    o[0] = (f32x16){0.f, 0.f, 0.f, 0.f, 0.f, 0.f, 0.f, 0.f, 0.f, 0.f, 0.f, 0.f, 0.f, 0.f, 0.f, 0.f}; o[1] = o[0];
    const LAS unsigned char* vb = lds + V_OFF + ((lane >> 4) & 1) * 32 + (lane & 3) * 8 + (4 * hi + ((lane & 15) >> 2)) * 64;
#pragma unroll
    for (int s = 0; s < 5; ++s)
#pragma unroll
        for (int ks = 0; ks < 2; ++ks) {
            u32x4 pw; pw.x = cvtpk(p[s][8 * ks + 0], p[s][8 * ks + 1]); pw.y = cvtpk(p[s][8 * ks + 2], p[s][8 * ks + 3]); pw.z = cvtpk(p[s][8 * ks + 4], p[s][8 * ks + 5]); pw.w = cvtpk(p[s][8 * ks + 6], p[s][8 * ks + 7]);
            const bf16x8 pa = __builtin_bit_cast(bf16x8, pw);
            const LAS unsigned char* vrow = vb + (32 * (w + s) + 16 * ks) * 64;
#pragma unroll
            for (int d0 = 0; d0 < 2; ++d0) {
                const s16x4 lo = vtr(vrow + d0 * VHALF), hh = vtr(vrow + d0 * VHALF + 512);
                const bf16x8 vf = {lo[0], lo[1], lo[2], lo[3], hh[0], hh[1], hh[2], hh[3]};
                o[d0] = __builtin_amdgcn_mfma_f32_32x32x16_bf16(pa, vf, o[d0], 0, 0, 0);
            }
        }
    LAS float* wsf = (LAS float*)(lds + WS_OFF) + w * 64;
    if (hi == 0) wsf[r32] = ls;
    LDS_WAIT();
    LAS bf16_t* stg = (LAS bf16_t*)(lds + OST_OFF) + w * 2048;
#pragma unroll
    for (int rr = 0; rr < 16; ++rr) {
        const int orow = crow(rr, hi); const float rl = frcp(wsf[orow]);
        stg[orow * 64 + r32] = (bf16_t)f2bf(o[0][rr] * rl); stg[orow * 64 + 32 + r32] = (bf16_t)f2bf(o[1][rr] * rl);
    }
    LDS_WAIT();
#pragma unroll
    for (int i = 0; i < 4; ++i) {
        const int row = i * 8 + (lane >> 3), ch = lane & 7;
        const u32x4 v = *(const LAS u32x4*)(stg + row * 64 + ch * 8);
        const size_t tok = ((size_t)(i0 + 32 * w + row) << dsh) + r;
        *(u32x4*)(O + tok * 512 + h * 64 + ch * 8) = v;
    }
    if (hi == 0) LSE[qtok * 8 + h] = mx + __builtin_amdgcn_logf(ls);
    B.end(bgr);
    LDS_WAIT();
    __syncthreads();
}
}

namespace rg {
constexpr int XC_STRIDE = 1040;
constexpr int XC_BYTES = 64 * XC_STRIDE;
constexpr int NCHUNK = MP / 64;
__device__ __forceinline__ int crow(int r, int hi) { return (r & 3) + 8 * (r >> 2) + 4 * hi; }
__device__ __forceinline__ float expm1_(float x) {
    const float p = x * (1.0f + x * (0.5f + x * (0.16666667f + x * (0.041666668f + x * (0.008333334f + x * 0.0013888889f)))));
    return (x > -0.25f) ? p : (expf(x) - 1.0f);
}
__device__ __forceinline__ void task(LAS unsigned char* lds, const Args& a, int l, int tk) {
    const int tid = pg8::opaque_tid(), lane = tid & 63, r32 = lane & 31, hi = lane >> 5;
    const int w = __builtin_amdgcn_readfirstlane(tid >> 6);
    unsigned char* ws = a.ws;
    const bf16_t* XR = (const bf16_t*)(ws + WS_XR);
    bf16_t* HL = (bf16_t*)(ws + WS_HL); bf16_t* CA = (bf16_t*)(ws + WS_CA);
    const bf16_t* WT = (const bf16_t*)(ws + WS_WGT) + (size_t)l * (2 * 8 * 64 * 64);
    const float* cw = a.in[8] + l * 4 * DR; const float* cbias = a.in[9] + l * DR;
    const float* bga = a.in[11] + l * DR; const float* bgx = a.in[13] + l * DR; const float* sp = (const float*)(ws + WS_SP) + l * DR;
    float* AGGA = (float*)(ws + WS_AGGA) + (size_t)l * NCHUNK * DR; float* AGGH = (float*)(ws + WS_AGGH) + (size_t)l * NCHUNK * DR; float* CARRY = (float*)(ws + WS_CARRY) + (size_t)l * NCHUNK * DR;
    const int tg = tid >> 6, cg = tid & 63;
    const int t0 = tk * 64;
    {
        float cwj[4][8], cbv[8];
#pragma unroll
        for (int j = 0; j < 4; ++j) { const f32x4 x0 = *(const f32x4*)(cw + j * DR + cg * 8), x1 = *(const f32x4*)(cw + j * DR + cg * 8 + 4);
#pragma unroll
            for (int e = 0; e < 4; ++e) { cwj[j][e] = x0[e]; cwj[j][4 + e] = x1[e]; } }
        { const f32x4 x0 = *(const f32x4*)(cbias + cg * 8), x1 = *(const f32x4*)(cbias + cg * 8 + 4);
#pragma unroll
            for (int e = 0; e < 4; ++e) { cbv[e] = x0[e]; cbv[4 + e] = x1[e]; } }
        u32x4 raw[11];
#pragma unroll
        for (int j = 0; j < 11; ++j) { const int t = t0 + 8 * tg - 3 + j; raw[j] = (t >= 0) ? *(const u32x4*)(XR + (size_t)t * 512 + cg * 8) : (u32x4){0u, 0u, 0u, 0u}; }
#pragma unroll
        for (int tt = 0; tt < 8; ++tt) {
            float xc[8];
#pragma unroll
            for (int e = 0; e < 8; ++e) xc[e] = cbv[e];
#pragma unroll
            for (int j = 0; j < 4; ++j) {
                const u32x4 rw = raw[tt + j];
#pragma unroll
                for (int e2 = 0; e2 < 4; ++e2) { const unsigned wv = rw[e2]; xc[2 * e2] += cwj[j][2 * e2] * __builtin_bit_cast(float, wv << 16); xc[2 * e2 + 1] += cwj[j][2 * e2 + 1] * __builtin_bit_cast(float, wv & 0xffff0000u); }
            }
            u32x4 o; o.x = cvtpk(xc[0], xc[1]); o.y = cvtpk(xc[2], xc[3]); o.z = cvtpk(xc[4], xc[5]); o.w = cvtpk(xc[6], xc[7]);
            *(LAS u32x4*)(lds + (8 * tg + tt) * XC_STRIDE + cg * 16) = o;
        }
    }
    LDS_WAIT();
    __syncthreads();
#pragma unroll
    for (int nt = 0; nt < 2; ++nt) {
        const int c = 64 * w + 32 * nt + r32;
        f32x16 ar[2], ab[2];
#pragma unroll
        for (int mt = 0; mt < 2; ++mt) { ar[mt] = (f32x16){0.f, 0.f, 0.f, 0.f, 0.f, 0.f, 0.f, 0.f, 0.f, 0.f, 0.f, 0.f, 0.f, 0.f, 0.f, 0.f}; ab[mt] = ar[mt]; }
#pragma unroll
        for (int ks = 0; ks < 4; ++ks) {
            const bf16x8 ba = *(const bf16x8*)(WT + ((size_t)(0 * 8 + w) * 64 + 32 * nt + r32) * 64 + 16 * ks + 8 * hi);
            const bf16x8 bx = *(const bf16x8*)(WT + ((size_t)(1 * 8 + w) * 64 + 32 * nt + r32) * 64 + 16 * ks + 8 * hi);
#pragma unroll
            for (int mt = 0; mt < 2; ++mt) {
                const bf16x8 af = *(const LAS bf16x8*)(lds + (32 * mt + r32) * XC_STRIDE + (64 * w + 16 * ks + 8 * hi) * 2);
                ar[mt] = __builtin_amdgcn_mfma_f32_32x32x16_bf16(af, ba, ar[mt], 0, 0, 0);
                ab[mt] = __builtin_amdgcn_mfma_f32_32x32x16_bf16(af, bx, ab[mt], 0, 0, 0);
            }
        }
        const float vbga = bga[c] * -1.4426950408889634f, vbgx = bgx[c] * -1.4426950408889634f, vsp2 = sp[c] * (-8.0f * 1.4426950408889634f);
        LAS bf16_t* stg = (LAS bf16_t*)(lds + XC_BYTES) + w * 4096;
        LAS bf16_t* stgw = stg + 4 * hi * 32 + r32;
#pragma unroll
        for (int mt = 0; mt < 2; ++mt)
#pragma unroll
            for (int rr = 0; rr < 16; ++rr) {
                const int tkn = 32 * mt + crow(rr, hi);
                const float xcv = bf2f(*(const LAS bf16_t*)(lds + tkn * XC_STRIDE + c * 2));
                const float rg_ = frcp(1.0f + fexp2(ar[mt][rr] * -1.4426950408889634f + vbga)), ig_ = frcp(1.0f + fexp2(ab[mt][rr] * -1.4426950408889634f + vbgx));
                const float av = fexp2(rg_ * vsp2);
                const float bv = sqrtf(fmaxf(1.0f - av * av, 0.f)) * (ig_ * xcv);
                ar[mt][rr] = av; ab[mt][rr] = bv;
            }
        float GA[8], GH[8];
#pragma unroll
        for (int mt = 0; mt < 2; ++mt)
#pragma unroll
            for (int k = 0; k < 4; ++k) {
                float A = 1.f, H = 0.f;
#pragma unroll
                for (int e = 0; e < 4; ++e) { const float av = ar[mt][4 * k + e], bv = ab[mt][4 * k + e]; H = av * H + bv; A = A * av; ar[mt][4 * k + e] = A; ab[mt][4 * k + e] = H; }
                GA[mt * 4 + k] = A; GH[mt * 4 + k] = H;
            }
        float OA[8], OH[8];
#pragma unroll
        for (int q = 0; q < 8; ++q) { OA[q] = __shfl_xor(GA[q], 32); OH[q] = __shfl_xor(GH[q], 32); }
        float curH = 0.f, curA = 1.f;
#pragma unroll
        for (int mt = 0; mt < 2; ++mt)
#pragma unroll
            for (int k = 0; k < 4; ++k) {
                const int q = mt * 4 + k;
                const float ga0 = hi ? OA[q] : GA[q], gh0 = hi ? OH[q] : GH[q];
                const float ga1 = hi ? GA[q] : OA[q], gh1 = hi ? GH[q] : OH[q];
                const float midH = gh0 + ga0 * curH, midA = curA * ga0;
                const float cinH = hi ? midH : curH, cinA = hi ? midA : curA;
#pragma unroll
                for (int e = 0; e < 4; ++e) {
                    const float Al = ar[mt][4 * k + e], Hl = ab[mt][4 * k + e];
                    const float hv = Hl + Al * cinH, cav = Al * cinA;
                    stgw[(32 * mt + 8 * k + e) * 32] = (bf16_t)f2bf(hv); stgw[2048 + (32 * mt + 8 * k + e) * 32] = (bf16_t)f2bf(cav);
                }
                curH = gh1 + ga1 * midH; curA = midA * ga1;
            }
        if (hi == 0) { AGGA[(size_t)tk * DR + c] = curA; AGGH[(size_t)tk * DR + c] = curH; }
        LDS_WAIT();
#pragma unroll
        for (int i = 0; i < 4; ++i) {
            const int row = i * 16 + (lane >> 2), seg = lane & 3;
            const u32x4 vh = *(const LAS u32x4*)(stg + row * 32 + seg * 8), vc = *(const LAS u32x4*)(stg + 2048 + row * 32 + seg * 8);
            const size_t off = (size_t)(t0 + row) * 512 + 64 * w + 32 * nt + seg * 8;
            *(u32x4*)(HL + off) = vh; *(u32x4*)(CA + off) = vc;
        }
        LDS_WAIT();
    }
    VM_WAIT();
    __syncthreads();
    volatile LAS unsigned* flag = (volatile LAS unsigned*)(lds + MISC_OFF + 64);
    if (tid == 0) {
        __builtin_amdgcn_fence(__ATOMIC_RELEASE, "agent");
        asm volatile("s_waitcnt vmcnt(0)" ::: "memory");
        const unsigned old = __hip_atomic_fetch_add((unsigned*)(ws + WS_CTL) + CW_RG + 64 * l, 1u, __ATOMIC_RELAXED, __HIP_MEMORY_SCOPE_AGENT);
        const unsigned last = (old == (unsigned)(NCHUNK - 1)) ? 1u : 0u;
        if (last) { __builtin_amdgcn_fence(__ATOMIC_ACQUIRE, "agent"); asm volatile("s_waitcnt vmcnt(0)" ::: "memory"); }
        flag[0] = last;
    }
    LDS_WAIT();
    __syncthreads();
    if (flag[0]) {
        const int cq = tid & 127, sg = tid >> 7;
        const f32x4* pa = (const f32x4*)(AGGA + (size_t)(64 * sg) * DR) + cq; const f32x4* ph = (const f32x4*)(AGGH + (size_t)(64 * sg) * DR) + cq;
        f32x4 A = {1.f, 1.f, 1.f, 1.f}, H = {0.f, 0.f, 0.f, 0.f};
        for (int j0 = 0; j0 < 64; j0 += 8) {
            f32x4 va[8], vh[8];
#pragma unroll
            for (int j = 0; j < 8; ++j) { va[j] = pa[(size_t)(j0 + j) * 128]; vh[j] = ph[(size_t)(j0 + j) * 128]; }
#pragma unroll
            for (int j = 0; j < 8; ++j) { H = vh[j] + va[j] * H; A = A * va[j]; }
        }
        LAS f32x4* xa = (LAS f32x4*)lds; LAS f32x4* xh = xa + 512;
        xa[sg * 128 + cq] = A; xh[sg * 128 + cq] = H;
        LDS_WAIT();
        __syncthreads();
        f32x4 h = {0.f, 0.f, 0.f, 0.f};
        for (int s2 = 0; s2 < sg; ++s2) h = xh[s2 * 128 + cq] + xa[s2 * 128 + cq] * h;
        f32x4* pc = (f32x4*)(CARRY + (size_t)(64 * sg) * DR) + cq;
        for (int j0 = 0; j0 < 64; j0 += 8) {
            f32x4 va[8], vh[8];
#pragma unroll
            for (int j = 0; j < 8; ++j) { va[j] = pa[(size_t)(j0 + j) * 128]; vh[j] = ph[(size_t)(j0 + j) * 128]; }
#pragma unroll
            for (int j = 0; j < 8; ++j) { pc[(size_t)(j0 + j) * 128] = h; h = vh[j] + va[j] * h; }
        }
        if (sg == 3) *((f32x4*)(a.out + O_PH + (size_t)l * DR) + cq) = h;
    }
    __syncthreads();
}
}

__device__ __forceinline__ void phase_fin(const Args& a, int l, int wg, int nwg) {
    unsigned char* ws = a.ws;
    const bf16_t* OG = (const bf16_t*)(ws + WS_OG); const float* LSE = (const float*)(ws + WS_LSE);
    const bf16_t* HL = (const bf16_t*)(ws + WS_HL); const bf16_t* CA = (const bf16_t*)(ws + WS_CA); const bf16_t* GY = (const bf16_t*)(ws + WS_GY);
    const float* CARRY = (const float*)(ws + WS_CARRY) + (size_t)l * rg::NCHUNK * DR;
    bf16_t* MIX = (bf16_t*)(ws + WS_MIX);
    const size_t gt = (size_t)wg * 512 + pg8::opaque_tid(), NGT = (size_t)nwg * 512;
    for (size_t it = gt; it < (size_t)MP * 128; it += NGT) {
        const int tok = (int)(it >> 7), grp = (int)(it & 127);
#ifdef DBG_NO_ATT
        if (grp < 64) { *(u32x4*)(MIX + (size_t)tok * DM + grp * 8) = (u32x4){0u, 0u, 0u, 0u}; continue; }
#endif
#ifdef DBG_NO_RNN
        if (grp >= 64) { *(u32x4*)(MIX + (size_t)tok * DM + grp * 8) = (u32x4){0u, 0u, 0u, 0u}; continue; }
#endif
        if (grp < 64) {
            const int h = grp >> 3;
            const float l0 = LSE[(size_t)tok * 8 + h], l1 = LSE[(size_t)MP * 8 + (size_t)tok * 8 + h], l2 = LSE[(size_t)2 * MP * 8 + (size_t)tok * 8 + h];
            const float m = fmaxf(l0, fmaxf(l1, l2));
            float w0 = fexp2(l0 - m), w1 = fexp2(l1 - m), w2 = fexp2(l2 - m);
            const float inv = frcp(w0 + w1 + w2); w0 *= inv; w1 *= inv; w2 *= inv;
            const size_t off = (size_t)tok * 512 + grp * 8;
            const u32x4 o0 = *(const u32x4*)(OG + off), o1 = *(const u32x4*)(OG + (OG_STRIDE / 2) + off), o2 = *(const u32x4*)(OG + 2 * (OG_STRIDE / 2) + off);
            u32x4 r;
#pragma unroll
            for (int e = 0; e < 4; ++e) {
                const float lo = w0 * __builtin_bit_cast(float, o0[e] << 16) + w1 * __builtin_bit_cast(float, o1[e] << 16) + w2 * __builtin_bit_cast(float, o2[e] << 16);
                const float hh = w0 * __builtin_bit_cast(float, o0[e] & 0xffff0000u) + w1 * __builtin_bit_cast(float, o1[e] & 0xffff0000u) + w2 * __builtin_bit_cast(float, o2[e] & 0xffff0000u);
                r[e] = cvtpk(lo, hh);
            }
            *(u32x4*)(MIX + (size_t)tok * DM + grp * 8) = r;
        } else {
            const int cg = grp - 64;
            const size_t off = (size_t)tok * 512 + cg * 8;
            const u32x4 hl = *(const u32x4*)(HL + off), ca = *(const u32x4*)(CA + off), gy = *(const u32x4*)(GY + off);
            const float* cp = CARRY + (size_t)(tok >> 6) * DR + cg * 8;
            const f32x4 c0 = *(const f32x4*)cp, c1 = *(const f32x4*)(cp + 4);
            u32x4 r;
#pragma unroll
            for (int e = 0; e < 4; ++e) {
                const float clo = (e < 2) ? c0[2 * e] : c1[2 * e - 4], chi = (e < 2) ? c0[2 * e + 1] : c1[2 * e - 3];
                const float lo = (__builtin_bit_cast(float, hl[e] << 16) + __builtin_bit_cast(float, ca[e] << 16) * clo) * __builtin_bit_cast(float, gy[e] << 16);
                const float hh = (__builtin_bit_cast(float, hl[e] & 0xffff0000u) + __builtin_bit_cast(float, ca[e] & 0xffff0000u) * chi) * __builtin_bit_cast(float, gy[e] & 0xffff0000u);
                r[e] = cvtpk(lo, hh);
            }
            *(u32x4*)(MIX + (size_t)tok * DM + 512 + cg * 8) = r;
        }
    }
}

__device__ __forceinline__ void dbg_zero_sample_mix(const Args& a, int lo_col, int hi_col) {
    bf16_t* MIX = (bf16_t*)(a.ws + WS_MIX);
    for (size_t i = (size_t)blockIdx.x * 512 + threadIdx.x; i < (size_t)MS * DM; i += (size_t)gridDim.x * 512) { const int c = (int)(i & 1023); if (c >= lo_col && c < hi_col) MIX[(size_t)MP * DM + i] = 0; }
}
namespace sat {
constexpr int NE = 388, NG = 97;
__device__ __forceinline__ const float* row_ptr(const float* cache, const float* fresh, int t, int e) {
    const int ee = e < 387 ? e : 0, g = ee / 129, m = ee - g * 129;
    const int j = WBUF + t - (m << (2 * g));
    return (j >= WBUF) ? (fresh + (size_t)(j - WBUF) * 512) : (cache + (size_t)j * 512);
}
__device__ __forceinline__ void task(LAS unsigned char* lds, const Args& a, int l, int b, int h) {
    const int tid = pg8::opaque_tid(), lane = tid & 63, slot = lane >> 4, d4 = lane & 15;
    const int w = __builtin_amdgcn_readfirstlane(tid >> 6), t = w >> 1, half = w & 1;
    unsigned char* ws = a.ws;
    LAS float* qsh = (LAS float*)lds;
    LAS float* sc = qsh + 256;
    LAS float* sums = sc + 4 * NE;
    LAS float* part = sums + 16;
    if (tid < 256) qsh[tid] = ((const float*)(ws + WS_QS))[(size_t)(b * 4 + (tid >> 6)) * 512 + h * 64 + (tid & 63)] * 0.125f;
    LDS_WAIT();
    __syncthreads();
    const size_t cbase = ((size_t)(l * NB + b) * WBUF) * 512 + h * 64;
    const float* ck = a.in[2] + cbase; const float* cv = a.in[3] + cbase;
    const float* nk = a.out + O_SK + cbase + (size_t)(WBUF - NT) * 512; const float* nv = a.out + O_SV + cbase + (size_t)(WBUF - NT) * 512;
    const f32x4 qv = *(const LAS f32x4*)(qsh + t * 64 + 4 * d4);
    for (int g0 = half; g0 < NG; g0 += 16) {
        f32x4 kv[8];
#pragma unroll
        for (int i = 0; i < 8; ++i) { const int grp = g0 + 2 * i; const int e = 4 * (grp < NG ? grp : 0) + slot; kv[i] = *(const f32x4*)(row_ptr(ck, nk, t, e) + 4 * d4); }
#pragma unroll
        for (int i = 0; i < 8; ++i) {
            const int grp = g0 + 2 * i;
            float s = (kv[i][0] * qv[0] + kv[i][1] * qv[1]) + (kv[i][2] * qv[2] + kv[i][3] * qv[3]);
            s += __shfl_xor(s, 1); s += __shfl_xor(s, 2); s += __shfl_xor(s, 4); s += __shfl_xor(s, 8);
            const int e = 4 * grp + slot;
            if (grp < NG && d4 == 0) sc[t * NE + e] = (e < 387) ? s : -INFINITY;
        }
    }
    LDS_WAIT();
    __syncthreads();
    if (w < 4) {
        float mx = -INFINITY;
        for (int e = lane; e < NE; e += 64) mx = fmaxf(mx, sc[w * NE + e]);
        mx = wave_max(mx);
        float sum = 0.f;
        for (int e = lane; e < NE; e += 64) { const float pe = expf(sc[w * NE + e] - mx); sc[w * NE + e] = pe; sum += pe; }
        sum = wave_sum(sum);
        if (lane == 0) sums[w] = sum;
    }
    LDS_WAIT();
    __syncthreads();
    f32x4 acc = {0.f, 0.f, 0.f, 0.f};
    for (int g0 = half; g0 < NG; g0 += 16) {
        f32x4 vv[8]; float pe[8];
#pragma unroll
        for (int i = 0; i < 8; ++i) { const int grp = g0 + 2 * i; const int e = 4 * (grp < NG ? grp : 0) + slot; vv[i] = *(const f32x4*)(row_ptr(cv, nv, t, e) + 4 * d4); pe[i] = (grp < NG) ? sc[t * NE + e] : 0.f; }
#pragma unroll
        for (int i = 0; i < 8; ++i) acc += vv[i] * pe[i];
    }
#pragma unroll
    for (int c = 0; c < 4; ++c) { acc[c] += __shfl_xor(acc[c], 16); acc[c] += __shfl_xor(acc[c], 32); }
    if (lane < 16) *(LAS f32x4*)(part + w * 64 + 4 * lane) = acc;
    LDS_WAIT();
    __syncthreads();
    if (tid < 256) {
        const int tt = tid >> 6, d = tid & 63;
        const float o = (part[(2 * tt) * 64 + d] + part[(2 * tt + 1) * 64 + d]) / sums[tt];
        ((bf16_t*)(ws + WS_MIX))[(size_t)(MP + b * 4 + tt) * DM + h * 64 + d] = (bf16_t)f2bf(o);
    }
    __syncthreads();
}
}

__device__ __forceinline__ void srglru_task(LAS unsigned char* lds, const Args& a, int l, int b) {
    const int c = pg8::opaque_tid();
    unsigned char* ws = a.ws;
    const float* xrs = (const float*)(ws + WS_XRS) + (size_t)b * 4 * DR;
    const float* sconv = a.in[4] + (size_t)(l * NB + b) * 3 * DR;
    float xp[7];
#pragma unroll
    for (int j = 0; j < 3; ++j) xp[j] = sconv[j * DR + c];
#pragma unroll
    for (int j = 0; j < 4; ++j) xp[3 + j] = xrs[j * DR + c];
    const float* cw = a.in[8] + l * 4 * DR;
    const float w0 = cw[c], w1 = cw[DR + c], w2 = cw[2 * DR + c], w3 = cw[3 * DR + c], cb = a.in[9][l * DR + c];
    float xc[4];
    LAS float* xcs = (LAS float*)lds;
    __syncthreads();
#pragma unroll
    for (int t = 0; t < 4; ++t) { xc[t] = w0 * xp[t] + w1 * xp[t + 1] + w2 * xp[t + 2] + w3 * xp[t + 3] + cb; xcs[t * DR + c] = xc[t]; }
    LDS_WAIT();
    __syncthreads();
    const int n = c >> 6, d = c & 63;
    const float* wa = a.in[10] + (size_t)(l * 8 + n) * 4096 + d; const float* wx = a.in[12] + (size_t)(l * 8 + n) * 4096 + d;
    float pa[4] = {0.f, 0.f, 0.f, 0.f}, px[4] = {0.f, 0.f, 0.f, 0.f};
#pragma unroll 8
    for (int k = 0; k < 64; ++k) {
        const float va = wa[k * 64], vx = wx[k * 64];
#pragma unroll
        for (int t = 0; t < 4; ++t) { const float xv = xcs[t * DR + n * 64 + k]; pa[t] += xv * va; px[t] += xv * vx; }
    }
    const float vbga = a.in[11][l * DR + c], vbgx = a.in[13][l * DR + c], vsp = ((const float*)(ws + WS_SP))[l * DR + c];
    float h = a.in[5][(size_t)(l * NB + b) * DR + c];
    const bf16_t* GY = (const bf16_t*)(ws + WS_GY); bf16_t* MIX = (bf16_t*)(ws + WS_MIX);
#pragma unroll
    for (int t = 0; t < 4; ++t) {
        const float rg_ = 1.0f / (1.0f + expf(-(pa[t] + vbga))), ig_ = 1.0f / (1.0f + expf(-(px[t] + vbgx)));
        const float la = -8.0f * rg_ * vsp;
        const float av = expf(la), bv = sqrtf(-rg::expm1_(2.0f * la)) * (ig_ * xc[t]);
        h = av * h + bv;
        const size_t row = (size_t)MP + b * 4 + t;
        MIX[row * DM + 512 + c] = (bf16_t)f2bf(h * bf2f(GY[row * 512 + c]));
    }
    a.out[O_SH + (size_t)(l * NB + b) * DR + c] = h;
#pragma unroll
    for (int j = 0; j < 3; ++j) a.out[O_SC + ((size_t)(l * NB + b) * 3 + j) * DR + c] = xp[4 + j];
    __syncthreads();
}

__device__ __forceinline__ void phase_final(const Args& a, int wg, int nwg) {
    unsigned char* ws = a.ws;
    const int tid = pg8::opaque_tid(), lane = tid & 63, wave = tid >> 6;
    const int gw = wg * 8 + wave, NGW = nwg * 8;
    const bf16_t* XB = (const bf16_t*)(ws + WS_XBA); const float* ssqp = (const float*)(ws + WS_SSQP + 4 * SSQP_STRIDE);
    const float* gf = a.in[20];
    f32x4 g0[2], g1[2];
#pragma unroll
    for (int j = 0; j < 2; ++j) { g0[j] = *((const f32x4*)gf + 2 * lane + 128 * j); g1[j] = *((const f32x4*)gf + 2 * lane + 128 * j + 1); }
    for (int m = gw; m < MP; m += NGW) {
        const float rs = row_rstd(ssqp, m);
        f32x4* o = (f32x4*)(a.out + O_YP + (size_t)m * DM);
#pragma unroll
        for (int j = 0; j < 2; ++j) {
            const u32x4 xw = *((const u32x4*)(XB + (size_t)m * DM) + lane + 64 * j);
            const f32x4 a0 = {__builtin_bit_cast(float, xw.x << 16), __builtin_bit_cast(float, xw.x & 0xffff0000u), __builtin_bit_cast(float, xw.y << 16), __builtin_bit_cast(float, xw.y & 0xffff0000u)};
            const f32x4 a1 = {__builtin_bit_cast(float, xw.z << 16), __builtin_bit_cast(float, xw.z & 0xffff0000u), __builtin_bit_cast(float, xw.w << 16), __builtin_bit_cast(float, xw.w & 0xffff0000u)};
            o[2 * lane + 128 * j] = a0 * rs * g0[j]; o[2 * lane + 128 * j + 1] = a1 * rs * g1[j];
        }
    }
}
__device__ __forceinline__ void skinny_down(const Args& a, int l) {
    unsigned char* ws = a.ws;
    const int tid = pg8::opaque_tid(), lane = tid & 63, i = lane & 15, kq = lane >> 4;
    const int w = __builtin_amdgcn_readfirstlane(tid >> 6);
    const bf16_t* Hs = (const bf16_t*)(ws + WS_H) + (size_t)MP * DFF;
    const bf16_t* Wt = (const bf16_t*)(ws + WS_W + (size_t)l * W_LAYER + W_FD);
    float* ACC = (float*)(ws + WS_ACC);
    for (int it = blockIdx.x; it < 256; it += gridDim.x) {
        const int ns = it & 31, ks = it >> 5;
        const bf16_t* ap = Hs + (size_t)(16 * w + i) * DFF + ks * 352 + 8 * kq;
        const bf16_t* bp = Wt + (size_t)(32 * ns + i) * DFF + ks * 352 + 8 * kq;
        bf16x8 af[11], b0[11], b1[11];
#pragma unroll
        for (int s = 0; s < 11; ++s) { af[s] = *(const bf16x8*)(ap + 32 * s); b0[s] = *(const bf16x8*)(bp + 32 * s); b1[s] = *(const bf16x8*)(bp + (size_t)16 * DFF + 32 * s); }
        f32x4 c0 = {0.f, 0.f, 0.f, 0.f}, c1 = c0;
#pragma unroll
        for (int s = 0; s < 11; ++s) { c0 = __builtin_amdgcn_mfma_f32_16x16x32_bf16(af[s], b0[s], c0, 0, 0, 0); c1 = __builtin_amdgcn_mfma_f32_16x16x32_bf16(af[s], b1[s], c1, 0, 0, 0); }
        float* o = ACC + (size_t)ks * MS * DM + (size_t)(16 * w + 4 * kq) * DM + 32 * ns + i;
#pragma unroll
        for (int r = 0; r < 4; ++r) { o[(size_t)r * DM] = c0[r]; o[(size_t)r * DM + 16] = c1[r]; }
    }
}
__device__ __forceinline__ void sample_final(const Args& a) {
    unsigned char* ws = a.ws;
    const int tid = pg8::opaque_tid(), lane = tid & 63, wave = tid >> 6;
    const bf16_t* XB = (const bf16_t*)(ws + WS_XBB) + (size_t)MP * DM; const float* ACC = (const float*)(ws + WS_ACC);
    const float* gf = a.in[20];
    for (int s = blockIdx.x * 8 + wave; s < MS; s += gridDim.x * 8) {
        f32x4 v[4]; float ss = 0.f;
#pragma unroll
        for (int j = 0; j < 2; ++j) {
            const u32x4 xw = *((const u32x4*)(XB + (size_t)s * DM) + lane + 64 * j);
            v[2 * j] = (f32x4){__builtin_bit_cast(float, xw.x << 16), __builtin_bit_cast(float, xw.x & 0xffff0000u), __builtin_bit_cast(float, xw.y << 16), __builtin_bit_cast(float, xw.y & 0xffff0000u)};
            v[2 * j + 1] = (f32x4){__builtin_bit_cast(float, xw.z << 16), __builtin_bit_cast(float, xw.z & 0xffff0000u), __builtin_bit_cast(float, xw.w << 16), __builtin_bit_cast(float, xw.w & 0xffff0000u)};
#pragma unroll
            for (int ks = 0; ks < 8; ++ks) { const f32x4* ap = (const f32x4*)(ACC + (size_t)ks * MS * DM + (size_t)s * DM) + 2 * lane + 128 * j; v[2 * j] += ap[0]; v[2 * j + 1] += ap[1]; }
            ss += (v[2 * j].x * v[2 * j].x + v[2 * j].y * v[2 * j].y) + (v[2 * j].z * v[2 * j].z + v[2 * j].w * v[2 * j].w) + (v[2 * j + 1].x * v[2 * j + 1].x + v[2 * j + 1].y * v[2 * j + 1].y) + (v[2 * j + 1].z * v[2 * j + 1].z + v[2 * j + 1].w * v[2 * j + 1].w);
        }
        ss = wave_sum(ss);
        const float rs = 1.0f / sqrtf(ss * (1.0f / DM) + RMS_EPS);
#pragma unroll
        for (int j = 0; j < 2; ++j) { f32x4* o = (f32x4*)(a.out + O_YS + (size_t)s * DM) + 2 * lane + 128 * j; const f32x4* gp = (const f32x4*)gf + 2 * lane + 128 * j; o[0] = v[2 * j] * rs * gp[0]; o[1] = v[2 * j + 1] * rs * gp[1]; }
    }
}

constexpr int N_PHASES = 16;
#ifndef MK_ONE_LAUNCH
#define MK_ONE_LAUNCH 1
#endif

__global__ void __launch_bounds__(512, 2) mk_fwd(Args a_unused) {
    extern __shared__ __attribute__((aligned(16))) unsigned char lds_raw[];
    LAS unsigned char* lds = (LAS unsigned char*)lds_raw;
    { const int tid0 = threadIdx.x; for (int u = tid0; u < (LDS_BYTES - MISC_OFF) / 4; u += 512) ((LAS unsigned*)(lds + MISC_OFF))[u] = 0u; }
    __syncthreads();
#ifndef REPM
#define REPM 0
#endif
#define NREP(b) (((REPM >> (b)) & 1) ? 2 : 1)
#define IN(k) phase_on(k)
#define MAKE_BG(a) const cpy::Bg bg{a.in[2], a.in[3], a.out, (unsigned*)(a.ws + WS_CTL) + cpy::CW_COPYQ, lds}
#if MK_ONE_LAUNCH
    { XcdBarrier b0 = xcd_barrier_post((unsigned*)((unsigned char*)kargs()->ws + WS_CTL) + CW_BAR, (volatile LAS unsigned*)(lds + MISC_OFF + 32)); (void)b0; }
#define SEAM(k) do { if (IN(k) && IN((k) + 1)) { XcdBarrier b_; b_.bar = (unsigned*)((unsigned char*)kargs()->ws + WS_CTL) + CW_BAR; b_.x = xb_xcc_id(); b_.st = (volatile LAS unsigned*)(lds + MISC_OFF + 32); xcd_barrier(b_); } } while (0)
#else
#define SEAM(k) do { } while (0)
#endif
    const int bid = (int)blockIdx.x, G = (int)gridDim.x;

#define S_G1(jj, R) do { pg8::Gemm g{(const bf16_t*)(ws + WS_XBA) + (size_t)MP * DM, (const bf16_t*)(wl + W_IN), 256, DIN, DM}; PanelOrder S{jj, R, DIN / 256}; \
        fill_rstd_table(lds, (const float*)(ws + WS_SSQP + (size_t)(l == 0 ? 0 : 2) * SSQP_STRIDE) + (size_t)MP * 16, S); EpiG1 E{lds, ws, a.out, l, MP, true}; \
        pg8::gemm_phase<EpiG1, PanelOrder, true, true>(lds, g, S, E); } while (0)
#define S_G2(jj, R) do { pg8::Gemm g{(const bf16_t*)(ws + WS_MIX) + (size_t)MP * DM, (const bf16_t*)(wl + W_OUT), 256, DM, DM}; PanelOrder S{jj, R, DM / 256}; \
        EpiRes E{l == 0 ? a.in[0] : nullptr, a.in[1], (const bf16_t*)(ws + WS_XBA), (bf16_t*)(ws + WS_XBB), (float*)(ws + WS_SSQP + (size_t)(l == 0 ? 1 : 3) * SSQP_STRIDE), MP, true}; \
        pg8::gemm_phase<EpiRes, PanelOrder, true, true>(lds, g, S, E); } while (0)
#define S_G3(jj, R) do { pg8::Gemm g{(const bf16_t*)(ws + WS_XBB) + (size_t)MP * DM, (const bf16_t*)(wl + W_GU), 256, NGU, DM}; PanelOrder S{jj, R, NGU / 256}; \
        fill_rstd_table(lds, (const float*)(ws + WS_SSQP + (size_t)(l == 0 ? 1 : 3) * SSQP_STRIDE) + (size_t)MP * 16, S); EpiG3 E{lds, (bf16_t*)(ws + WS_H), MP, true}; \
        pg8::gemm_phase<EpiG3, PanelOrder, true, true>(lds, g, S, E); } while (0)
#define S_G4(jj, R, LL) do { unsigned char* wl4_ = ws + WS_W + (size_t)(LL) * W_LAYER; pg8::Gemm g{(const bf16_t*)(ws + WS_H) + (size_t)MP * DFF, (const bf16_t*)(wl4_ + W_FD), 256, DM, DFF}; PanelOrder S{jj, R, DM / 256}; \
        EpiRes E{nullptr, nullptr, (const bf16_t*)(ws + WS_XBB), (bf16_t*)(ws + WS_XBA), (float*)(ws + WS_SSQP + (size_t)((LL) == 0 ? 2 : 4) * SSQP_STRIDE), MP, true}; \
        pg8::gemm_phase<EpiRes, PanelOrder, true, true>(lds, g, S, E); } while (0)

    if (IN(0)) for (int rep_ = 0; rep_ < NREP(0); ++rep_) { LOAD_ARGS(a); MAKE_BG(a); bg.init(); phase_prologue(a, lds); SEAM(0); }
#ifdef DBG_EXTRA_BARRIERS
    for (int eb_ = 0; eb_ < DBG_EXTRA_BARRIERS; ++eb_) { SEAM(0); }
#endif

    for (int l = 0; l < NLAYER; ++l) {
        const int pb = 1 + 6 * l;
        if (IN(pb)) for (int rep_ = 0; rep_ < NREP(1); ++rep_) {
            LOAD_ARGS(a); MAKE_BG(a); unsigned char* ws = a.ws; unsigned char* wl = ws + WS_W + (size_t)l * W_LAYER;
            const int jr = (bid >= G - 8) ? bid - (G - 8) : -1;
            if (bid < G - 8) {
                pg8::Gemm g{(const bf16_t*)(ws + WS_XBA), (const bf16_t*)(wl + W_IN), MP, DIN, DM}; pg8::StaticOrder S; S.init(MP, DIN, G - 8, bid);
                fill_rstd_table(lds, (const float*)(ws + WS_SSQP + (size_t)(l == 0 ? 0 : 2) * SSQP_STRIDE), S);
                EpiG1 E{lds, ws, a.out, l, 0, false};
                pg8::gemm_phase<EpiG1, pg8::StaticOrder, true, true>(lds, g, S, E);
            }
            if (l == 0) { S_G1(jr, 8); }
            if (l == 1) { S_G4(jr, 8, 0); }
            SEAM(pb);
        }
        if (IN(pb + 1)) for (int rep_ = 0; rep_ < NREP(2); ++rep_) {
            LOAD_ARGS(a); MAKE_BG(a); unsigned char* ws = a.ws; unsigned char* wl = ws + WS_W + (size_t)l * W_LAYER;
            const int R = (l == 0) ? 0 : 10, Gp = G - R;
            if (bid < Gp) {
                for (int r2_ = 0; r2_ < NREP(8); ++r2_) for (int t = bid; t < rg::NCHUNK; t += Gp) rg::task(lds, a, l, t);
                if (l == 0 && bid >= 64 && bid < 64 + NB) srglru_task(lds, a, l, bid - 64);
                __syncthreads();
                for (int r2_ = 0; r2_ < NREP(10); ++r2_) for (int u = bid; u < 1536; u += Gp) {
                    const int g = u >> 9, rem = u & 511, h = rem & 7, rj = rem >> 3;
                    const int dsh = 2 * g, bpc = 64 >> dsh, r = rj / bpc, jb = rj % bpc;
                    att::unit(lds, (const bf16_t*)(ws + WS_Q), (const bf16_t*)(ws + WS_K), (const bf16_t*)(ws + WS_V),
                              (bf16_t*)(ws + WS_OG + (size_t)g * OG_STRIDE), (float*)(ws + WS_LSE) + (size_t)g * MP * 8, dsh, r, jb, h, bg);
                }
                __syncthreads();
                if (l == 0) for (int r2_ = 0; r2_ < NREP(11); ++r2_) for (int t = bid; t < NB * NH; t += Gp) sat::task(lds, a, l, t >> 3, t & 7);
            }
            if (l == 1) { S_G1(bid >= Gp ? bid - Gp : -1, 10); }
            SEAM(pb + 1);
        }
        if (IN(pb + 2)) for (int rep_ = 0; rep_ < NREP(3); ++rep_) {
            LOAD_ARGS(a); MAKE_BG(a); unsigned char* ws = a.ws; unsigned char* wl = ws + WS_W + (size_t)l * W_LAYER;
            const int R = (l == 0) ? 4 : 0, Gp = G - R;
            if (bid < Gp) {
                if (l == 1) { if (bid < NB) srglru_task(lds, a, l, bid); __syncthreads(); for (int t = bid; t < NB * NH; t += Gp) sat::task(lds, a, l, t >> 3, t & 7); }
                phase_fin(a, l, bid, Gp);
            }
            if (l == 0) { S_G2(bid >= Gp ? bid - Gp : -1, 4); }
            SEAM(pb + 2);
        }
        if (IN(pb + 3)) for (int rep_ = 0; rep_ < NREP(4); ++rep_) {
            LOAD_ARGS(a); MAKE_BG(a); unsigned char* ws = a.ws; unsigned char* wl = ws + WS_W + (size_t)l * W_LAYER;
            pg8::Gemm g{(const bf16_t*)(ws + WS_MIX), (const bf16_t*)(wl + W_OUT), MP, DM, DM}; pg8::StaticOrder S; S.init(MP, DM, G, bid);
            EpiRes E{l == 0 ? a.in[0] : nullptr, a.in[1], (const bf16_t*)(ws + WS_XBA), (bf16_t*)(ws + WS_XBB), (float*)(ws + WS_SSQP + (size_t)(l == 0 ? 1 : 3) * SSQP_STRIDE), 0, false};
            pg8::gemm_phase<EpiRes, pg8::StaticOrder, true, true>(lds, g, S, E);
            SEAM(pb + 3);
        }
        if (IN(pb + 4)) for (int rep_ = 0; rep_ < NREP(5); ++rep_) {
            LOAD_ARGS(a); MAKE_BG(a); unsigned char* ws = a.ws; unsigned char* wl = ws + WS_W + (size_t)l * W_LAYER;
            const int jr = (bid >= G - 8) ? bid - (G - 8) : -1;
            if (bid < G - 8) {
                pg8::Gemm g{(const bf16_t*)(ws + WS_XBB), (const bf16_t*)(wl + W_GU), MP, NGU, DM}; pg8::StaticOrder S; S.init(MP, NGU, G - 8, bid);
                fill_rstd_table(lds, (const float*)(ws + WS_SSQP + (size_t)(l == 0 ? 1 : 3) * SSQP_STRIDE), S);
                EpiG3 E{lds, (bf16_t*)(ws + WS_H), 0, false};
                pg8::gemm_phase<EpiG3, pg8::StaticOrder, true, true>(lds, g, S, E);
            }
            if (l == 0) { S_G3(jr, 8); }
            if (l == 1) { S_G2(jr, 8); }
            SEAM(pb + 4);
        }
        if (IN(pb + 5)) for (int rep_ = 0; rep_ < NREP(6); ++rep_) {
            LOAD_ARGS(a); MAKE_BG(a); unsigned char* ws = a.ws; unsigned char* wl = ws + WS_W + (size_t)l * W_LAYER;
            pg8::Gemm g{(const bf16_t*)(ws + WS_H), (const bf16_t*)(wl + W_FD), MP, DM, DFF}; pg8::StaticOrder S; S.init(MP, DM, G, bid);
            EpiRes E{nullptr, nullptr, (const bf16_t*)(ws + WS_XBB), (bf16_t*)(ws + WS_XBA), (float*)(ws + WS_SSQP + (size_t)(l == 0 ? 2 : 4) * SSQP_STRIDE), 0, false};
            pg8::gemm_phase<EpiRes, pg8::StaticOrder, true, true>(lds, g, S, E);
            SEAM(pb + 5);
        }
    }
    if (IN(13)) {
        LOAD_ARGS(a); MAKE_BG(a); unsigned char* ws = a.ws; const int l = 1; unsigned char* wl = ws + WS_W + (size_t)l * W_LAYER;
        if (bid < G - 22) phase_final(a, bid, G - 22);
        { S_G3(bid >= G - 22 ? bid - (G - 22) : -1, 22); }
        SEAM(13);
    }
    if (IN(14)) { LOAD_ARGS(a); skinny_down(a, 1); SEAM(14); }
    if (IN(15)) { LOAD_ARGS(a); MAKE_BG(a); sample_final(a); bg.drain(); }
#undef IN
#undef SEAM
}

extern "C" void kernel_launch(void* const* d_in, const int* in_sizes, int n_in, void* d_out, int out_size, void* d_ws, size_t ws_size, hipStream_t stream) {
    static int grid = 0;
    if (grid == 0) {
        if (n_in != 21 || (size_t)out_size != O_END || ws_size < WS_END) { fprintf(stderr, "kernel_launch: unexpected shapes (n_in %d, out %d, ws %zu); nothing launched\n", n_in, out_size, ws_size); grid = -1; return; }
        int dev = 0, cus = 0, per_cu = 0;
        if (hipGetDevice(&dev) != hipSuccess || hipDeviceGetAttribute(&cus, hipDeviceAttributeMultiprocessorCount, dev) != hipSuccess) { grid = -1; return; }
        if (hipFuncSetAttribute((const void*)mk_fwd, hipFuncAttributeMaxDynamicSharedMemorySize, LDS_BYTES) != hipSuccess) { fprintf(stderr, "kernel_launch: hipFuncSetAttribute failed\n"); grid = -1; return; }
        if (hipOccupancyMaxActiveBlocksPerMultiprocessor(&per_cu, (const void*)mk_fwd, 512, LDS_BYTES) != hipSuccess || per_cu < 1) { fprintf(stderr, "kernel_launch: occupancy query says %d blocks per CU\n", per_cu); }
        (void)hipGetLastError();
        grid = cus;
    }
    if (grid < 0) return;
    hipMemsetAsync((char*)d_ws + WS_CTL, 0, CTL_ZERO_BYTES, stream);
    Args a{};
    for (int i = 0; i < 21; ++i) a.in[i] = (const float*)d_in[i];
    a.out = (float*)d_out; a.ws = (unsigned char*)d_ws;
#if MK_ONE_LAUNCH
    a.ph_lo = 0; a.ph_hi = N_PHASES;
    hipLaunchKernelGGL(mk_fwd, dim3(grid), dim3(512), LDS_BYTES, stream, a);
#else
    for (int p = 0; p < N_PHASES; ++p) { a.ph_lo = p; a.ph_hi = p + 1; hipLaunchKernelGGL(mk_fwd, dim3(grid), dim3(512), LDS_BYTES, stream, a); }
#endif
}
```

```cpp
#define MK_ONE_LAUNCH 1
#include <hip/hip_runtime.h>
#include <cstdio>
#include <cstdint>

namespace pg8 {
#define PG8_LAS __attribute__((address_space(3)))
typedef unsigned short bf16_t;
typedef short bf16x8 __attribute__((ext_vector_type(8)));
typedef float f32x4 __attribute__((ext_vector_type(4)));
typedef unsigned u32x4 __attribute__((ext_vector_type(4)));
constexpr int BM = 256, BK = 64, HALF = 128, HTB = HALF * BK * 2  , STAGE_BYTES = 8 * HTB, NXCD = 8, WGM = 8;

__host__ __device__ __forceinline__ int lds_byte(int r, int c) { const int st = (r >> 4) * 2 + (c >> 5), rr = r & 15, cc = c & 31, ob = rr * 64 + cc * 2; return st * 1024 + (ob ^ (((ob >> 9) & 1) << 5)); }
__host__ __device__ __forceinline__ void stage_rc(int b, int& R, int& C) { const int st = b / 1024, sb = b % 1024, swz = sb ^ (((sb >> 9) & 1) << 5); R = (st >> 1) * 16 + swz / 64; C = (st & 1) * 32 + (swz % 64) / 2; }
__host__ __device__ __forceinline__ int perm32(int rho) { const int n = rho >> 4, i = rho & 15; return 8 * (i >> 2) + 4 * n + (i & 3); }

struct Unit { int pm, pn; };
struct Gemm { const bf16_t* A; const bf16_t* Bt; int M, N, K; };

struct StaticOrder {
    int nM, nN, nwg, G, c;
    __host__ __device__ void init(int M, int N, int G_, int c_) { nM = M / BM; nN = N / BM; nwg = nM * nN; G = G_; c = c_; }
    __host__ __device__ bool next(int i, Unit& u) const {
        const long L = (long)i * G + c; if (L >= nwg) return false;
        int wgid = (int)L; { const int q = nwg / NXCD, r = nwg % NXCD, xcd = wgid % NXCD, off = wgid / NXCD; wgid = (xcd < r ? xcd * (q + 1) : r * (q + 1) + (xcd - r) * q) + off; }
        const int nig = WGM * nN, gid = wgid / nig, fm = gid * WGM, gsz = (nM - fm) < WGM ? (nM - fm) : WGM;
        u.pm = fm + ((wgid % nig) % gsz); u.pn = (wgid % nig) / gsz; return true;
    }
    __device__ __forceinline__ void a_ready(const Unit&) const {}
    __device__ __forceinline__ void done(const Unit&) const {}
};

__device__ __forceinline__ int opaque_tid() { int t = threadIdx.x; asm volatile("" : "+v"(t)); return t; }
__device__ __forceinline__ unsigned cvt_pk_bf16(float lo, float hi) { unsigned r; asm volatile("v_cvt_pk_bf16_f32 %0, %1, %2" : "=v"(r) : "v"(lo), "v"(hi)); return r; }

struct NoBg { struct Regs {}; __device__ __forceinline__ void begin(Regs&) const {} __device__ __forceinline__ void end(Regs&) const {} };
template <class Epi, class Sched, bool ALIGN_EPI = false, bool SP2 = false, class Bg = NoBg>
__device__ __forceinline__ void gemm_phase(PG8_LAS unsigned char* lds, const Gemm g, const Sched& S, const Epi& E, const Bg& B = Bg()) {
    const int tid = opaque_tid(), wid = __builtin_amdgcn_readfirstlane(tid >> 6), lane = tid & 63, wr = wid >> 2, wc = wid & 3, fr = lane & 15, fq = lane >> 4;
    const int K = g.K, nt = K / BK;
    unsigned voffA[2], voffB[2];
#pragma unroll
    for (int i = 0; i < 2; ++i) { int R, C; stage_rc(tid * 16 + i * 8192, R, C); const int Rb = Epi::PERM ? ((R & ~31) + perm32(R & 31)) : R;
        voffA[i] = (unsigned)(R * K + C) * 2u; voffB[i] = (unsigned)(Rb * K + C) * 2u; }
    const unsigned kstep = (unsigned)(BK * 2);
    const unsigned hstep = (unsigned)HALF * K * 2;
    const unsigned tstep = 2 * hstep;
    const __amdgpu_buffer_rsrc_t rsA = __builtin_amdgcn_make_buffer_rsrc((void*)g.A, 0, (int)((unsigned)g.M * (unsigned)K * 2u), 0x00020000);
    const __amdgpu_buffer_rsrc_t rsB = __builtin_amdgcn_make_buffer_rsrc((void*)g.Bt, 0, (int)((unsigned)g.N * (unsigned)K * 2u), 0x00020000);
    const unsigned ldsw = (unsigned)wid * 1024u;
    const int aoff = lds_byte(wr * 64 + fr, fq * 8), boff = lds_byte(wc * 32 + fr, fq * 8);
#define PG8_SA(b, h) (((b) * 2 + (h)) * HTB)
#define PG8_SB(b, h) ((4 + (b) * 2 + (h)) * HTB)
#define PG8_STAGE(bufoff, gbase, voff) do { _Pragma("unroll") for (int _i = 0; _i < 2; ++_i) \
        __builtin_amdgcn_raw_ptr_buffer_load_lds(PG8_RSRC_##voff, (PG8_LAS void*)(lds + (bufoff) + ldsw + _i * 8192), 16, (int)(voff)[_i], (int)(gbase), 0, 0); } while (0)
#define PG8_RSRC_voffA rsA
#define PG8_RSRC_voffB rsB
#define PG8_LDA(dst, b, h) do { _Pragma("unroll") for (int m = 0; m < 4; ++m) _Pragma("unroll") for (int k = 0; k < 2; ++k) dst[m][k] = *(const PG8_LAS bf16x8*)(lds + PG8_SA(b, h) + aoff + m * 2048 + k * 1024); } while (0)
#define PG8_LDB(dst, b, h) do { _Pragma("unroll") for (int n = 0; n < 2; ++n) _Pragma("unroll") for (int k = 0; k < 2; ++k) dst[n][k] = *(const PG8_LAS bf16x8*)(lds + PG8_SB(b, h) + boff + n * 2048 + k * 1024); } while (0)
#define PG8_MMA(ai, bj, At, Bt) do { __builtin_amdgcn_s_setprio(1); _Pragma("unroll") for (int m = 0; m < 4; ++m) _Pragma("unroll") for (int n = 0; n < 2; ++n) _Pragma("unroll") for (int k = 0; k < 2; ++k) \
        acc[ai][bj][m][n] = __builtin_amdgcn_mfma_f32_16x16x32_bf16(Bt[n][k], At[m][k], acc[ai][bj][m][n], 0, 0, 0); __builtin_amdgcn_s_setprio(0); } while (0)
#define PG8_WAIT_V(n) asm volatile("s_waitcnt vmcnt(" #n ")" ::: "memory")
#define PG8_WAIT_L(n) asm volatile("s_waitcnt lgkmcnt(" #n ")" ::: "memory")
#define PG8_BAR __builtin_amdgcn_s_barrier()
#define PG8_SCHED __builtin_amdgcn_sched_barrier(0)
    Unit cur, nxt; int ui = 0;
    if (!S.next(0, cur)) return;
    f32x4 acc[2][2][4][2];
#pragma unroll
    for (int a = 0; a < 2; ++a)
#pragma unroll
        for (int b = 0; b < 2; ++b)
#pragma unroll
            for (int m = 0; m < 4; ++m)
#pragma unroll
                for (int n = 0; n < 2; ++n) acc[a][b][m][n] = (f32x4){0.f, 0.f, 0.f, 0.f};
    bf16x8 At[4][2], B0[2][2], B1[2][2];
    unsigned cA = (unsigned)cur.pm * tstep, cB = (unsigned)cur.pn * tstep;
    S.a_ready(cur);
    if constexpr (SP2) {
        PG8_STAGE(PG8_SB(0, 0), cB, voffB); PG8_STAGE(PG8_SB(0, 1), cB + hstep, voffB); PG8_STAGE(PG8_SA(0, 0), cA, voffA); PG8_STAGE(PG8_SA(0, 1), cA + hstep, voffA);
        if (wr == 1) PG8_BAR;
        PG8_WAIT_V(2); PG8_BAR;
        PG8_STAGE(PG8_SB(1, 0), cB + kstep, voffB); PG8_STAGE(PG8_SA(1, 0), cA + kstep, voffA); PG8_STAGE(PG8_SB(1, 1), cB + hstep + kstep, voffB);
        PG8_WAIT_V(6); PG8_BAR;
    } else {
        PG8_STAGE(PG8_SB(0, 0), cB, voffB); PG8_STAGE(PG8_SA(0, 0), cA, voffA); PG8_STAGE(PG8_SB(0, 1), cB + hstep, voffB); PG8_STAGE(PG8_SA(0, 1), cA + hstep, voffA);
        if (wr == 1) PG8_BAR;
        PG8_WAIT_V(4); PG8_BAR;
        PG8_STAGE(PG8_SB(1, 0), cB + kstep, voffB); PG8_STAGE(PG8_SA(1, 0), cA + kstep, voffA); PG8_STAGE(PG8_SB(1, 1), cB + hstep + kstep, voffB);
        PG8_WAIT_V(6); PG8_BAR;
    }
    for (;;) {
        const bool has_next = S.next(ui + 1, nxt);
        const unsigned nA = has_next ? (unsigned)nxt.pm * tstep : cA, nB = has_next ? (unsigned)nxt.pn * tstep : cB;
        for (int t = 0; t < nt; t += 2) {
            const bool last = (t == nt - 2);
            const unsigned a1 = cA + (unsigned)(t + 1) * kstep;
            const unsigned a2 = last ? nA : cA + (unsigned)(t + 2) * kstep, b2 = last ? nB : cB + (unsigned)(t + 2) * kstep;
            const unsigned a3 = a2 + kstep, b3 = b2 + kstep;
            if (last && has_next) S.a_ready(nxt);
            if constexpr (SP2) {
            PG8_LDB(B0, 0, 0); PG8_LDB(B1, 0, 1); PG8_SCHED; PG8_LDA(At, 0, 0); PG8_STAGE(PG8_SA(1, 1), a1 + hstep, voffA);
            PG8_WAIT_V(8); PG8_WAIT_L(0); PG8_BAR; PG8_MMA(0, 0, At, B0); PG8_MMA(0, 1, At, B1); PG8_BAR; PG8_SCHED;
            PG8_LDA(At, 0, 1); PG8_STAGE(PG8_SB(0, 0), b2, voffB); PG8_STAGE(PG8_SB(0, 1), b2 + hstep, voffB); PG8_STAGE(PG8_SA(0, 0), a2, voffA);
            PG8_WAIT_V(8); PG8_WAIT_L(0); PG8_BAR; PG8_MMA(1, 0, At, B0); PG8_MMA(1, 1, At, B1); PG8_BAR; PG8_SCHED;
            PG8_LDB(B0, 1, 0); PG8_LDB(B1, 1, 1); PG8_SCHED; PG8_LDA(At, 1, 0); PG8_STAGE(PG8_SA(0, 1), a2 + hstep, voffA);
            PG8_WAIT_V(8); PG8_WAIT_L(0); PG8_BAR; PG8_MMA(0, 0, At, B0); PG8_MMA(0, 1, At, B1); PG8_BAR; PG8_SCHED;
            PG8_LDA(At, 1, 1); PG8_STAGE(PG8_SB(1, 0), b3, voffB); PG8_STAGE(PG8_SB(1, 1), b3 + hstep, voffB); PG8_STAGE(PG8_SA(1, 0), a3, voffA);
            PG8_WAIT_V(8); PG8_WAIT_L(0); PG8_BAR; PG8_MMA(1, 0, At, B0); PG8_MMA(1, 1, At, B1); PG8_BAR; PG8_SCHED;
            } else {
            PG8_LDB(B0, 0, 0); PG8_SCHED; PG8_LDA(At, 0, 0); PG8_STAGE(PG8_SA(1, 1), a1 + hstep, voffA);
            PG8_WAIT_L(8); PG8_BAR; PG8_WAIT_L(0); PG8_MMA(0, 0, At, B0); PG8_BAR; PG8_SCHED;
            PG8_LDB(B1, 0, 1); PG8_STAGE(PG8_SB(0, 0), b2, voffB);
            PG8_BAR; PG8_WAIT_L(0); PG8_MMA(0, 1, At, B1); PG8_BAR;
            PG8_LDA(At, 0, 1); PG8_STAGE(PG8_SA(0, 0), a2, voffA);
            PG8_BAR; PG8_WAIT_L(0); PG8_MMA(1, 0, At, B0); PG8_BAR; PG8_SCHED;
            PG8_STAGE(PG8_SB(0, 1), b2 + hstep, voffB);
            PG8_WAIT_V(6); PG8_BAR; PG8_MMA(1, 1, At, B1); PG8_BAR;
            PG8_LDB(B0, 1, 0); PG8_SCHED; PG8_LDA(At, 1, 0); PG8_STAGE(PG8_SA(0, 1), a2 + hstep, voffA);
            PG8_WAIT_L(8); PG8_BAR; PG8_WAIT_L(0); PG8_MMA(0, 0, At, B0); PG8_BAR; PG8_SCHED;
            PG8_LDB(B1, 1, 1); PG8_STAGE(PG8_SB(1, 0), b3, voffB);
            PG8_BAR; PG8_WAIT_L(0); PG8_MMA(0, 1, At, B1); PG8_BAR;
            PG8_LDA(At, 1, 1); PG8_STAGE(PG8_SA(1, 0), a3, voffA);
            PG8_BAR; PG8_WAIT_L(0); PG8_MMA(1, 0, At, B0); PG8_BAR; PG8_SCHED;
            PG8_STAGE(PG8_SB(1, 1), b3 + hstep, voffB);
            PG8_WAIT_V(6); PG8_BAR; PG8_MMA(1, 1, At, B1); PG8_BAR;
            }
        }
        if constexpr (ALIGN_EPI) { if (wr == 0) PG8_BAR; }
        if constexpr (!Epi::AFTER_DRAIN) { typename Bg::Regs bgr; E(acc, cur, wr, wc, fr, fq, ui, B, bgr); B.end(bgr); S.done(cur); }
        if (!has_next) break;
#pragma unroll
        for (int a = 0; a < 2; ++a)
#pragma unroll
            for (int b = 0; b < 2; ++b)
#pragma unroll
                for (int m = 0; m < 4; ++m)
#pragma unroll
                    for (int n = 0; n < 2; ++n) acc[a][b][m][n] = (f32x4){0.f, 0.f, 0.f, 0.f};
        cur = nxt; cA = nA; cB = nB; ++ui;
        if constexpr (ALIGN_EPI) { if (wr == 1) PG8_BAR; }
    }
    PG8_WAIT_V(0);
    if constexpr (!ALIGN_EPI) { if (wr == 0) PG8_BAR; }
    PG8_BAR;
#undef PG8_SA
#undef PG8_SB
#undef PG8_STAGE
#undef PG8_RSRC_voffA
#undef PG8_RSRC_voffB
#undef PG8_LDA
#undef PG8_LDB
#undef PG8_MMA
#undef PG8_WAIT_V
#undef PG8_WAIT_L
#undef PG8_BAR
#undef PG8_SCHED
}
}

#define LAS __attribute__((address_space(3)))
#define GAS __attribute__((address_space(1)))
typedef unsigned short bf16_t;
typedef short bf16x8 __attribute__((ext_vector_type(8)));
typedef short s16x4 __attribute__((ext_vector_type(4)));
typedef float f32x4 __attribute__((ext_vector_type(4)));
typedef float f32x16 __attribute__((ext_vector_type(16)));
typedef unsigned u32x4 __attribute__((ext_vector_type(4)));
typedef unsigned u32x2 __attribute__((ext_vector_type(2)));

constexpr int MP = 16384;
constexpr int MS = 128;
constexpr int MROWS = MP + MS;
constexpr int MTOT = 16640;
constexpr int DM = 1024, DIN = 2560, DA = 512, DR = 512, DFF = 2816, NGU = 2 * DFF;
constexpr int NH = 8, HD = 64, WBUF = 2048, NB = 32, NT = 4, NLAYER = 2;
constexpr int ROPE_ROWS = MP + NT;
constexpr float RMS_EPS = 1e-6f;
constexpr float QSCALE = 0.18033688011112042f;

constexpr size_t O_YP = 0, O_YS = 16777216, O_PK = 16908288, O_PV = 19005440, O_PC = 21102592, O_PH = 21105664,
                 O_SK = 21106688, O_SV = 88215552, O_SC = 155324416, O_SH = 155422720, O_END = 155455488;

constexpr size_t MiB = 1u << 20;
constexpr size_t WS_CTL = 0, CTL_ZERO_BYTES = 1 * MiB;
constexpr size_t WS_ROPE = 1 * MiB;
constexpr size_t WS_WGT = 3 * MiB;
constexpr size_t WS_SP = WS_WGT + 512 * 1024;
constexpr size_t WS_W = 5 * MiB, W_LAYER = 24 * MiB;
constexpr size_t W_IN = 0, W_OUT = 5242880, W_GU = 7340032, W_FD = 18874368;
constexpr size_t WS_SSQP = 53 * MiB, SSQP_STRIDE = 1114112;
constexpr size_t WS_QS = 59 * MiB;
constexpr size_t WS_XRS = WS_QS + 512 * 1024;
constexpr size_t WS_LSE = 60 * MiB;
constexpr size_t WS_XBA = 62 * MiB;
constexpr size_t WS_XBB = 95 * MiB;
constexpr size_t WS_X = 128 * MiB;
constexpr size_t WS_Q = 193 * MiB, WS_K = 210 * MiB, WS_V = 227 * MiB, WS_XR = 244 * MiB, WS_GY = 261 * MiB, WS_HL = 278 * MiB, WS_CA = 295 * MiB;
constexpr size_t WS_OG = 312 * MiB, OG_STRIDE = 16 * MiB;
constexpr size_t WS_MIX = 360 * MiB;
constexpr size_t WS_H = 393 * MiB;
constexpr size_t WS_AGGA = 483 * MiB, WS_AGGH = 484 * MiB, WS_CARRY = 485 * MiB;
constexpr size_t WS_ACC = 486 * MiB;
constexpr size_t WS_XP = 491 * MiB;
constexpr size_t WS_END = 556 * MiB;

constexpr int CW_BAR = 4096;
constexpr int CW_RG = 16384;

constexpr int LDS_BYTES = 155648;
constexpr int MISC_OFF = 150 * 1024;

struct Args { const float* in[21]; float* out; unsigned char* ws; int ph_lo, ph_hi; };
typedef const volatile __attribute__((address_space(4))) Args* KArgsPtr;
__device__ __forceinline__ KArgsPtr kargs() { return (KArgsPtr)__builtin_amdgcn_kernarg_segment_ptr(); }
#define LOAD_ARGS(a) Args a; { KArgsPtr k_ = kargs(); _Pragma("unroll") for (int i_ = 0; i_ < 21; ++i_) a.in[i_] = (const float*)k_->in[i_]; a.out = (float*)k_->out; a.ws = (unsigned char*)k_->ws; a.ph_lo = 0; a.ph_hi = 0; }
__device__ __forceinline__ bool phase_on(int k) { KArgsPtr k_ = kargs(); const int lo = k_->ph_lo, hi = k_->ph_hi; return lo <= k && k < hi; }

__device__ __forceinline__ unsigned f2bf(float f) { unsigned u = __builtin_bit_cast(unsigned, f); return (u + 0x7fffu + ((u >> 16) & 1u)) >> 16; }
__device__ __forceinline__ unsigned pk2(float lo, float hi) { return f2bf(lo) | (f2bf(hi) << 16); }
__device__ __forceinline__ float bf2f(unsigned short b) { return __builtin_bit_cast(float, (unsigned)b << 16); }
__device__ __forceinline__ unsigned cvtpk(float lo, float hi) { return pg8::cvt_pk_bf16(lo, hi); }
__device__ __forceinline__ float fexp2(float x) { return __builtin_amdgcn_exp2f(x); }
__device__ __forceinline__ float frcp(float x) { return __builtin_amdgcn_rcpf(x); }
__device__ __forceinline__ float sigmoidf_(float x) { return frcp(1.0f + fexp2(-1.4426950408889634f * x)); }
__device__ __forceinline__ float gelu_tanh(float x) {
    const float u = x * (1.0f + 0.044715f * x * x);
    return x * frcp(1.0f + fexp2(-2.3022081565f * u));
}
#define LDS_WAIT() asm volatile("s_waitcnt lgkmcnt(0)" ::: "memory")
#define VM_WAIT() asm volatile("s_waitcnt vmcnt(0)" ::: "memory")

using pg8::Unit;
__device__ __forceinline__ float row_rstd(const float* ssqp, int row) {
    const f32x4* p = (const f32x4*)(ssqp + (size_t)row * 16);
    const f32x4 a = p[0], b = p[1], c = p[2], d = p[3];
    const f32x4 s = (a + b) + (c + d);
    const float ss = (s[0] + s[1]) + (s[2] + s[3]);
    return 1.0f / sqrtf(ss * (1.0f / DM) + RMS_EPS);
}

constexpr int RSTD_OFF = 131072, RSTD_MAX_UNITS = 8;
template <class Sched>
__device__ __forceinline__ void fill_rstd_table(LAS unsigned char* lds, const float* ssqp  , const Sched& S) {
    const int tid = pg8::opaque_tid();
    Unit u;
    for (int i = 0; i < RSTD_MAX_UNITS && S.next(i, u); ++i) {
        const int row = u.pm * 256 + (tid >> 1);
        const f32x4* p = (const f32x4*)(ssqp + (size_t)row * 16) + (tid & 1) * 2;
        const f32x4 s = p[0] + p[1];
        float ss = (s[0] + s[1]) + (s[2] + s[3]);
        ss += __shfl_xor(ss, 1);
        if ((tid & 1) == 0) ((LAS float*)(lds + RSTD_OFF))[i * 256 + (tid >> 1)] = 1.0f / sqrtf(ss * (1.0f / DM) + RMS_EPS);
    }
    LDS_WAIT();
    __syncthreads();
}

struct PanelOrder {
    int j, R, nN;
    __device__ __forceinline__ bool next(int i, Unit& u) const { const int id = j + i * R; if (j < 0 || id >= nN) return false; u.pm = 0; u.pn = id; return true; }
    __device__ __forceinline__ void a_ready(const Unit&) const {}
    __device__ __forceinline__ void done(const Unit&) const {}
};

struct EpiG1 {
    static constexpr bool PERM = true, AFTER_DRAIN = false;
    LAS unsigned char* lds; unsigned char* ws; float* out; int l; int row0; bool samp;
    template <class Bg> __device__ __forceinline__ void operator()(const f32x4 (&acc)[2][2][4][2], const Unit& u, int wr, int wc, int fr, int fq, int ui, const Bg& B, typename Bg::Regs& bgr) const {
        const int sect = u.pn >> 1;
        const LAS float* rtab = (const LAS float*)(lds + RSTD_OFF) + ui * 256;
        const bool dorope = (sect <= 1) && ((wc & 1) == 0);
        const bool rl = dorope && (fq < 2);
        const int cbase = (u.pn & 1) * 256 + wc * 32;
        const int ca0 = cbase + (rl ? 4 * fq : 8 * fq), ca1 = cbase + (rl ? 8 + 4 * fq : 8 * fq + 4);
        const float* rope = (const float*)(ws + WS_ROPE) + 4 * (fq & 1);
        bf16_t* bdst = (bf16_t*)(ws + (sect == 0 ? WS_Q : sect == 1 ? WS_K : sect == 2 ? WS_V : sect == 3 ? WS_XR : WS_GY));
        float* pdst = out + (sect == 1 ? O_PK + (size_t)l * WBUF * 512 : sect == 2 ? O_PV + (size_t)l * WBUF * 512 : O_PC + (size_t)l * 3 * 512);
        const int prow0 = (sect == 3) ? (MP - 3) : (MP - WBUF);
        const bool has_p = (sect >= 1 && sect <= 3);
        float* sdst = (sect == 0) ? (float*)(ws + WS_QS) : (sect == 3) ? (float*)(ws + WS_XRS) : out + (sect == 1 ? O_SK : O_SV) + (size_t)l * NB * WBUF * 512;
        const float qs_ = (sect == 0) ? QSCALE : 1.0f;
#pragma unroll
        for (int ai = 0; ai < 2; ++ai) {
            if (ai == 1) { asm volatile("" ::: "memory"); B.begin(bgr); }
            if (samp && ai == 1) continue;
#pragma unroll
            for (int m = 0; m < 4; ++m) {
                const int rloc = ai * 128 + wr * 64 + m * 16 + fr, row = row0 + u.pm * 256 + rloc;
                const float rs = rtab[rloc];
                f32x4 cs = {1.f, 1.f, 1.f, 1.f}, sn = {0.f, 0.f, 0.f, 0.f};
                if (dorope) {
                    const int pos = samp ? (MP + (row & 3)) : row;
                    const float* rp = rope + (size_t)pos * 16;
                    cs = *(const f32x4*)rp; sn = *(const f32x4*)(rp + 8);
                }
#pragma unroll
                for (int bj = 0; bj < 2; ++bj) {
                    f32x4 v0 = acc[ai][bj][m][0] * rs, v1 = acc[ai][bj][m][1] * rs;
                    if (rl) { const f32x4 x1 = v0, x2 = v1; v0 = x1 * cs - x2 * sn; v1 = x2 * cs + x1 * sn; }
                    if (sect == 4) {
#pragma unroll
                        for (int e = 0; e < 4; ++e) { v0[e] = gelu_tanh(v0[e]); v1[e] = gelu_tanh(v1[e]); }
                    }
                    if (!samp || sect == 4) {
                        u32x2 w0, w1; w0.x = cvtpk(v0[0] * qs_, v0[1] * qs_); w0.y = cvtpk(v0[2] * qs_, v0[3] * qs_); w1.x = cvtpk(v1[0] * qs_, v1[1] * qs_); w1.y = cvtpk(v1[2] * qs_, v1[3] * qs_);
                        bf16_t* bp = bdst + (size_t)row * 512 + 128 * bj;
                        if (dorope) { *(u32x2*)(bp + ca0) = w0; *(u32x2*)(bp + ca1) = w1; }
                        else { *(u32x4*)(bp + ca0) = (u32x4){w0.x, w0.y, w1.x, w1.y}; }
                        if (has_p && row >= prow0) { float* o = pdst + (size_t)(row - prow0) * 512 + 128 * bj; *(f32x4*)(o + ca0) = v0; *(f32x4*)(o + ca1) = v1; }
                    } else {
                        const int s = row - MP;
                        const size_t srow = (sect == 1 || sect == 2) ? ((size_t)(s >> 2) * WBUF + (WBUF - NT) + (s & 3)) : (size_t)s;
                        float* o = sdst + srow * 512 + 128 * bj; *(f32x4*)(o + ca0) = v0; *(f32x4*)(o + ca1) = v1;
                    }
                }
                if (m & 1) asm volatile("" ::: "memory");
            }
        }
    }
};

struct EpiRes {
    static constexpr bool PERM = true, AFTER_DRAIN = false;
    const float* xin_p; const float* xin_s;
    const bf16_t* XBin; bf16_t* XBout; float* ssqp_out; int row0; bool samp;
    template <class Bg> __device__ __forceinline__ void operator()(const f32x4 (&acc)[2][2][4][2], const Unit& u, int wr, int wc, int fr, int fq, int ui, const Bg& B, typename Bg::Regs& bgr) const {
        const int cb = u.pn * 256 + wc * 32 + 8 * fq;
#pragma unroll
        for (int ai = 0; ai < 2; ++ai) {
            if (ai == 1) { asm volatile("" ::: "memory"); B.begin(bgr); }
            if (samp && ai == 1) continue;
#pragma unroll
            for (int m = 0; m < 4; ++m) {
                const int row = row0 + u.pm * 256 + ai * 128 + wr * 64 + m * 16 + fr;
                float ss = 0.f;
#pragma unroll
                for (int bj = 0; bj < 2; ++bj) {
                    const int c0 = cb + 128 * bj;
                    f32x4 a0, a1;
                    if (xin_p) { const float* xr_ = samp ? (xin_s + (size_t)(row - MP) * DM) : (xin_p + (size_t)row * DM); a0 = *(const f32x4*)(xr_ + c0); a1 = *(const f32x4*)(xr_ + c0 + 4); }
                    else { const u32x4 xw = *(const u32x4*)(XBin + (size_t)row * DM + c0);
                        a0 = (f32x4){__builtin_bit_cast(float, xw.x << 16), __builtin_bit_cast(float, xw.x & 0xffff0000u), __builtin_bit_cast(float, xw.y << 16), __builtin_bit_cast(float, xw.y & 0xffff0000u)};
                        a1 = (f32x4){__builtin_bit_cast(float, xw.z << 16), __builtin_bit_cast(float, xw.z & 0xffff0000u), __builtin_bit_cast(float, xw.w << 16), __builtin_bit_cast(float, xw.w & 0xffff0000u)}; }
                    const f32x4 v0 = acc[ai][bj][m][0] + a0, v1 = acc[ai][bj][m][1] + a1;
                    u32x4 w; w.x = cvtpk(v0[0], v0[1]); w.y = cvtpk(v0[2], v0[3]); w.z = cvtpk(v1[0], v1[1]); w.w = cvtpk(v1[2], v1[3]);
                    *(u32x4*)(XBout + (size_t)row * DM + c0) = w;
                    ss += (v0[0] * v0[0] + v0[1] * v0[1]) + (v0[2] * v0[2] + v0[3] * v0[3]) + (v1[0] * v1[0] + v1[1] * v1[1]) + (v1[2] * v1[2] + v1[3] * v1[3]);
                }
                ss += __shfl_xor(ss, 16); ss += __shfl_xor(ss, 32);
                if (fq == 0) ssqp_out[(size_t)row * 16 + u.pn * 4 + wc] = ss;
                if (m & 1) asm volatile("" ::: "memory");
            }
        }
    }
};

struct EpiG3 {
    static constexpr bool PERM = true, AFTER_DRAIN = false;
    LAS unsigned char* lds; bf16_t* H; int row0; bool samp;
    template <class Bg> __device__ __forceinline__ void operator()(const f32x4 (&acc)[2][2][4][2], const Unit& u, int wr, int wc, int fr, int fq, int ui, const Bg& B, typename Bg::Regs& bgr) const {
        const int c0 = u.pn * 128 + wc * 32 + 8 * fq;
        const LAS float* rtab = (const LAS float*)(lds + RSTD_OFF) + ui * 256;
#pragma unroll
        for (int ai = 0; ai < 2; ++ai) {
            if (ai == 1) { asm volatile("" ::: "memory"); B.begin(bgr); }
            if (samp && ai == 1) continue;
#pragma unroll
            for (int m = 0; m < 4; ++m) {
                const int row = row0 + u.pm * 256 + ai * 128 + wr * 64 + m * 16 + fr;
                const float rs = rtab[ai * 128 + wr * 64 + m * 16 + fr];
                float hv[8];
#pragma unroll
                for (int n = 0; n < 2; ++n)
#pragma unroll
                    for (int e = 0; e < 4; ++e) { const float g = acc[ai][0][m][n][e] * rs, up = acc[ai][1][m][n][e] * rs; hv[4 * n + e] = g * up * sigmoidf_(g); }
                u32x4 w; w.x = cvtpk(hv[0], hv[1]); w.y = cvtpk(hv[2], hv[3]); w.z = cvtpk(hv[4], hv[5]); w.w = cvtpk(hv[6], hv[7]);
                *(u32x4*)(H + (size_t)row * DFF + c0) = w;
                asm volatile("" ::: "memory");
            }
        }
    }
};

#define XB_TMO      128
#define XB_XCNT(j)  (256  + 64 * (j))
#define XB_XSUB(j)  (1280 + 64 * (j))
#define XB_XGEN(j)  (2304 + 64 * (j))
#define XB_TOP      3328
#define XB_TOPGEN   3392
#define XCD_BAR_WORDS 3456
#define XB_SPIN_CAP (1u << 18)
__device__ __forceinline__ unsigned xb_ld(unsigned* p)              { return __hip_atomic_load(p, __ATOMIC_RELAXED, __HIP_MEMORY_SCOPE_AGENT); }
__device__ __forceinline__ unsigned xb_add(unsigned* p, unsigned v) { return __hip_atomic_fetch_add(p, v, __ATOMIC_RELAXED, __HIP_MEMORY_SCOPE_AGENT); }
__device__ __forceinline__ unsigned xb_xcc_id() { return (unsigned)__builtin_amdgcn_s_getreg((3 << 11) | 20) & 0xFu; }
#define XB_SPIN(cond, bar) do { unsigned _sp = 0; while (cond) { __builtin_amdgcn_s_sleep(1); \
    if ((++_sp & 255u) == 0u) { if (xb_ld(&(bar)[XB_TMO])) break; if (_sp > XB_SPIN_CAP) { atomicAdd(&(bar)[XB_TMO], 1u); break; } } } } while (0)
struct XcdBarrier { unsigned* bar; unsigned x; volatile LAS unsigned* st; };
__device__ __forceinline__ XcdBarrier xcd_barrier_post(unsigned* bar, volatile LAS unsigned* st) {
    XcdBarrier b; b.bar = bar; b.x = xb_xcc_id(); b.st = st;
    if (threadIdx.x == 0) (void)xb_add(&bar[XB_XCNT(b.x)], 1u);
    return b;
}
__device__ __forceinline__ void xcd_barrier_complete(unsigned* bar, unsigned x, unsigned& nloc, unsigned& nx) {
    const unsigned G = gridDim.x * gridDim.y * gridDim.z;
    unsigned sum, cnt, mine, sp = 0u;
    for (;;) {
        sum = 0u; cnt = 0u; mine = 0u;
#pragma unroll
        for (unsigned j = 0; j < 16; ++j) { const unsigned c = xb_ld(&bar[XB_XCNT(j)]); sum += c; cnt += (c > 0u) ? 1u : 0u; mine = (j == x) ? c : mine; }
        if (sum == G) break;
        __builtin_amdgcn_s_sleep(1);
        if ((++sp & 255u) == 0u) { if (xb_ld(&bar[XB_TMO])) break; if (sp > XB_SPIN_CAP) { atomicAdd(&bar[XB_TMO], 1u); break; } }
    }
    nloc = mine > 0u ? mine : 1u; nx = cnt > 0u ? cnt : 1u;
}
__device__ __forceinline__ void xcd_barrier(const XcdBarrier& b) {
    asm volatile("s_waitcnt vmcnt(0)" ::: "memory");
    __syncthreads();
    if (threadIdx.x == 0) {
        unsigned* bar = b.bar;
        __builtin_amdgcn_s_waitcnt(0);
        unsigned nloc = b.st[0], nx = b.st[1];
        if (nloc == 0u) { xcd_barrier_complete(bar, b.x, nloc, nx); b.st[0] = nloc; b.st[1] = nx; }
        const unsigned old = xb_add(&bar[XB_XSUB(b.x)], 1u);
        const unsigned gen = old / nloc;
        if (old + 1u == (gen + 1u) * nloc) {
            __builtin_amdgcn_fence(__ATOMIC_RELEASE, "agent");
            asm volatile("s_waitcnt vmcnt(0)" ::: "memory");
            const unsigned og = xb_add(&bar[XB_TOP], 1u);
            const unsigned tg = og / nx;
            if (og + 1u == (tg + 1u) * nx) xb_add(&bar[XB_TOPGEN], 1u);
            else XB_SPIN(xb_ld(&bar[XB_TOPGEN]) == tg, bar);
            __builtin_amdgcn_fence(__ATOMIC_ACQUIRE, "agent");
            xb_add(&bar[XB_XGEN(b.x)], 1u);
            asm volatile("s_waitcnt vmcnt(0)" ::: "memory");
        } else {
            XB_SPIN(xb_ld(&bar[XB_XGEN(b.x)]) == gen, bar);
            __builtin_amdgcn_fence(__ATOMIC_ACQUIRE, "agent");
            asm volatile("s_waitcnt vmcnt(0)" ::: "memory");
        }
    }
    __syncthreads();
}

__device__ __forceinline__ float wave_sum(float v) {
#pragma unroll
    for (int o = 1; o < 64; o <<= 1) v += __shfl_xor(v, o);
    return v;
}
__device__ __forceinline__ float wave_max(float v) {
#pragma unroll
    for (int o = 1; o < 64; o <<= 1) v = fmaxf(v, __shfl_xor(v, o));
    return v;
}
__device__ __forceinline__ void transpose_item(const float* W, int K, int N, bf16_t* WT, int item, const float* g, int rowmode, LAS float* scr, int lane) {
    const int nblk = N / 32, kb = item / nblk, nb = item % nblk, k0 = 64 * kb, n0 = 32 * nb;
    {
        f32x4 v[8]; float gk[8];
#pragma unroll
        for (int i = 0; i < 8; ++i) { const int kk = (lane >> 3) + 8 * i; v[i] = *(const f32x4*)(W + (size_t)(k0 + kk) * N + n0 + 4 * (lane & 7)); gk[i] = g ? g[k0 + kk] : 1.0f; }
#pragma unroll
        for (int i = 0; i < 8; ++i) { const int kk = (lane >> 3) + 8 * i; LAS float* d = scr + kk * 33 + 4 * (lane & 7); d[0] = v[i][0] * gk[i]; d[1] = v[i][1] * gk[i]; d[2] = v[i][2] * gk[i]; d[3] = v[i][3] * gk[i]; }
    }
    LDS_WAIT(); asm volatile("" ::: "memory");
    const int c = lane & 7;
#pragma unroll
    for (int j = 0; j < 4; ++j) { const int n = (lane >> 3) + 8 * j; const LAS float* s = scr + (8 * c) * 33 + n;
        u32x4 o; o.x = pk2(s[0 * 33], s[1 * 33]); o.y = pk2(s[2 * 33], s[3 * 33]); o.z = pk2(s[4 * 33], s[5 * 33]); o.w = pk2(s[6 * 33], s[7 * 33]);
        const int nn = n0 + n; int row;
        if (rowmode == 0) row = nn;
        else if (rowmode == 3) { const int d = nn & 63; row = (nn < 1024 && d < 16) ? ((nn & ~15) + 8 * ((d >> 2) & 1) + 4 * (d >> 3) + (d & 3)) : nn; }
        else row = 256 * (nn >> 7) + (nn & 127) + (rowmode == 2 ? 128 : 0);
        *(u32x4*)(WT + (size_t)row * K + k0 + 8 * c) = o; }
    LDS_WAIT(); asm volatile("" ::: "memory");
}
__device__ __forceinline__ void xrow_to_bf16(const float* xrow, bf16_t* orow, float* ssq16, int lane) {
    f32x4 v[4]; float s = 0.f;
    if (xrow) {
        const f32x4* xr = (const f32x4*)xrow + lane;
#pragma unroll
        for (int j = 0; j < 4; ++j) { v[j] = xr[64 * j]; s += (v[j].x * v[j].x + v[j].y * v[j].y) + (v[j].z * v[j].z + v[j].w * v[j].w); }
    } else {
#pragma unroll
        for (int j = 0; j < 4; ++j) v[j] = (f32x4){0.f, 0.f, 0.f, 0.f};
    }
    s = wave_sum(s);
    unsigned long long* o8 = (unsigned long long*)orow + lane;
#pragma unroll
    for (int j = 0; j < 4; ++j) o8[64 * j] = (unsigned long long)pk2(v[j].x, v[j].y) | ((unsigned long long)pk2(v[j].z, v[j].w) << 32);
    if (lane < 16) ssq16[lane] = (lane == 0) ? s : 0.f;
}
__device__ __forceinline__ void sincos_d(double x, float& c, float& s) {
    const double k = __builtin_rint(x * 0.6366197723675814);
    double r = __builtin_fma(-k, 1.5707963267948966, x); r = __builtin_fma(-k, 6.123233995736766e-17, r);
    const int q = ((int)k) & 3;
    const double r2 = r * r;
    double sp = -7.6471637318198164759e-13; sp = sp * r2 + 1.6059043836821614599e-10; sp = sp * r2 - 2.5052108385441718775e-08; sp = sp * r2 + 2.7557319223985890653e-06;
    sp = sp * r2 - 1.9841269841269841270e-04; sp = sp * r2 + 8.3333333333333333333e-03; sp = sp * r2 - 1.6666666666666666667e-01; const double sn = r + r * r2 * sp;
    double cp = 4.7794773323873852974e-14; cp = cp * r2 - 1.1470745597729724714e-11; cp = cp * r2 + 2.0876756987868098979e-09; cp = cp * r2 - 2.7557319223985890653e-07;
    cp = cp * r2 + 2.4801587301587301587e-05; cp = cp * r2 - 1.3888888888888888889e-03; cp = cp * r2 + 4.1666666666666666667e-02; cp = cp * r2 - 0.5; const double cn = 1.0 + r2 * cp;
    const double sv = (q == 0) ? sn : (q == 1) ? cn : (q == 2) ? -sn : -cn;
    const double cv = (q == 0) ? cn : (q == 1) ? -sn : (q == 2) ? -cn : sn;
    c = (float)cv; s = (float)sv;
}

constexpr int WCV_I_IN = (DM / 64) * (DIN / 32), WCV_I_OUT = (DM / 64) * (DM / 32), WCV_I_F = (DM / 64) * (DFF / 32), WCV_I_D = (DFF / 64) * (DM / 32);
constexpr int WCV_I_LAYER = WCV_I_IN + WCV_I_OUT + 2 * WCV_I_F + WCV_I_D, WCV_TOTAL = NLAYER * WCV_I_LAYER, WCV_FIRST = WCV_I_LAYER;
__device__ __forceinline__ void weight_convert_items(const Args& a, LAS float* scr, int it0, int it1, int gw, int ngw, int lane) {
    unsigned char* ws = a.ws;
    for (int it = it0 + gw; it < it1; it += ngw) {
        const int l = it / WCV_I_LAYER; int r = it % WCV_I_LAYER;
        unsigned char* wl = ws + WS_W + (size_t)l * W_LAYER;
        if (r < WCV_I_IN) { transpose_item(a.in[7] + (size_t)l * DM * DIN, DM, DIN, (bf16_t*)(wl + W_IN), r, a.in[6] + l * DM, 3, scr, lane); continue; } r -= WCV_I_IN;
        if (r < WCV_I_OUT) { transpose_item(a.in[15] + (size_t)l * DM * DM, DM, DM, (bf16_t*)(wl + W_OUT), r, nullptr, 0, scr, lane); continue; } r -= WCV_I_OUT;
        if (r < WCV_I_F) { transpose_item(a.in[17] + (size_t)l * DM * DFF, DM, DFF, (bf16_t*)(wl + W_GU), r, a.in[16] + l * DM, 1, scr, lane); continue; } r -= WCV_I_F;
        if (r < WCV_I_F) { transpose_item(a.in[18] + (size_t)l * DM * DFF, DM, DFF, (bf16_t*)(wl + W_GU), r, a.in[16] + l * DM, 2, scr, lane); continue; } r -= WCV_I_F;
        transpose_item(a.in[19] + (size_t)l * DFF * DM, DFF, DM, (bf16_t*)(wl + W_FD), r, nullptr, 0, scr, lane);
    }
}
__device__ __forceinline__ void phase_prologue(const Args& a, LAS unsigned char* lds) {
    const int tid = pg8::opaque_tid(), lane = tid & 63, wave = __builtin_amdgcn_readfirstlane(tid >> 6);
    const int G = gridDim.x, gw = blockIdx.x * 8 + wave, NGW = G * 8;
    LAS float* scr = (LAS float*)(lds + wave * 16384);
    unsigned char* ws = a.ws;
    weight_convert_items(a, scr, 0, WCV_FIRST, gw, NGW, lane);
    {
        bf16_t* XBA = (bf16_t*)(ws + WS_XBA); float* ssq0 = (float*)(ws + WS_SSQP);
        for (int m = gw; m < MTOT; m += NGW) {
            const float* xr = (m < MP) ? (a.in[0] + (size_t)m * DM) : (m < MROWS) ? (a.in[1] + (size_t)(m - MP) * DM) : nullptr;
            xrow_to_bf16(xr, XBA + (size_t)m * DM, ssq0 + (size_t)m * 16, lane);
        }
    }
    const int gt = blockIdx.x * 512 + tid, NGT = G * 512;
    {
        float* rope = (float*)(ws + WS_ROPE);
        for (int e = gt; e < ROPE_ROWS * 8; e += NGT) {
            const int pos = e >> 3, i = e & 7;
            const double inv = (i == 0) ? 1.0 : (i == 1) ? 0.19392274474868576 : (i == 2) ? 0.03760603093086393 : (i == 3) ? 0.007292664737217109 :
                               (i == 4) ? 0.001414213562373095 : (i == 5) ? 0.0002742481756762073 : (i == 6) ? 5.318295896944988e-05 : 1.031338537721246e-05;
            float c, s; sincos_d((double)pos * inv, c, s);
            rope[(size_t)pos * 16 + i] = c; rope[(size_t)pos * 16 + 8 + i] = s;
        }
    }
    {
        bf16_t* wgt = (bf16_t*)(ws + WS_WGT);
        for (int e = gt; e < NLAYER * 2 * 8 * 64 * 64; e += NGT) {
            const int c = e & 63, d = (e >> 6) & 63, n = (e >> 12) & 7, gate = (e >> 15) & 1, l = e >> 16;
            const float* src = a.in[gate ? 12 : 10] + (size_t)((l * 8 + n) * 64 + c) * 64 + d;
            wgt[e] = (bf16_t)f2bf(*src);
        }
        float* sp = (float*)(ws + WS_SP);
        for (int e = gt; e < NLAYER * DR; e += NGT) { const float lam = a.in[14][e]; const float y = expf(-lam); sp[e] = (y < 0.03f) ? y * (1.0f - y * (0.5f - y * (0.33333333f - y * (0.25f - 0.2f * y)))) : logf(1.0f + y); }
    }
}

namespace cpy {
constexpr unsigned CPB = (unsigned)(WBUF - NT) * 2048u / 8192u;
constexpr unsigned NPIECE = 2u * NLAYER * NB * CPB;
constexpr unsigned NCHUNKS = NPIECE / 2u;
static_assert((WBUF - NT) * 2048 % 8192 == 0 && NPIECE % 2 == 0, "copy chunking");
#ifndef CPQ_G1A
#define CPQ_G1A 8u
#endif
#ifndef CPQ_G1B
#define CPQ_G1B 20u
#endif
#ifndef CPQ_G3
#define CPQ_G3 24u
#endif
constexpr unsigned BG_G1_WGS = 32, BG_G3_WGS = 8;
constexpr unsigned Q_G1A = CPQ_G1A, Q_G1B = CPQ_G1B, Q_G3 = CPQ_G3;
constexpr unsigned C1 = BG_G1_WGS * 8u * Q_G1A, C2 = C1 + BG_G3_WGS * 8u * Q_G3, C3 = C2 + BG_G1_WGS * 8u * Q_G1B, PIGGY0 = C3 + BG_G3_WGS * 8u * Q_G3;
static_assert(PIGGY0 <= NCHUNKS, "copy quotas");
constexpr int CW_COPYQ = 20480;
constexpr int LDS_NEXT = MISC_OFF + 128;
struct Bg {
    const float* ck; const float* cv; float* out; unsigned* q; LAS unsigned char* lds;
    struct Regs { f32x4 v[16]; unsigned id, nxt; };
    __device__ __forceinline__ void addr(unsigned p, const char*& src, char*& dst) const {
        const unsigned t = p / (NLAYER * NB * CPB), r = p - t * (NLAYER * NB * CPB), blk = r / CPB, k = r - blk * CPB;
        src = (const char*)(t ? cv : ck) + (size_t)blk * (WBUF * 2048u) + NT * 2048u + (size_t)k * 8192u;
        dst = (char*)(out + (t ? O_SV : O_SK)) + (size_t)blk * (WBUF * 2048u) + (size_t)k * 8192u;
    }
    __device__ __forceinline__ void init() const {}
    __device__ __forceinline__ void begin(Regs& r) const {
        const int tid = pg8::opaque_tid(), lane = tid & 63, w = __builtin_amdgcn_readfirstlane(tid >> 6);
        const unsigned k = (unsigned)__builtin_amdgcn_readfirstlane(((volatile LAS unsigned*)(lds + LDS_NEXT))[w]);
        r.id = PIGGY0 + (blockIdx.x * 8u + (unsigned)w) + k * (gridDim.x * 8u); r.nxt = k + 1u;
        if (r.id < NCHUNKS) {
#pragma unroll
            for (int h = 0; h < 2; ++h) { const char* s; char* d; addr(2u * r.id + h, s, d);
#pragma unroll
                for (int i = 0; i < 8; ++i) r.v[8 * h + i] = __builtin_nontemporal_load((const f32x4*)(s + i * 1024) + lane); }
        }
    }
    __device__ __forceinline__ void end(Regs& r) const {
        const int tid = pg8::opaque_tid(), lane = tid & 63, w = __builtin_amdgcn_readfirstlane(tid >> 6);
        if (r.id < NCHUNKS) {
#pragma unroll
            for (int h = 0; h < 2; ++h) { const char* s; char* d; addr(2u * r.id + h, s, d);
#pragma unroll
                for (int i = 0; i < 8; ++i) __builtin_nontemporal_store(r.v[8 * h + i], (f32x4*)(d + i * 1024) + lane); }
            if (lane == 0) ((LAS unsigned*)(lds + LDS_NEXT))[w] = r.nxt;
        }
    }
    __device__ __forceinline__ void stream(unsigned c0, unsigned n) const {
        const int lane = pg8::opaque_tid() & 63;
        for (unsigned c = c0; c < c0 + n && c < NCHUNKS; c += 2) {
            const bool two = (c + 1 < c0 + n) && (c + 1 < NCHUNKS);
            f32x4 va[16], vb[16];
#pragma unroll
            for (int h = 0; h < 2; ++h) { const char* s; char* d; addr(2u * c + h, s, d);
#pragma unroll
                for (int i = 0; i < 8; ++i) va[8 * h + i] = __builtin_nontemporal_load((const f32x4*)(s + i * 1024) + lane); }
            if (two) {
#pragma unroll
                for (int h = 0; h < 2; ++h) { const char* s; char* d; addr(2u * (c + 1) + h, s, d);
#pragma unroll
                    for (int i = 0; i < 8; ++i) vb[8 * h + i] = __builtin_nontemporal_load((const f32x4*)(s + i * 1024) + lane); }
            }
#pragma unroll
            for (int h = 0; h < 2; ++h) { const char* s; char* d; addr(2u * c + h, s, d);
#pragma unroll
                for (int i = 0; i < 8; ++i) __builtin_nontemporal_store(va[8 * h + i], (f32x4*)(d + i * 1024) + lane); }
            if (two) {
#pragma unroll
                for (int h = 0; h < 2; ++h) { const char* s; char* d; addr(2u * (c + 1) + h, s, d);
#pragma unroll
                    for (int i = 0; i < 8; ++i) __builtin_nontemporal_store(vb[8 * h + i], (f32x4*)(d + i * 1024) + lane); }
            }
        }
    }
    __device__ __forceinline__ void drain() const {
        Regs r;
        for (;;) { begin(r); if (r.id >= NCHUNKS) break; end(r); LDS_WAIT(); }
    }
};
}

namespace att {
constexpr int KCH = 6144;
constexpr int K_OFF = 0, V_OFF = 8 * KCH, VHALF = 384 * 64, WS_OFF = V_OFF + 2 * VHALF, OST_OFF = WS_OFF + 8 * 256, LDS_END = OST_OFF + 8 * 4096;
static_assert(LDS_END <= MISC_OFF, "attention LDS map");
typedef short v4i16_t __attribute__((ext_vector_type(4)));
__device__ __forceinline__ s16x4 vtr(const LAS unsigned char* p) { return __builtin_bit_cast(s16x4, __builtin_amdgcn_ds_read_tr16_b64_v4i16((LAS v4i16_t*)p)); }
__device__ __forceinline__ int crow(int r, int hi) { return (r & 3) + 8 * (r >> 2) + 4 * hi; }

template <class Bg> __device__ __forceinline__ void unit(LAS unsigned char* lds, const bf16_t* Q, const bf16_t* K, const bf16_t* V, bf16_t* O, float* LSE, int dsh, int r, int jb, int h, const Bg& B) {
    const int tid = pg8::opaque_tid(), lane = tid & 63, r32 = lane & 31, hi = lane >> 5;
    const int w = __builtin_amdgcn_readfirstlane(tid >> 6);
    const int i0 = jb * 256, kb = i0 - 128;
#pragma unroll
    for (int t = 0; t < 6; ++t) {
        int idx = kb + 64 * t + lane; idx = idx < 0 ? 0 : idx;
        const size_t tok = ((size_t)idx << dsh) + r;
        __builtin_amdgcn_global_load_lds((const unsigned*)(K + tok * 512 + h * 64 + w * 8), (LAS unsigned*)(lds + K_OFF + w * KCH + t * 1024), 16, 0, 0);
    }
#pragma unroll
    for (int t = 0; t < 6; ++t) {
        const int p = w * 6 + t, dh = p / 24, rg = p % 24;
        int idx = kb + 16 * rg + (lane >> 2); idx = idx < 0 ? 0 : idx;
        const size_t tok = ((size_t)idx << dsh) + r;
        __builtin_amdgcn_global_load_lds((const unsigned*)(V + tok * 512 + h * 64 + dh * 32 + (lane & 3) * 8), (LAS unsigned*)(lds + V_OFF + dh * VHALF + rg * 1024), 16, 0, 0);
    }
    const size_t qtok = ((size_t)(i0 + 32 * w + r32) << dsh) + r;
    bf16x8 qr[4];
#pragma unroll
    for (int d0 = 0; d0 < 4; ++d0) qr[d0] = *(const bf16x8*)(Q + qtok * 512 + h * 64 + d0 * 16 + hi * 8);
    VM_WAIT();
    __syncthreads();
    typename Bg::Regs bgr; B.begin(bgr);
    f32x16 p[5];
#pragma unroll
    for (int s = 0; s < 5; ++s) {
        const LAS unsigned char* kp = lds + K_OFF + hi * KCH + (32 * (w + s) + r32) * 16;
        f32x16 acc = {0.f, 0.f, 0.f, 0.f, 0.f, 0.f, 0.f, 0.f, 0.f, 0.f, 0.f, 0.f, 0.f, 0.f, 0.f, 0.f};
#pragma unroll
        for (int d0 = 0; d0 < 4; ++d0) { const bf16x8 kf = *(const LAS bf16x8*)(kp + d0 * 2 * KCH); acc = __builtin_amdgcn_mfma_f32_32x32x16_bf16(kf, qr[d0], acc, 0, 0, 0); }
        p[s] = acc;
    }
    const float NEG = -INFINITY;
#pragma unroll
    for (int rr = 0; rr < 16; ++rr) { const int kk = crow(rr, hi); if (kk < r32) p[0][rr] = NEG; if (kk > r32) p[4][rr] = NEG; }
    if (jb == 0) {
#pragma unroll
        for (int s = 0; s < 4; ++s) if (w + s <= 3) {
#pragma unroll
            for (int rr = 0; rr < 16; ++rr) p[s][rr] = NEG; }
    }
    float mx = p[4][0];
#pragma unroll
    for (int s = 0; s < 5; ++s)
#pragma unroll
        for (int rr = 0; rr < 16; ++rr) mx = fmaxf(mx, p[s][rr]);
    mx = fmaxf(mx, __shfl_xor(mx, 32));
    float ls = 0.f;
#pragma unroll
    for (int s = 0; s < 5; ++s)
#pragma unroll
        for (int rr = 0; rr < 16; ++rr) { const float e = fexp2(p[s][rr] - mx); p[s][rr] = e; ls += e; }
    ls += __shfl_xor(ls, 32);
    f32x16 o[2];
    o[0] = (f32x16){0.f, 0.f, 0.f, 0.f, 0.f, 0.f, 0.f, 0.f, 0.f, 0.f, 0.f, 0.f, 0.f, 0.f, 0.f, 0.f}; o[1] = o[0];
    const LAS unsigned char* vb = lds + V_OFF + ((lane >> 4) & 1) * 32 + (lane & 3) * 8 + (4 * hi + ((lane & 15) >> 2)) * 64;
#pragma unroll
    for (int s = 0; s < 5; ++s)
#pragma unroll
        for (int ks = 0; ks < 2; ++ks) {
            u32x4 pw; pw.x = cvtpk(p[s][8 * ks + 0], p[s][8 * ks + 1]); pw.y = cvtpk(p[s][8 * ks + 2], p[s][8 * ks + 3]); pw.z = cvtpk(p[s][8 * ks + 4], p[s][8 * ks + 5]); pw.w = cvtpk(p[s][8 * ks + 6], p[s][8 * ks + 7]);
            const bf16x8 pa = __builtin_bit_cast(bf16x8, pw);
            const LAS unsigned char* vrow = vb + (32 * (w + s) + 16 * ks) * 64;
#pragma unroll
            for (int d0 = 0; d0 < 2; ++d0) {
                const s16x4 lo = vtr(vrow + d0 * VHALF), hh = vtr(vrow + d0 * VHALF + 512);
                const bf16x8 vf = {lo[0], lo[1], lo[2], lo[3], hh[0], hh[1], hh[2], hh[3]};
                o[d0] = __builtin_amdgcn_mfma_f32_32x32x16_bf16(pa, vf, o[d0], 0, 0, 0);
            }
        }
    LAS float* wsf = (LAS float*)(lds + WS_OFF) + w * 64;
    if (hi == 0) wsf[r32] = ls;
    LDS_WAIT();
    LAS bf16_t* stg = (LAS bf16_t*)(lds + OST_OFF) + w * 2048;
#pragma unroll
    for (int rr = 0; rr < 16; ++rr) {
        const int orow = crow(rr, hi); const float rl = frcp(wsf[orow]);
        stg[orow * 64 + r32] = (bf16_t)f2bf(o[0][rr] * rl); stg[orow * 64 + 32 + r32] = (bf16_t)f2bf(o[1][rr] * rl);
    }
    LDS_WAIT();
#pragma unroll
    for (int i = 0; i < 4; ++i) {
        const int row = i * 8 + (lane >> 3), ch = lane & 7;
        const u32x4 v = *(const LAS u32x4*)(stg + row * 64 + ch * 8);
        const size_t tok = ((size_t)(i0 + 32 * w + row) << dsh) + r;
        *(u32x4*)(O + tok * 512 + h * 64 + ch * 8) = v;
    }
    if (hi == 0) LSE[qtok * 8 + h] = mx + __builtin_amdgcn_logf(ls);
    B.end(bgr);
    LDS_WAIT();
    __syncthreads();
}
}

namespace rg {
constexpr int XC_STRIDE = 1040;
constexpr int XC_BYTES = 64 * XC_STRIDE;
constexpr int NCHUNK = MP / 64;
__device__ __forceinline__ int crow(int r, int hi) { return (r & 3) + 8 * (r >> 2) + 4 * hi; }
__device__ __forceinline__ float expm1_(float x) {
    const float p = x * (1.0f + x * (0.5f + x * (0.16666667f + x * (0.041666668f + x * (0.008333334f + x * 0.0013888889f)))));
    return (x > -0.25f) ? p : (expf(x) - 1.0f);
}
__device__ __forceinline__ void task(LAS unsigned char* lds, const Args& a, int l, int tk) {
    const int tid = pg8::opaque_tid(), lane = tid & 63, r32 = lane & 31, hi = lane >> 5;
    const int w = __builtin_amdgcn_readfirstlane(tid >> 6);
    unsigned char* ws = a.ws;
    const bf16_t* XR = (const bf16_t*)(ws + WS_XR);
    bf16_t* HL = (bf16_t*)(ws + WS_HL); bf16_t* CA = (bf16_t*)(ws + WS_CA);
    const bf16_t* WT = (const bf16_t*)(ws + WS_WGT) + (size_t)l * (2 * 8 * 64 * 64);
    const float* cw = a.in[8] + l * 4 * DR; const float* cbias = a.in[9] + l * DR;
    const float* bga = a.in[11] + l * DR; const float* bgx = a.in[13] + l * DR; const float* sp = (const float*)(ws + WS_SP) + l * DR;
    float* AGGA = (float*)(ws + WS_AGGA) + (size_t)l * NCHUNK * DR; float* AGGH = (float*)(ws + WS_AGGH) + (size_t)l * NCHUNK * DR; float* CARRY = (float*)(ws + WS_CARRY) + (size_t)l * NCHUNK * DR;
    const int tg = tid >> 6, cg = tid & 63;
    const int t0 = tk * 64;
    {
        float cwj[4][8], cbv[8];
#pragma unroll
        for (int j = 0; j < 4; ++j) { const f32x4 x0 = *(const f32x4*)(cw + j * DR + cg * 8), x1 = *(const f32x4*)(cw + j * DR + cg * 8 + 4);
#pragma unroll
            for (int e = 0; e < 4; ++e) { cwj[j][e] = x0[e]; cwj[j][4 + e] = x1[e]; } }
        { const f32x4 x0 = *(const f32x4*)(cbias + cg * 8), x1 = *(const f32x4*)(cbias + cg * 8 + 4);
#pragma unroll
            for (int e = 0; e < 4; ++e) { cbv[e] = x0[e]; cbv[4 + e] = x1[e]; } }
        u32x4 raw[11];
#pragma unroll
        for (int j = 0; j < 11; ++j) { const int t = t0 + 8 * tg - 3 + j; raw[j] = (t >= 0) ? *(const u32x4*)(XR + (size_t)t * 512 + cg * 8) : (u32x4){0u, 0u, 0u, 0u}; }
#pragma unroll
        for (int tt = 0; tt < 8; ++tt) {
            float xc[8];
#pragma unroll
            for (int e = 0; e < 8; ++e) xc[e] = cbv[e];
#pragma unroll
            for (int j = 0; j < 4; ++j) {
                const u32x4 rw = raw[tt + j];
#pragma unroll
                for (int e2 = 0; e2 < 4; ++e2) { const unsigned wv = rw[e2]; xc[2 * e2] += cwj[j][2 * e2] * __builtin_bit_cast(float, wv << 16); xc[2 * e2 + 1] += cwj[j][2 * e2 + 1] * __builtin_bit_cast(float, wv & 0xffff0000u); }
            }
            u32x4 o; o.x = cvtpk(xc[0], xc[1]); o.y = cvtpk(xc[2], xc[3]); o.z = cvtpk(xc[4], xc[5]); o.w = cvtpk(xc[6], xc[7]);
            *(LAS u32x4*)(lds + (8 * tg + tt) * XC_STRIDE + cg * 16) = o;
        }
    }
    LDS_WAIT();
    __syncthreads();
#pragma unroll
    for (int nt = 0; nt < 2; ++nt) {
        const int c = 64 * w + 32 * nt + r32;
        f32x16 ar[2], ab[2];
#pragma unroll
        for (int mt = 0; mt < 2; ++mt) { ar[mt] = (f32x16){0.f, 0.f, 0.f, 0.f, 0.f, 0.f, 0.f, 0.f, 0.f, 0.f, 0.f, 0.f, 0.f, 0.f, 0.f, 0.f}; ab[mt] = ar[mt]; }
#pragma unroll
        for (int ks = 0; ks < 4; ++ks) {
            const bf16x8 ba = *(const bf16x8*)(WT + ((size_t)(0 * 8 + w) * 64 + 32 * nt + r32) * 64 + 16 * ks + 8 * hi);
            const bf16x8 bx = *(const bf16x8*)(WT + ((size_t)(1 * 8 + w) * 64 + 32 * nt + r32) * 64 + 16 * ks + 8 * hi);
#pragma unroll
            for (int mt = 0; mt < 2; ++mt) {
                const bf16x8 af = *(const LAS bf16x8*)(lds + (32 * mt + r32) * XC_STRIDE + (64 * w + 16 * ks + 8 * hi) * 2);
                ar[mt] = __builtin_amdgcn_mfma_f32_32x32x16_bf16(af, ba, ar[mt], 0, 0, 0);
                ab[mt] = __builtin_amdgcn_mfma_f32_32x32x16_bf16(af, bx, ab[mt], 0, 0, 0);
            }
        }
        const float vbga = bga[c] * -1.4426950408889634f, vbgx = bgx[c] * -1.4426950408889634f, vsp2 = sp[c] * (-8.0f * 1.4426950408889634f);
        LAS bf16_t* stg = (LAS bf16_t*)(lds + XC_BYTES) + w * 4096;
        LAS bf16_t* stgw = stg + 4 * hi * 32 + r32;
#pragma unroll
        for (int mt = 0; mt < 2; ++mt)
#pragma unroll
            for (int rr = 0; rr < 16; ++rr) {
                const int tkn = 32 * mt + crow(rr, hi);
                const float xcv = bf2f(*(const LAS bf16_t*)(lds + tkn * XC_STRIDE + c * 2));
                const float rg_ = frcp(1.0f + fexp2(ar[mt][rr] * -1.4426950408889634f + vbga)), ig_ = frcp(1.0f + fexp2(ab[mt][rr] * -1.4426950408889634f + vbgx));
                const float av = fexp2(rg_ * vsp2);
                const float bv = sqrtf(fmaxf(1.0f - av * av, 0.f)) * (ig_ * xcv);
                ar[mt][rr] = av; ab[mt][rr] = bv;
            }
        float GA[8], GH[8];
#pragma unroll
        for (int mt = 0; mt < 2; ++mt)
#pragma unroll
            for (int k = 0; k < 4; ++k) {
                float A = 1.f, H = 0.f;
#pragma unroll
                for (int e = 0; e < 4; ++e) { const float av = ar[mt][4 * k + e], bv = ab[mt][4 * k + e]; H = av * H + bv; A = A * av; ar[mt][4 * k + e] = A; ab[mt][4 * k + e] = H; }
                GA[mt * 4 + k] = A; GH[mt * 4 + k] = H;
            }
        float OA[8], OH[8];
#pragma unroll
        for (int q = 0; q < 8; ++q) { OA[q] = __shfl_xor(GA[q], 32); OH[q] = __shfl_xor(GH[q], 32); }
        float curH = 0.f, curA = 1.f;
#pragma unroll
        for (int mt = 0; mt < 2; ++mt)
#pragma unroll
            for (int k = 0; k < 4; ++k) {
                const int q = mt * 4 + k;
                const float ga0 = hi ? OA[q] : GA[q], gh0 = hi ? OH[q] : GH[q];
                const float ga1 = hi ? GA[q] : OA[q], gh1 = hi ? GH[q] : OH[q];
                const float midH = gh0 + ga0 * curH, midA = curA * ga0;
                const float cinH = hi ? midH : curH, cinA = hi ? midA : curA;
#pragma unroll
                for (int e = 0; e < 4; ++e) {
                    const float Al = ar[mt][4 * k + e], Hl = ab[mt][4 * k + e];
                    const float hv = Hl + Al * cinH, cav = Al * cinA;
                    stgw[(32 * mt + 8 * k + e) * 32] = (bf16_t)f2bf(hv); stgw[2048 + (32 * mt + 8 * k + e) * 32] = (bf16_t)f2bf(cav);
                }
                curH = gh1 + ga1 * midH; curA = midA * ga1;
            }
        if (hi == 0) { AGGA[(size_t)tk * DR + c] = curA; AGGH[(size_t)tk * DR + c] = curH; }
        LDS_WAIT();
#pragma unroll
        for (int i = 0; i < 4; ++i) {
            const int row = i * 16 + (lane >> 2), seg = lane & 3;
            const u32x4 vh = *(const LAS u32x4*)(stg + row * 32 + seg * 8), vc = *(const LAS u32x4*)(stg + 2048 + row * 32 + seg * 8);
            const size_t off = (size_t)(t0 + row) * 512 + 64 * w + 32 * nt + seg * 8;
            *(u32x4*)(HL + off) = vh; *(u32x4*)(CA + off) = vc;
        }
        LDS_WAIT();
    }
    VM_WAIT();
    __syncthreads();
    volatile LAS unsigned* flag = (volatile LAS unsigned*)(lds + MISC_OFF + 64);
    if (tid == 0) {
        __builtin_amdgcn_fence(__ATOMIC_RELEASE, "agent");
        asm volatile("s_waitcnt vmcnt(0)" ::: "memory");
        const unsigned old = __hip_atomic_fetch_add((unsigned*)(ws + WS_CTL) + CW_RG + 64 * l, 1u, __ATOMIC_RELAXED, __HIP_MEMORY_SCOPE_AGENT);
        const unsigned last = (old == (unsigned)(NCHUNK - 1)) ? 1u : 0u;
        if (last) { __builtin_amdgcn_fence(__ATOMIC_ACQUIRE, "agent"); asm volatile("s_waitcnt vmcnt(0)" ::: "memory"); }
        flag[0] = last;
    }
    LDS_WAIT();
    __syncthreads();
    if (flag[0]) {
        const int cq = tid & 127, sg = tid >> 7;
        const f32x4* pa = (const f32x4*)(AGGA + (size_t)(64 * sg) * DR) + cq; const f32x4* ph = (const f32x4*)(AGGH + (size_t)(64 * sg) * DR) + cq;
        f32x4 A = {1.f, 1.f, 1.f, 1.f}, H = {0.f, 0.f, 0.f, 0.f};
        for (int j0 = 0; j0 < 64; j0 += 8) {
            f32x4 va[8], vh[8];
#pragma unroll
            for (int j = 0; j < 8; ++j) { va[j] = pa[(size_t)(j0 + j) * 128]; vh[j] = ph[(size_t)(j0 + j) * 128]; }
#pragma unroll
            for (int j = 0; j < 8; ++j) { H = vh[j] + va[j] * H; A = A * va[j]; }
        }
        LAS f32x4* xa = (LAS f32x4*)lds; LAS f32x4* xh = xa + 512;
        xa[sg * 128 + cq] = A; xh[sg * 128 + cq] = H;
        LDS_WAIT();
        __syncthreads();
        f32x4 h = {0.f, 0.f, 0.f, 0.f};
        for (int s2 = 0; s2 < sg; ++s2) h = xh[s2 * 128 + cq] + xa[s2 * 128 + cq] * h;
        f32x4* pc = (f32x4*)(CARRY + (size_t)(64 * sg) * DR) + cq;
        for (int j0 = 0; j0 < 64; j0 += 8) {
            f32x4 va[8], vh[8];
#pragma unroll
            for (int j = 0; j < 8; ++j) { va[j] = pa[(size_t)(j0 + j) * 128]; vh[j] = ph[(size_t)(j0 + j) * 128]; }
#pragma unroll
            for (int j = 0; j < 8; ++j) { pc[(size_t)(j0 + j) * 128] = h; h = vh[j] + va[j] * h; }
        }
        if (sg == 3) *((f32x4*)(a.out + O_PH + (size_t)l * DR) + cq) = h;
    }
    __syncthreads();
}
}

__device__ __forceinline__ void phase_fin(const Args& a, int l, int wg, int nwg) {
    unsigned char* ws = a.ws;
    const bf16_t* OG = (const bf16_t*)(ws + WS_OG); const float* LSE = (const float*)(ws + WS_LSE);
    const bf16_t* HL = (const bf16_t*)(ws + WS_HL); const bf16_t* CA = (const bf16_t*)(ws + WS_CA); const bf16_t* GY = (const bf16_t*)(ws + WS_GY);
    const float* CARRY = (const float*)(ws + WS_CARRY) + (size_t)l * rg::NCHUNK * DR;
    bf16_t* MIX = (bf16_t*)(ws + WS_MIX);
    const size_t gt = (size_t)wg * 512 + pg8::opaque_tid(), NGT = (size_t)nwg * 512;
    for (size_t it = gt; it < (size_t)MP * 128; it += NGT) {
        const int tok = (int)(it >> 7), grp = (int)(it & 127);
#ifdef DBG_NO_ATT
        if (grp < 64) { *(u32x4*)(MIX + (size_t)tok * DM + grp * 8) = (u32x4){0u, 0u, 0u, 0u}; continue; }
#endif
#ifdef DBG_NO_RNN
        if (grp >= 64) { *(u32x4*)(MIX + (size_t)tok * DM + grp * 8) = (u32x4){0u, 0u, 0u, 0u}; continue; }
#endif
        if (grp < 64) {
            const int h = grp >> 3;
            const float l0 = LSE[(size_t)tok * 8 + h], l1 = LSE[(size_t)MP * 8 + (size_t)tok * 8 + h], l2 = LSE[(size_t)2 * MP * 8 + (size_t)tok * 8 + h];
            const float m = fmaxf(l0, fmaxf(l1, l2));
            float w0 = fexp2(l0 - m), w1 = fexp2(l1 - m), w2 = fexp2(l2 - m);
            const float inv = frcp(w0 + w1 + w2); w0 *= inv; w1 *= inv; w2 *= inv;
            const size_t off = (size_t)tok * 512 + grp * 8;
            const u32x4 o0 = *(const u32x4*)(OG + off), o1 = *(const u32x4*)(OG + (OG_STRIDE / 2) + off), o2 = *(const u32x4*)(OG + 2 * (OG_STRIDE / 2) + off);
            u32x4 r;
#pragma unroll
            for (int e = 0; e < 4; ++e) {
                const float lo = w0 * __builtin_bit_cast(float, o0[e] << 16) + w1 * __builtin_bit_cast(float, o1[e] << 16) + w2 * __builtin_bit_cast(float, o2[e] << 16);
                const float hh = w0 * __builtin_bit_cast(float, o0[e] & 0xffff0000u) + w1 * __builtin_bit_cast(float, o1[e] & 0xffff0000u) + w2 * __builtin_bit_cast(float, o2[e] & 0xffff0000u);
                r[e] = cvtpk(lo, hh);
            }
            *(u32x4*)(MIX + (size_t)tok * DM + grp * 8) = r;
        } else {
            const int cg = grp - 64;
            const size_t off = (size_t)tok * 512 + cg * 8;
            const u32x4 hl = *(const u32x4*)(HL + off), ca = *(const u32x4*)(CA + off), gy = *(const u32x4*)(GY + off);
            const float* cp = CARRY + (size_t)(tok >> 6) * DR + cg * 8;
            const f32x4 c0 = *(const f32x4*)cp, c1 = *(const f32x4*)(cp + 4);
            u32x4 r;
#pragma unroll
            for (int e = 0; e < 4; ++e) {
                const float clo = (e < 2) ? c0[2 * e] : c1[2 * e - 4], chi = (e < 2) ? c0[2 * e + 1] : c1[2 * e - 3];
                const float lo = (__builtin_bit_cast(float, hl[e] << 16) + __builtin_bit_cast(float, ca[e] << 16) * clo) * __builtin_bit_cast(float, gy[e] << 16);
                const float hh = (__builtin_bit_cast(float, hl[e] & 0xffff0000u) + __builtin_bit_cast(float, ca[e] & 0xffff0000u) * chi) * __builtin_bit_cast(float, gy[e] & 0xffff0000u);
                r[e] = cvtpk(lo, hh);
            }
            *(u32x4*)(MIX + (size_t)tok * DM + 512 + cg * 8) = r;
        }
    }
}

__device__ __forceinline__ void dbg_zero_sample_mix(const Args& a, int lo_col, int hi_col) {
    bf16_t* MIX = (bf16_t*)(a.ws + WS_MIX);
    for (size_t i = (size_t)blockIdx.x * 512 + threadIdx.x; i < (size_t)MS * DM; i += (size_t)gridDim.x * 512) { const int c = (int)(i & 1023); if (c >= lo_col && c < hi_col) MIX[(size_t)MP * DM + i] = 0; }
}
namespace sat {
constexpr int NE = 388, NG = 97;
__device__ __forceinline__ const float* row_ptr(const float* cache, const float* fresh, int t, int e) {
    const int ee = e < 387 ? e : 0, g = ee / 129, m = ee - g * 129;
    const int j = WBUF + t - (m << (2 * g));
    return (j >= WBUF) ? (fresh + (size_t)(j - WBUF) * 512) : (cache + (size_t)j * 512);
}
__device__ __forceinline__ void task(LAS unsigned char* lds, const Args& a, int l, int b, int h) {
    const int tid = pg8::opaque_tid(), lane = tid & 63, slot = lane >> 4, d4 = lane & 15;
    const int w = __builtin_amdgcn_readfirstlane(tid >> 6), t = w >> 1, half = w & 1;
    unsigned char* ws = a.ws;
    LAS float* qsh = (LAS float*)lds;
    LAS float* sc = qsh + 256;
    LAS float* sums = sc + 4 * NE;
    LAS float* part = sums + 16;
    if (tid < 256) qsh[tid] = ((const float*)(ws + WS_QS))[(size_t)(b * 4 + (tid >> 6)) * 512 + h * 64 + (tid & 63)] * 0.125f;
    LDS_WAIT();
    __syncthreads();
    const size_t cbase = ((size_t)(l * NB + b) * WBUF) * 512 + h * 64;
    const float* ck = a.in[2] + cbase; const float* cv = a.in[3] + cbase;
    const float* nk = a.out + O_SK + cbase + (size_t)(WBUF - NT) * 512; const float* nv = a.out + O_SV + cbase + (size_t)(WBUF - NT) * 512;
    const f32x4 qv = *(const LAS f32x4*)(qsh + t * 64 + 4 * d4);
    for (int g0 = half; g0 < NG; g0 += 16) {
        f32x4 kv[8];
#pragma unroll
        for (int i = 0; i < 8; ++i) { const int grp = g0 + 2 * i; const int e = 4 * (grp < NG ? grp : 0) + slot; kv[i] = *(const f32x4*)(row_ptr(ck, nk, t, e) + 4 * d4); }
#pragma unroll
        for (int i = 0; i < 8; ++i) {
            const int grp = g0 + 2 * i;
            float s = (kv[i][0] * qv[0] + kv[i][1] * qv[1]) + (kv[i][2] * qv[2] + kv[i][3] * qv[3]);
            s += __shfl_xor(s, 1); s += __shfl_xor(s, 2); s += __shfl_xor(s, 4); s += __shfl_xor(s, 8);
            const int e = 4 * grp + slot;
            if (grp < NG && d4 == 0) sc[t * NE + e] = (e < 387) ? s : -INFINITY;
        }
    }
    LDS_WAIT();
    __syncthreads();
    if (w < 4) {
        float mx = -INFINITY;
        for (int e = lane; e < NE; e += 64) mx = fmaxf(mx, sc[w * NE + e]);
        mx = wave_max(mx);
        float sum = 0.f;
        for (int e = lane; e < NE; e += 64) { const float pe = expf(sc[w * NE + e] - mx); sc[w * NE + e] = pe; sum += pe; }
        sum = wave_sum(sum);
        if (lane == 0) sums[w] = sum;
    }
    LDS_WAIT();
    __syncthreads();
    f32x4 acc = {0.f, 0.f, 0.f, 0.f};
    for (int g0 = half; g0 < NG; g0 += 16) {
        f32x4 vv[8]; float pe[8];
#pragma unroll
        for (int i = 0; i < 8; ++i) { const int grp = g0 + 2 * i; const int e = 4 * (grp < NG ? grp : 0) + slot; vv[i] = *(const f32x4*)(row_ptr(cv, nv, t, e) + 4 * d4); pe[i] = (grp < NG) ? sc[t * NE + e] : 0.f; }
#pragma unroll
        for (int i = 0; i < 8; ++i) acc += vv[i] * pe[i];
    }
#pragma unroll
    for (int c = 0; c < 4; ++c) { acc[c] += __shfl_xor(acc[c], 16); acc[c] += __shfl_xor(acc[c], 32); }
    if (lane < 16) *(LAS f32x4*)(part + w * 64 + 4 * lane) = acc;
    LDS_WAIT();
    __syncthreads();
    if (tid < 256) {
        const int tt = tid >> 6, d = tid & 63;
        const float o = (part[(2 * tt) * 64 + d] + part[(2 * tt + 1) * 64 + d]) / sums[tt];
        ((bf16_t*)(ws + WS_MIX))[(size_t)(MP + b * 4 + tt) * DM + h * 64 + d] = (bf16_t)f2bf(o);
    }
    __syncthreads();
}
}

__device__ __forceinline__ void srglru_task(LAS unsigned char* lds, const Args& a, int l, int b) {
    const int c = pg8::opaque_tid();
    unsigned char* ws = a.ws;
    const float* xrs = (const float*)(ws + WS_XRS) + (size_t)b * 4 * DR;
    const float* sconv = a.in[4] + (size_t)(l * NB + b) * 3 * DR;
    float xp[7];
#pragma unroll
    for (int j = 0; j < 3; ++j) xp[j] = sconv[j * DR + c];
#pragma unroll
    for (int j = 0; j < 4; ++j) xp[3 + j] = xrs[j * DR + c];
    const float* cw = a.in[8] + l * 4 * DR;
    const float w0 = cw[c], w1 = cw[DR + c], w2 = cw[2 * DR + c], w3 = cw[3 * DR + c], cb = a.in[9][l * DR + c];
    float xc[4];
    LAS float* xcs = (LAS float*)lds;
    __syncthreads();
#pragma unroll
    for (int t = 0; t < 4; ++t) { xc[t] = w0 * xp[t] + w1 * xp[t + 1] + w2 * xp[t + 2] + w3 * xp[t + 3] + cb; xcs[t * DR + c] = xc[t]; }
    LDS_WAIT();
    __syncthreads();
    const int n = c >> 6, d = c & 63;
    const float* wa = a.in[10] + (size_t)(l * 8 + n) * 4096 + d; const float* wx = a.in[12] + (size_t)(l * 8 + n) * 4096 + d;
    float pa[4] = {0.f, 0.f, 0.f, 0.f}, px[4] = {0.f, 0.f, 0.f, 0.f};
#pragma unroll 8
    for (int k = 0; k < 64; ++k) {
        const float va = wa[k * 64], vx = wx[k * 64];
#pragma unroll
        for (int t = 0; t < 4; ++t) { const float xv = xcs[t * DR + n * 64 + k]; pa[t] += xv * va; px[t] += xv * vx; }
    }
    const float vbga = a.in[11][l * DR + c], vbgx = a.in[13][l * DR + c], vsp = ((const float*)(ws + WS_SP))[l * DR + c];
    float h = a.in[5][(size_t)(l * NB + b) * DR + c];
    const bf16_t* GY = (const bf16_t*)(ws + WS_GY); bf16_t* MIX = (bf16_t*)(ws + WS_MIX);
#pragma unroll
    for (int t = 0; t < 4; ++t) {
        const float rg_ = 1.0f / (1.0f + expf(-(pa[t] + vbga))), ig_ = 1.0f / (1.0f + expf(-(px[t] + vbgx)));
        const float la = -8.0f * rg_ * vsp;
        const float av = expf(la), bv = sqrtf(-rg::expm1_(2.0f * la)) * (ig_ * xc[t]);
        h = av * h + bv;
        const size_t row = (size_t)MP + b * 4 + t;
        MIX[row * DM + 512 + c] = (bf16_t)f2bf(h * bf2f(GY[row * 512 + c]));
    }
    a.out[O_SH + (size_t)(l * NB + b) * DR + c] = h;
#pragma unroll
    for (int j = 0; j < 3; ++j) a.out[O_SC + ((size_t)(l * NB + b) * 3 + j) * DR + c] = xp[4 + j];
    __syncthreads();
}

__device__ __forceinline__ void phase_final(const Args& a, int wg, int nwg) {
    unsigned char* ws = a.ws;
    const int tid = pg8::opaque_tid(), lane = tid & 63, wave = tid >> 6;
    const int gw = wg * 8 + wave, NGW = nwg * 8;
    const bf16_t* XB = (const bf16_t*)(ws + WS_XBA); const float* ssqp = (const float*)(ws + WS_SSQP + 4 * SSQP_STRIDE);
    const float* gf = a.in[20];
    f32x4 g0[2], g1[2];
#pragma unroll
    for (int j = 0; j < 2; ++j) { g0[j] = *((const f32x4*)gf + 2 * lane + 128 * j); g1[j] = *((const f32x4*)gf + 2 * lane + 128 * j + 1); }
    for (int m = gw; m < MP; m += NGW) {
        const float rs = row_rstd(ssqp, m);
        f32x4* o = (f32x4*)(a.out + O_YP + (size_t)m * DM);
#pragma unroll
        for (int j = 0; j < 2; ++j) {
            const u32x4 xw = *((const u32x4*)(XB + (size_t)m * DM) + lane + 64 * j);
            const f32x4 a0 = {__builtin_bit_cast(float, xw.x << 16), __builtin_bit_cast(float, xw.x & 0xffff0000u), __builtin_bit_cast(float, xw.y << 16), __builtin_bit_cast(float, xw.y & 0xffff0000u)};
            const f32x4 a1 = {__builtin_bit_cast(float, xw.z << 16), __builtin_bit_cast(float, xw.z & 0xffff0000u), __builtin_bit_cast(float, xw.w << 16), __builtin_bit_cast(float, xw.w & 0xffff0000u)};
            o[2 * lane + 128 * j] = a0 * rs * g0[j]; o[2 * lane + 128 * j + 1] = a1 * rs * g1[j];
        }
    }
}
__device__ __forceinline__ void skinny_down(const Args& a, int l) {
    unsigned char* ws = a.ws;
    const int tid = pg8::opaque_tid(), lane = tid & 63, i = lane & 15, kq = lane >> 4;
    const int w = __builtin_amdgcn_readfirstlane(tid >> 6);
    const bf16_t* Hs = (const bf16_t*)(ws + WS_H) + (size_t)MP * DFF;
    const bf16_t* Wt = (const bf16_t*)(ws + WS_W + (size_t)l * W_LAYER + W_FD);
    float* ACC = (float*)(ws + WS_ACC);
    for (int it = blockIdx.x; it < 256; it += gridDim.x) {
        const int ns = it & 31, ks = it >> 5;
        const bf16_t* ap = Hs + (size_t)(16 * w + i) * DFF + ks * 352 + 8 * kq;
        const bf16_t* bp = Wt + (size_t)(32 * ns + i) * DFF + ks * 352 + 8 * kq;
        bf16x8 af[11], b0[11], b1[11];
#pragma unroll
        for (int s = 0; s < 11; ++s) { af[s] = *(const bf16x8*)(ap + 32 * s); b0[s] = *(const bf16x8*)(bp + 32 * s); b1[s] = *(const bf16x8*)(bp + (size_t)16 * DFF + 32 * s); }
        f32x4 c0 = {0.f, 0.f, 0.f, 0.f}, c1 = c0;
#pragma unroll
        for (int s = 0; s < 11; ++s) { c0 = __builtin_amdgcn_mfma_f32_16x16x32_bf16(af[s], b0[s], c0, 0, 0, 0); c1 = __builtin_amdgcn_mfma_f32_16x16x32_bf16(af[s], b1[s], c1, 0, 0, 0); }
        float* o = ACC + (size_t)ks * MS * DM + (size_t)(16 * w + 4 * kq) * DM + 32 * ns + i;
#pragma unroll
        for (int r = 0; r < 4; ++r) { o[(size_t)r * DM] = c0[r]; o[(size_t)r * DM + 16] = c1[r]; }
    }
}
__device__ __forceinline__ void sample_final(const Args& a) {
    unsigned char* ws = a.ws;
    const int tid = pg8::opaque_tid(), lane = tid & 63, wave = tid >> 6;
    const bf16_t* XB = (const bf16_t*)(ws + WS_XBB) + (size_t)MP * DM; const float* ACC = (const float*)(ws + WS_ACC);
    const float* gf = a.in[20];
    for (int s = blockIdx.x * 8 + wave; s < MS; s += gridDim.x * 8) {
        f32x4 v[4]; float ss = 0.f;
#pragma unroll
        for (int j = 0; j < 2; ++j) {
            const u32x4 xw = *((const u32x4*)(XB + (size_t)s * DM) + lane + 64 * j);
            v[2 * j] = (f32x4){__builtin_bit_cast(float, xw.x << 16), __builtin_bit_cast(float, xw.x & 0xffff0000u), __builtin_bit_cast(float, xw.y << 16), __builtin_bit_cast(float, xw.y & 0xffff0000u)};
            v[2 * j + 1] = (f32x4){__builtin_bit_cast(float, xw.z << 16), __builtin_bit_cast(float, xw.z & 0xffff0000u), __builtin_bit_cast(float, xw.w << 16), __builtin_bit_cast(float, xw.w & 0xffff0000u)};
#pragma unroll
            for (int ks = 0; ks < 8; ++ks) { const f32x4* ap = (const f32x4*)(ACC + (size_t)ks * MS * DM + (size_t)s * DM) + 2 * lane + 128 * j; v[2 * j] += ap[0]; v[2 * j + 1] += ap[1]; }
            ss += (v[2 * j].x * v[2 * j].x + v[2 * j].y * v[2 * j].y) + (v[2 * j].z * v[2 * j].z + v[2 * j].w * v[2 * j].w) + (v[2 * j + 1].x * v[2 * j + 1].x + v[2 * j + 1].y * v[2 * j + 1].y) + (v[2 * j + 1].z * v[2 * j + 1].z + v[2 * j + 1].w * v[2 * j + 1].w);
        }
        ss = wave_sum(ss);
        const float rs = 1.0f / sqrtf(ss * (1.0f / DM) + RMS_EPS);
#pragma unroll
        for (int j = 0; j < 2; ++j) { f32x4* o = (f32x4*)(a.out + O_YS + (size_t)s * DM) + 2 * lane + 128 * j; const f32x4* gp = (const f32x4*)gf + 2 * lane + 128 * j; o[0] = v[2 * j] * rs * gp[0]; o[1] = v[2 * j + 1] * rs * gp[1]; }
    }
}

constexpr int N_PHASES = 16;
#ifndef MK_ONE_LAUNCH
#define MK_ONE_LAUNCH 1
#endif

__global__ void __launch_bounds__(512, 2) mk_fwd(Args a_unused) {
    extern __shared__ __attribute__((aligned(16))) unsigned char lds_raw[];
    LAS unsigned char* lds = (LAS unsigned char*)lds_raw;
    { const int tid0 = threadIdx.x; for (int u = tid0; u < (LDS_BYTES - MISC_OFF) / 4; u += 512) ((LAS unsigned*)(lds + MISC_OFF))[u] = 0u; }
    __syncthreads();
#ifndef REPM
#define REPM 0
#endif
#define NREP(b) (((REPM >> (b)) & 1) ? 2 : 1)
#define IN(k) phase_on(k)
#define MAKE_BG(a) const cpy::Bg bg{a.in[2], a.in[3], a.out, (unsigned*)(a.ws + WS_CTL) + cpy::CW_COPYQ, lds}
#if MK_ONE_LAUNCH
    { XcdBarrier b0 = xcd_barrier_post((unsigned*)((unsigned char*)kargs()->ws + WS_CTL) + CW_BAR, (volatile LAS unsigned*)(lds + MISC_OFF + 32)); (void)b0; }
#define SEAM(k) do { if (IN(k) && IN((k) + 1)) { XcdBarrier b_; b_.bar = (unsigned*)((unsigned char*)kargs()->ws + WS_CTL) + CW_BAR; b_.x = xb_xcc_id(); b_.st = (volatile LAS unsigned*)(lds + MISC_OFF + 32); xcd_barrier(b_); } } while (0)
#else
#define SEAM(k) do { } while (0)
#endif
    const int bid = (int)blockIdx.x, G = (int)gridDim.x;

#define S_G1(jj, R) do { pg8::Gemm g{(const bf16_t*)(ws + WS_XBA) + (size_t)MP * DM, (const bf16_t*)(wl + W_IN), 256, DIN, DM}; PanelOrder S{jj, R, DIN / 256}; \
        fill_rstd_table(lds, (const float*)(ws + WS_SSQP + (size_t)(l == 0 ? 0 : 2) * SSQP_STRIDE) + (size_t)MP * 16, S); EpiG1 E{lds, ws, a.out, l, MP, true}; \
        pg8::gemm_phase<EpiG1, PanelOrder, true, true>(lds, g, S, E); } while (0)
#define S_G2(jj, R) do { pg8::Gemm g{(const bf16_t*)(ws + WS_MIX) + (size_t)MP * DM, (const bf16_t*)(wl + W_OUT), 256, DM, DM}; PanelOrder S{jj, R, DM / 256}; \
        EpiRes E{l == 0 ? a.in[0] : nullptr, a.in[1], (const bf16_t*)(ws + WS_XBA), (bf16_t*)(ws + WS_XBB), (float*)(ws + WS_SSQP + (size_t)(l == 0 ? 1 : 3) * SSQP_STRIDE), MP, true}; \
        pg8::gemm_phase<EpiRes, PanelOrder, true, true>(lds, g, S, E); } while (0)
#define S_G3(jj, R) do { pg8::Gemm g{(const bf16_t*)(ws + WS_XBB) + (size_t)MP * DM, (const bf16_t*)(wl + W_GU), 256, NGU, DM}; PanelOrder S{jj, R, NGU / 256}; \
        fill_rstd_table(lds, (const float*)(ws + WS_SSQP + (size_t)(l == 0 ? 1 : 3) * SSQP_STRIDE) + (size_t)MP * 16, S); EpiG3 E{lds, (bf16_t*)(ws + WS_H), MP, true}; \
        pg8::gemm_phase<EpiG3, PanelOrder, true, true>(lds, g, S, E); } while (0)
#define S_G4(jj, R, LL) do { unsigned char* wl4_ = ws + WS_W + (size_t)(LL) * W_LAYER; pg8::Gemm g{(const bf16_t*)(ws + WS_H) + (size_t)MP * DFF, (const bf16_t*)(wl4_ + W_FD), 256, DM, DFF}; PanelOrder S{jj, R, DM / 256}; \
        EpiRes E{nullptr, nullptr, (const bf16_t*)(ws + WS_XBB), (bf16_t*)(ws + WS_XBA), (float*)(ws + WS_SSQP + (size_t)((LL) == 0 ? 2 : 4) * SSQP_STRIDE), MP, true}; \
        pg8::gemm_phase<EpiRes, PanelOrder, true, true>(lds, g, S, E); } while (0)

    if (IN(0)) for (int rep_ = 0; rep_ < NREP(0); ++rep_) { LOAD_ARGS(a); MAKE_BG(a); bg.init(); phase_prologue(a, lds); SEAM(0); }
#ifdef DBG_EXTRA_BARRIERS
    for (int eb_ = 0; eb_ < DBG_EXTRA_BARRIERS; ++eb_) { SEAM(0); }
#endif

    for (int l = 0; l < NLAYER; ++l) {
        const int pb = 1 + 6 * l;
        if (IN(pb)) for (int rep_ = 0; rep_ < NREP(1); ++rep_) {
            LOAD_ARGS(a); MAKE_BG(a); unsigned char* ws = a.ws; unsigned char* wl = ws + WS_W + (size_t)l * W_LAYER;
            const int jr = (bid >= G - 8) ? bid - (G - 8) : -1;
            const int NBG = (int)cpy::BG_G1_WGS, GP = G - 8 - NBG;
            if (bid < GP) {
                pg8::Gemm g{(const bf16_t*)(ws + WS_XBA), (const bf16_t*)(wl + W_IN), MP, DIN, DM}; pg8::StaticOrder S; S.init(MP, DIN, GP, bid);
                fill_rstd_table(lds, (const float*)(ws + WS_SSQP + (size_t)(l == 0 ? 0 : 2) * SSQP_STRIDE), S);
                EpiG1 E{lds, ws, a.out, l, 0, false};
                pg8::gemm_phase<EpiG1, pg8::StaticOrder, true, true>(lds, g, S, E);
            }
            if (bid >= GP && bid < G - 8) {
                const int tb = pg8::opaque_tid(), wv = __builtin_amdgcn_readfirstlane(tb >> 6), bw = (bid - GP) * 8 + wv;
                if (l == 0) weight_convert_items(a, (LAS float*)(lds + wv * 16384), WCV_FIRST, WCV_TOTAL, bw, NBG * 8, tb & 63);
                if (l == 0) bg.stream((unsigned)bw * cpy::Q_G1A, cpy::Q_G1A); else bg.stream(cpy::C2 + (unsigned)bw * cpy::Q_G1B, cpy::Q_G1B);
            }
            if (l == 0) { S_G1(jr, 8); }
            if (l == 1) { S_G4(jr, 8, 0); }
            SEAM(pb);
        }
        if (IN(pb + 1)) for (int rep_ = 0; rep_ < NREP(2); ++rep_) {
            LOAD_ARGS(a); MAKE_BG(a); unsigned char* ws = a.ws; unsigned char* wl = ws + WS_W + (size_t)l * W_LAYER;
            const int R = (l == 0) ? 0 : 10, Gp = G - R;
            if (bid < Gp) {
                for (int r2_ = 0; r2_ < NREP(8); ++r2_) for (int t = bid; t < rg::NCHUNK; t += Gp) rg::task(lds, a, l, t);
                if (l == 0 && bid >= 64 && bid < 64 + NB) srglru_task(lds, a, l, bid - 64);
                __syncthreads();
                for (int r2_ = 0; r2_ < NREP(10); ++r2_) for (int u = bid; u < 1536; u += Gp) {
                    const int g = u >> 9, rem = u & 511, h = rem & 7, rj = rem >> 3;
                    const int dsh = 2 * g, bpc = 64 >> dsh, r = rj / bpc, jb = rj % bpc;
                    att::unit(lds, (const bf16_t*)(ws + WS_Q), (const bf16_t*)(ws + WS_K), (const bf16_t*)(ws + WS_V),
                              (bf16_t*)(ws + WS_OG + (size_t)g * OG_STRIDE), (float*)(ws + WS_LSE) + (size_t)g * MP * 8, dsh, r, jb, h, bg);
                }
                __syncthreads();
                if (l == 0) for (int r2_ = 0; r2_ < NREP(11); ++r2_) for (int t = bid; t < NB * NH; t += Gp) sat::task(lds, a, l, t >> 3, t & 7);
            }
            if (l == 1) { S_G1(bid >= Gp ? bid - Gp : -1, 10); }
            SEAM(pb + 1);
        }
        if (IN(pb + 2)) for (int rep_ = 0; rep_ < NREP(3); ++rep_) {
            LOAD_ARGS(a); MAKE_BG(a); unsigned char* ws = a.ws; unsigned char* wl = ws + WS_W + (size_t)l * W_LAYER;
            const int R = (l == 0) ? 4 : 0, Gp = G - R;
            if (bid < Gp) {
                if (l == 1) { if (bid < NB) srglru_task(lds, a, l, bid); __syncthreads(); for (int t = bid; t < NB * NH; t += Gp) sat::task(lds, a, l, t >> 3, t & 7); }
                phase_fin(a, l, bid, Gp);
            }
            if (l == 0) { S_G2(bid >= Gp ? bid - Gp : -1, 4); }
            SEAM(pb + 2);
        }
        if (IN(pb + 3)) for (int rep_ = 0; rep_ < NREP(4); ++rep_) {
            LOAD_ARGS(a); MAKE_BG(a); unsigned char* ws = a.ws; unsigned char* wl = ws + WS_W + (size_t)l * W_LAYER;
            pg8::Gemm g{(const bf16_t*)(ws + WS_MIX), (const bf16_t*)(wl + W_OUT), MP, DM, DM}; pg8::StaticOrder S; S.init(MP, DM, G, bid);
            EpiRes E{l == 0 ? a.in[0] : nullptr, a.in[1], (const bf16_t*)(ws + WS_XBA), (bf16_t*)(ws + WS_XBB), (float*)(ws + WS_SSQP + (size_t)(l == 0 ? 1 : 3) * SSQP_STRIDE), 0, false};
            pg8::gemm_phase<EpiRes, pg8::StaticOrder, true, true>(lds, g, S, E);
            SEAM(pb + 3);
        }
        if (IN(pb + 4)) for (int rep_ = 0; rep_ < NREP(5); ++rep_) {
            LOAD_ARGS(a); MAKE_BG(a); unsigned char* ws = a.ws; unsigned char* wl = ws + WS_W + (size_t)l * W_LAYER;
            const int jr = (bid >= G - 8) ? bid - (G - 8) : -1;
            const int NBG = (int)cpy::BG_G3_WGS, GP = G - 8 - NBG;
            if (bid < GP) {
                pg8::Gemm g{(const bf16_t*)(ws + WS_XBB), (const bf16_t*)(wl + W_GU), MP, NGU, DM}; pg8::StaticOrder S; S.init(MP, NGU, GP, bid);
                fill_rstd_table(lds, (const float*)(ws + WS_SSQP + (size_t)(l == 0 ? 1 : 3) * SSQP_STRIDE), S);
                EpiG3 E{lds, (bf16_t*)(ws + WS_H), 0, false};
                pg8::gemm_phase<EpiG3, pg8::StaticOrder, true, true>(lds, g, S, E);
            }
            if (bid >= GP && bid < G - 8) {
                const int tb = pg8::opaque_tid(), wv = __builtin_amdgcn_readfirstlane(tb >> 6), bw = (bid - GP) * 8 + wv;
                bg.stream((l == 0 ? cpy::C1 : cpy::C3) + (unsigned)bw * cpy::Q_G3, cpy::Q_G3);
            }
            if (l == 0) { S_G3(jr, 8); }
            if (l == 1) { S_G2(jr, 8); }
            SEAM(pb + 4);
        }
        if (IN(pb + 5)) for (int rep_ = 0; rep_ < NREP(6); ++rep_) {
            LOAD_ARGS(a); MAKE_BG(a); unsigned char* ws = a.ws; unsigned char* wl = ws + WS_W + (size_t)l * W_LAYER;
            pg8::Gemm g{(const bf16_t*)(ws + WS_H), (const bf16_t*)(wl + W_FD), MP, DM, DFF}; pg8::StaticOrder S; S.init(MP, DM, G, bid);
            EpiRes E{nullptr, nullptr, (const bf16_t*)(ws + WS_XBB), (bf16_t*)(ws + WS_XBA), (float*)(ws + WS_SSQP + (size_t)(l == 0 ? 2 : 4) * SSQP_STRIDE), 0, false};
            pg8::gemm_phase<EpiRes, pg8::StaticOrder, true, true>(lds, g, S, E);
            SEAM(pb + 5);
        }
    }
    if (IN(13)) {
        LOAD_ARGS(a); MAKE_BG(a); unsigned char* ws = a.ws; const int l = 1; unsigned char* wl = ws + WS_W + (size_t)l * W_LAYER;
        if (bid < G - 22) phase_final(a, bid, G - 22);
        { S_G3(bid >= G - 22 ? bid - (G - 22) : -1, 22); }
        SEAM(13);
    }
    if (IN(14)) { LOAD_ARGS(a); skinny_down(a, 1); SEAM(14); }
    if (IN(15)) { LOAD_ARGS(a); MAKE_BG(a); sample_final(a); bg.drain(); }
#undef IN
#undef SEAM
}

extern "C" void kernel_launch(void* const* d_in, const int* in_sizes, int n_in, void* d_out, int out_size, void* d_ws, size_t ws_size, hipStream_t stream) {
    static int grid = 0;
    if (grid == 0) {
        if (n_in != 21 || (size_t)out_size != O_END || ws_size < WS_END) { fprintf(stderr, "kernel_launch: unexpected shapes (n_in %d, out %d, ws %zu); nothing launched\n", n_in, out_size, ws_size); grid = -1; return; }
        int dev = 0, cus = 0, per_cu = 0;
        if (hipGetDevice(&dev) != hipSuccess || hipDeviceGetAttribute(&cus, hipDeviceAttributeMultiprocessorCount, dev) != hipSuccess) { grid = -1; return; }
        if (hipFuncSetAttribute((const void*)mk_fwd, hipFuncAttributeMaxDynamicSharedMemorySize, LDS_BYTES) != hipSuccess) { fprintf(stderr, "kernel_launch: hipFuncSetAttribute failed\n"); grid = -1; return; }
        if (hipOccupancyMaxActiveBlocksPerMultiprocessor(&per_cu, (const void*)mk_fwd, 512, LDS_BYTES) != hipSuccess || per_cu < 1) { fprintf(stderr, "kernel_launch: occupancy query says %d blocks per CU\n", per_cu); }
        (void)hipGetLastError();
        grid = cus;
    }
    if (grid < 0) return;
    hipMemsetAsync((char*)d_ws + WS_CTL, 0, CTL_ZERO_BYTES, stream);
    Args a{};
    for (int i = 0; i < 21; ++i) a.in[i] = (const float*)d_in[i];
    a.out = (float*)d_out; a.ws = (unsigned char*)d_ws;
#if MK_ONE_LAUNCH
    a.ph_lo = 0; a.ph_hi = N_PHASES;
    hipLaunchKernelGGL(mk_fwd, dim3(grid), dim3(512), LDS_BYTES, stream, a);
#else
    for (int p = 0; p < N_PHASES; ++p) { a.ph_lo = p; a.ph_hi = p + 1; hipLaunchKernelGGL(mk_fwd, dim3(grid), dim3(512), LDS_BYTES, stream, a); }
#endif
}
```

```cpp
#define MK_ONE_LAUNCH 1
#include <hip/hip_runtime.h>
#include <cstdio>
#include <cstdint>

namespace pg8 {
#define PG8_LAS __attribute__((address_space(3)))
typedef unsigned short bf16_t;
typedef short bf16x8 __attribute__((ext_vector_type(8)));
typedef float f32x4 __attribute__((ext_vector_type(4)));
typedef unsigned u32x4 __attribute__((ext_vector_type(4)));
constexpr int BM = 256, BK = 64, HALF = 128, HTB = HALF * BK * 2  , STAGE_BYTES = 8 * HTB, NXCD = 8, WGM = 8;

__host__ __device__ __forceinline__ int lds_byte(int r, int c) { const int st = (r >> 4) * 2 + (c >> 5), rr = r & 15, cc = c & 31, ob = rr * 64 + cc * 2; return st * 1024 + (ob ^ (((ob >> 9) & 1) << 5)); }
__host__ __device__ __forceinline__ void stage_rc(int b, int& R, int& C) { const int st = b / 1024, sb = b % 1024, swz = sb ^ (((sb >> 9) & 1) << 5); R = (st >> 1) * 16 + swz / 64; C = (st & 1) * 32 + (swz % 64) / 2; }
__host__ __device__ __forceinline__ int perm32(int rho) { const int n = rho >> 4, i = rho & 15; return 8 * (i >> 2) + 4 * n + (i & 3); }

struct Unit { int pm, pn; };
struct Gemm { const bf16_t* A; const bf16_t* Bt; int M, N, K; };

struct StaticOrder {
    int nM, nN, nwg, G, c;
    __host__ __device__ void init(int M, int N, int G_, int c_) { nM = M / BM; nN = N / BM; nwg = nM * nN; G = G_; c = c_; }
    __host__ __device__ bool next(int i, Unit& u) const {
        const long L = (long)i * G + c; if (L >= nwg) return false;
        int wgid = (int)L; { const int q = nwg / NXCD, r = nwg % NXCD, xcd = wgid % NXCD, off = wgid / NXCD; wgid = (xcd < r ? xcd * (q + 1) : r * (q + 1) + (xcd - r) * q) + off; }
        const int nig = WGM * nN, gid = wgid / nig, fm = gid * WGM, gsz = (nM - fm) < WGM ? (nM - fm) : WGM;
        u.pm = fm + ((wgid % nig) % gsz); u.pn = (wgid % nig) / gsz; return true;
    }
    __device__ __forceinline__ void a_ready(const Unit&) const {}
    __device__ __forceinline__ void done(const Unit&) const {}
};

__device__ __forceinline__ int opaque_tid() { int t = threadIdx.x; asm volatile("" : "+v"(t)); return t; }
__device__ __forceinline__ unsigned cvt_pk_bf16(float lo, float hi) { unsigned r; asm volatile("v_cvt_pk_bf16_f32 %0, %1, %2" : "=v"(r) : "v"(lo), "v"(hi)); return r; }

struct NoBg { struct Regs {}; __device__ __forceinline__ void begin(Regs&) const {} __device__ __forceinline__ void end(Regs&) const {} };
template <class Epi, class Sched, bool ALIGN_EPI = false, bool SP2 = false, class Bg = NoBg>
__device__ __forceinline__ void gemm_phase(PG8_LAS unsigned char* lds, const Gemm g, const Sched& S, const Epi& E, const Bg& B = Bg()) {
    const int tid = opaque_tid(), wid = __builtin_amdgcn_readfirstlane(tid >> 6), lane = tid & 63, wr = wid >> 2, wc = wid & 3, fr = lane & 15, fq = lane >> 4;
    const int K = g.K, nt = K / BK;
    unsigned voffA[2], voffB[2];
#pragma unroll
    for (int i = 0; i < 2; ++i) { int R, C; stage_rc(tid * 16 + i * 8192, R, C); const int Rb = Epi::PERM ? ((R & ~31) + perm32(R & 31)) : R;
        voffA[i] = (unsigned)(R * K + C) * 2u; voffB[i] = (unsigned)(Rb * K + C) * 2u; }
    const unsigned kstep = (unsigned)(BK * 2);
    const unsigned hstep = (unsigned)HALF * K * 2;
    const unsigned tstep = 2 * hstep;
    const __amdgpu_buffer_rsrc_t rsA = __builtin_amdgcn_make_buffer_rsrc((void*)g.A, 0, (int)((unsigned)g.M * (unsigned)K * 2u), 0x00020000);
    const __amdgpu_buffer_rsrc_t rsB = __builtin_amdgcn_make_buffer_rsrc((void*)g.Bt, 0, (int)((unsigned)g.N * (unsigned)K * 2u), 0x00020000);
    const unsigned ldsw = (unsigned)wid * 1024u;
    const int aoff = lds_byte(wr * 64 + fr, fq * 8), boff = lds_byte(wc * 32 + fr, fq * 8);
#define PG8_SA(b, h) (((b) * 2 + (h)) * HTB)
#define PG8_SB(b, h) ((4 + (b) * 2 + (h)) * HTB)
#define PG8_STAGE(bufoff, gbase, voff) do { _Pragma("unroll") for (int _i = 0; _i < 2; ++_i) \
        __builtin_amdgcn_raw_ptr_buffer_load_lds(PG8_RSRC_##voff, (PG8_LAS void*)(lds + (bufoff) + ldsw + _i * 8192), 16, (int)(voff)[_i], (int)(gbase), 0, 0); } while (0)
#define PG8_RSRC_voffA rsA
#define PG8_RSRC_voffB rsB
#define PG8_LDA(dst, b, h) do { _Pragma("unroll") for (int m = 0; m < 4; ++m) _Pragma("unroll") for (int k = 0; k < 2; ++k) dst[m][k] = *(const PG8_LAS bf16x8*)(lds + PG8_SA(b, h) + aoff + m * 2048 + k * 1024); } while (0)
#define PG8_LDB(dst, b, h) do { _Pragma("unroll") for (int n = 0; n < 2; ++n) _Pragma("unroll") for (int k = 0; k < 2; ++k) dst[n][k] = *(const PG8_LAS bf16x8*)(lds + PG8_SB(b, h) + boff + n * 2048 + k * 1024); } while (0)
#define PG8_MMA(ai, bj, At, Bt) do { __builtin_amdgcn_s_setprio(1); _Pragma("unroll") for (int m = 0; m < 4; ++m) _Pragma("unroll") for (int n = 0; n < 2; ++n) _Pragma("unroll") for (int k = 0; k < 2; ++k) \
        acc[ai][bj][m][n] = __builtin_amdgcn_mfma_f32_16x16x32_bf16(Bt[n][k], At[m][k], acc[ai][bj][m][n], 0, 0, 0); __builtin_amdgcn_s_setprio(0); } while (0)
#define PG8_WAIT_V(n) asm volatile("s_waitcnt vmcnt(" #n ")" ::: "memory")
#define PG8_WAIT_L(n) asm volatile("s_waitcnt lgkmcnt(" #n ")" ::: "memory")
#define PG8_BAR __builtin_amdgcn_s_barrier()
#define PG8_SCHED __builtin_amdgcn_sched_barrier(0)
    Unit cur, nxt; int ui = 0;
    if (!S.next(0, cur)) return;
    f32x4 acc[2][2][4][2];
#pragma unroll
    for (int a = 0; a < 2; ++a)
#pragma unroll
        for (int b = 0; b < 2; ++b)
#pragma unroll
            for (int m = 0; m < 4; ++m)
#pragma unroll
                for (int n = 0; n < 2; ++n) acc[a][b][m][n] = (f32x4){0.f, 0.f, 0.f, 0.f};
    bf16x8 At[4][2], B0[2][2], B1[2][2];
    unsigned cA = (unsigned)cur.pm * tstep, cB = (unsigned)cur.pn * tstep;
    S.a_ready(cur);
    if constexpr (SP2) {
        PG8_STAGE(PG8_SB(0, 0), cB, voffB); PG8_STAGE(PG8_SB(0, 1), cB + hstep, voffB); PG8_STAGE(PG8_SA(0, 0), cA, voffA); PG8_STAGE(PG8_SA(0, 1), cA + hstep, voffA);
        if (wr == 1) PG8_BAR;
        PG8_WAIT_V(2); PG8_BAR;
        PG8_STAGE(PG8_SB(1, 0), cB + kstep, voffB); PG8_STAGE(PG8_SA(1, 0), cA + kstep, voffA); PG8_STAGE(PG8_SB(1, 1), cB + hstep + kstep, voffB);
        PG8_WAIT_V(6); PG8_BAR;
    } else {
        PG8_STAGE(PG8_SB(0, 0), cB, voffB); PG8_STAGE(PG8_SA(0, 0), cA, voffA); PG8_STAGE(PG8_SB(0, 1), cB + hstep, voffB); PG8_STAGE(PG8_SA(0, 1), cA + hstep, voffA);
        if (wr == 1) PG8_BAR;
        PG8_WAIT_V(4); PG8_BAR;
        PG8_STAGE(PG8_SB(1, 0), cB + kstep, voffB); PG8_STAGE(PG8_SA(1, 0), cA + kstep, voffA); PG8_STAGE(PG8_SB(1, 1), cB + hstep + kstep, voffB);
        PG8_WAIT_V(6); PG8_BAR;
    }
    for (;;) {
        const bool has_next = S.next(ui + 1, nxt);
        const unsigned nA = has_next ? (unsigned)nxt.pm * tstep : cA, nB = has_next ? (unsigned)nxt.pn * tstep : cB;
        for (int t = 0; t < nt; t += 2) {
            const bool last = (t == nt - 2);
            const unsigned a1 = cA + (unsigned)(t + 1) * kstep;
            const unsigned a2 = last ? nA : cA + (unsigned)(t + 2) * kstep, b2 = last ? nB : cB + (unsigned)(t + 2) * kstep;
            const unsigned a3 = a2 + kstep, b3 = b2 + kstep;
            if (last && has_next) S.a_ready(nxt);
            if constexpr (SP2) {
            PG8_LDB(B0, 0, 0); PG8_LDB(B1, 0, 1); PG8_SCHED; PG8_LDA(At, 0, 0); PG8_STAGE(PG8_SA(1, 1), a1 + hstep, voffA);
            PG8_WAIT_V(8); PG8_WAIT_L(0); PG8_BAR; PG8_MMA(0, 0, At, B0); PG8_MMA(0, 1, At, B1); PG8_BAR; PG8_SCHED;
            PG8_LDA(At, 0, 1); PG8_STAGE(PG8_SB(0, 0), b2, voffB); PG8_STAGE(PG8_SB(0, 1), b2 + hstep, voffB); PG8_STAGE(PG8_SA(0, 0), a2, voffA);
            PG8_WAIT_V(8); PG8_WAIT_L(0); PG8_BAR; PG8_MMA(1, 0, At, B0); PG8_MMA(1, 1, At, B1); PG8_BAR; PG8_SCHED;
            PG8_LDB(B0, 1, 0); PG8_LDB(B1, 1, 1); PG8_SCHED; PG8_LDA(At, 1, 0); PG8_STAGE(PG8_SA(0, 1), a2 + hstep, voffA);
            PG8_WAIT_V(8); PG8_WAIT_L(0); PG8_BAR; PG8_MMA(0, 0, At, B0); PG8_MMA(0, 1, At, B1); PG8_BAR; PG8_SCHED;
            PG8_LDA(At, 1, 1); PG8_STAGE(PG8_SB(1, 0), b3, voffB); PG8_STAGE(PG8_SB(1, 1), b3 + hstep, voffB); PG8_STAGE(PG8_SA(1, 0), a3, voffA);
            PG8_WAIT_V(8); PG8_WAIT_L(0); PG8_BAR; PG8_MMA(1, 0, At, B0); PG8_MMA(1, 1, At, B1); PG8_BAR; PG8_SCHED;
            } else {
            PG8_LDB(B0, 0, 0); PG8_SCHED; PG8_LDA(At, 0, 0); PG8_STAGE(PG8_SA(1, 1), a1 + hstep, voffA);
            PG8_WAIT_L(8); PG8_BAR; PG8_WAIT_L(0); PG8_MMA(0, 0, At, B0); PG8_BAR; PG8_SCHED;
            PG8_LDB(B1, 0, 1); PG8_STAGE(PG8_SB(0, 0), b2, voffB);
            PG8_BAR; PG8_WAIT_L(0); PG8_MMA(0, 1, At, B1); PG8_BAR;
            PG8_LDA(At, 0, 1); PG8_STAGE(PG8_SA(0, 0), a2, voffA);
            PG8_BAR; PG8_WAIT_L(0); PG8_MMA(1, 0, At, B0); PG8_BAR; PG8_SCHED;
            PG8_STAGE(PG8_SB(0, 1), b2 + hstep, voffB);
            PG8_WAIT_V(6); PG8_BAR; PG8_MMA(1, 1, At, B1); PG8_BAR;
            PG8_LDB(B0, 1, 0); PG8_SCHED; PG8_LDA(At, 1, 0); PG8_STAGE(PG8_SA(0, 1), a2 + hstep, voffA);
            PG8_WAIT_L(8); PG8_BAR; PG8_WAIT_L(0); PG8_MMA(0, 0, At, B0); PG8_BAR; PG8_SCHED;
            PG8_LDB(B1, 1, 1); PG8_STAGE(PG8_SB(1, 0), b3, voffB);
            PG8_BAR; PG8_WAIT_L(0); PG8_MMA(0, 1, At, B1); PG8_BAR;
            PG8_LDA(At, 1, 1); PG8_STAGE(PG8_SA(1, 0), a3, voffA);
            PG8_BAR; PG8_WAIT_L(0); PG8_MMA(1, 0, At, B0); PG8_BAR; PG8_SCHED;
            PG8_STAGE(PG8_SB(1, 1), b3 + hstep, voffB);
            PG8_WAIT_V(6); PG8_BAR; PG8_MMA(1, 1, At, B1); PG8_BAR;
            }
        }
        if constexpr (ALIGN_EPI) { if (wr == 0) PG8_BAR; }
        if constexpr (!Epi::AFTER_DRAIN) { typename Bg::Regs bgr; E(acc, cur, wr, wc, fr, fq, ui, B, bgr); B.end(bgr); S.done(cur); }
        if (!has_next) break;
#pragma unroll
        for (int a = 0; a < 2; ++a)
#pragma unroll
            for (int b = 0; b < 2; ++b)
#pragma unroll
                for (int m = 0; m < 4; ++m)
#pragma unroll
                    for (int n = 0; n < 2; ++n) acc[a][b][m][n] = (f32x4){0.f, 0.f, 0.f, 0.f};
        cur = nxt; cA = nA; cB = nB; ++ui;
        if constexpr (ALIGN_EPI) { if (wr == 1) PG8_BAR; }
    }
    PG8_WAIT_V(0);
    if constexpr (!ALIGN_EPI) { if (wr == 0) PG8_BAR; }
    PG8_BAR;
#undef PG8_SA
#undef PG8_SB
#undef PG8_STAGE
#undef PG8_RSRC_voffA
#undef PG8_RSRC_voffB
#undef PG8_LDA
#undef PG8_LDB
#undef PG8_MMA
#undef PG8_WAIT_V
#undef PG8_WAIT_L
#undef PG8_BAR
#undef PG8_SCHED
}
}

#define LAS __attribute__((address_space(3)))
#define GAS __attribute__((address_space(1)))
typedef unsigned short bf16_t;
typedef short bf16x8 __attribute__((ext_vector_type(8)));
typedef short s16x4 __attribute__((ext_vector_type(4)));
typedef float f32x4 __attribute__((ext_vector_type(4)));
typedef float f32x16 __attribute__((ext_vector_type(16)));
typedef unsigned u32x4 __attribute__((ext_vector_type(4)));
typedef unsigned u32x2 __attribute__((ext_vector_type(2)));

constexpr int MP = 16384;
constexpr int MS = 128;
constexpr int MROWS = MP + MS;
constexpr int MTOT = 16640;
constexpr int DM = 1024, DIN = 2560, DA = 512, DR = 512, DFF = 2816, NGU = 2 * DFF;
constexpr int NH = 8, HD = 64, WBUF = 2048, NB = 32, NT = 4, NLAYER = 2;
constexpr int ROPE_ROWS = MP + NT;
constexpr float RMS_EPS = 1e-6f;
constexpr float QSCALE = 0.18033688011112042f;

constexpr size_t O_YP = 0, O_YS = 16777216, O_PK = 16908288, O_PV = 19005440, O_PC = 21102592, O_PH = 21105664,
                 O_SK = 21106688, O_SV = 88215552, O_SC = 155324416, O_SH = 155422720, O_END = 155455488;

constexpr size_t MiB = 1u << 20;
constexpr size_t WS_CTL = 0, CTL_ZERO_BYTES = 1 * MiB;
constexpr size_t WS_ROPE = 1 * MiB;
constexpr size_t WS_WGT = 3 * MiB;
constexpr size_t WS_SP = WS_WGT + 512 * 1024;
constexpr size_t WS_W = 5 * MiB, W_LAYER = 24 * MiB;
constexpr size_t W_IN = 0, W_OUT = 5242880, W_GU = 7340032, W_FD = 18874368;
constexpr size_t WS_SSQP = 53 * MiB, SSQP_STRIDE = 1114112;
constexpr size_t WS_QS = 59 * MiB;
constexpr size_t WS_XRS = WS_QS + 512 * 1024;
constexpr size_t WS_LSE = 60 * MiB;
constexpr size_t WS_XBA = 62 * MiB;
constexpr size_t WS_XBB = 95 * MiB;
constexpr size_t WS_X = 128 * MiB;
constexpr size_t WS_Q = 193 * MiB, WS_K = 210 * MiB, WS_V = 227 * MiB, WS_XR = 244 * MiB, WS_GY = 261 * MiB, WS_HL = 278 * MiB, WS_CA = 295 * MiB;
constexpr size_t WS_OG = 312 * MiB, OG_STRIDE = 16 * MiB;
constexpr size_t WS_MIX = 360 * MiB;
constexpr size_t WS_H = 393 * MiB;
constexpr size_t WS_AGGA = 483 * MiB, WS_AGGH = 484 * MiB, WS_CARRY = 485 * MiB;
constexpr size_t WS_ACC = 486 * MiB;
constexpr size_t WS_XP = 491 * MiB;
constexpr size_t WS_PREA = 556 * MiB;
constexpr size_t WS_GAGG = 557 * MiB;
constexpr size_t WS_END = 558 * MiB;

constexpr int CW_BAR = 4096;
constexpr int CW_RG = 16384;

constexpr int LDS_BYTES = 155648;
constexpr int MISC_OFF = 150 * 1024;

struct Args { const float* in[21]; float* out; unsigned char* ws; int ph_lo, ph_hi; };
typedef const volatile __attribute__((address_space(4))) Args* KArgsPtr;
__device__ __forceinline__ KArgsPtr kargs() { return (KArgsPtr)__builtin_amdgcn_kernarg_segment_ptr(); }
#define LOAD_ARGS(a) Args a; { KArgsPtr k_ = kargs(); _Pragma("unroll") for (int i_ = 0; i_ < 21; ++i_) a.in[i_] = (const float*)k_->in[i_]; a.out = (float*)k_->out; a.ws = (unsigned char*)k_->ws; a.ph_lo = 0; a.ph_hi = 0; }
__device__ __forceinline__ bool phase_on(int k) { KArgsPtr k_ = kargs(); const int lo = k_->ph_lo, hi = k_->ph_hi; return lo <= k && k < hi; }

__device__ __forceinline__ unsigned f2bf(float f) { unsigned u = __builtin_bit_cast(unsigned, f); return (u + 0x7fffu + ((u >> 16) & 1u)) >> 16; }
__device__ __forceinline__ unsigned pk2(float lo, float hi) { return f2bf(lo) | (f2bf(hi) << 16); }
__device__ __forceinline__ float bf2f(unsigned short b) { return __builtin_bit_cast(float, (unsigned)b << 16); }
__device__ __forceinline__ unsigned cvtpk(float lo, float hi) { return pg8::cvt_pk_bf16(lo, hi); }
__device__ __forceinline__ float fexp2(float x) { return __builtin_amdgcn_exp2f(x); }
__device__ __forceinline__ float frcp(float x) { return __builtin_amdgcn_rcpf(x); }
__device__ __forceinline__ float sigmoidf_(float x) { return frcp(1.0f + fexp2(-1.4426950408889634f * x)); }
__device__ __forceinline__ float gelu_tanh(float x) {
    const float u = x * (1.0f + 0.044715f * x * x);
    return x * frcp(1.0f + fexp2(-2.3022081565f * u));
}
#define LDS_WAIT() asm volatile("s_waitcnt lgkmcnt(0)" ::: "memory")
#define VM_WAIT() asm volatile("s_waitcnt vmcnt(0)" ::: "memory")

using pg8::Unit;
__device__ __forceinline__ float row_rstd(const float* ssqp, int row) {
    const f32x4* p = (const f32x4*)(ssqp + (size_t)row * 16);
    const f32x4 a = p[0], b = p[1], c = p[2], d = p[3];
    const f32x4 s = (a + b) + (c + d);
    const float ss = (s[0] + s[1]) + (s[2] + s[3]);
    return 1.0f / sqrtf(ss * (1.0f / DM) + RMS_EPS);
}

constexpr int RSTD_OFF = 131072, RSTD_MAX_UNITS = 8;
template <class Sched>
__device__ __forceinline__ void fill_rstd_table(LAS unsigned char* lds, const float* ssqp  , const Sched& S) {
    const int tid = pg8::opaque_tid();
    Unit u;
    for (int i = 0; i < RSTD_MAX_UNITS && S.next(i, u); ++i) {
        const int row = u.pm * 256 + (tid >> 1);
        const f32x4* p = (const f32x4*)(ssqp + (size_t)row * 16) + (tid & 1) * 2;
        const f32x4 s = p[0] + p[1];
        float ss = (s[0] + s[1]) + (s[2] + s[3]);
        ss += __shfl_xor(ss, 1);
        if ((tid & 1) == 0) ((LAS float*)(lds + RSTD_OFF))[i * 256 + (tid >> 1)] = 1.0f / sqrtf(ss * (1.0f / DM) + RMS_EPS);
    }
    LDS_WAIT();
    __syncthreads();
}

struct PanelOrder {
    int j, R, nN;
    __device__ __forceinline__ bool next(int i, Unit& u) const { const int id = j + i * R; if (j < 0 || id >= nN) return false; u.pm = 0; u.pn = id; return true; }
    __device__ __forceinline__ void a_ready(const Unit&) const {}
    __device__ __forceinline__ void done(const Unit&) const {}
};

struct EpiG1 {
    static constexpr bool PERM = true, AFTER_DRAIN = false;
    LAS unsigned char* lds; unsigned char* ws; float* out; int l; int row0; bool samp;
    template <class Bg> __device__ __forceinline__ void operator()(const f32x4 (&acc)[2][2][4][2], const Unit& u, int wr, int wc, int fr, int fq, int ui, const Bg& B, typename Bg::Regs& bgr) const {
        const int sect = u.pn >> 1;
        const LAS float* rtab = (const LAS float*)(lds + RSTD_OFF) + ui * 256;
        const bool dorope = (sect <= 1) && ((wc & 1) == 0);
        const bool rl = dorope && (fq < 2);
        const int cbase = (u.pn & 1) * 256 + wc * 32;
        const int ca0 = cbase + (rl ? 4 * fq : 8 * fq), ca1 = cbase + (rl ? 8 + 4 * fq : 8 * fq + 4);
        const float* rope = (const float*)(ws + WS_ROPE) + 4 * (fq & 1);
        bf16_t* bdst = (bf16_t*)(ws + (sect == 0 ? WS_Q : sect == 1 ? WS_K : sect == 2 ? WS_V : sect == 3 ? WS_XR : WS_GY));
        float* pdst = out + (sect == 1 ? O_PK + (size_t)l * WBUF * 512 : sect == 2 ? O_PV + (size_t)l * WBUF * 512 : O_PC + (size_t)l * 3 * 512);
        const int prow0 = (sect == 3) ? (MP - 3) : (MP - WBUF);
        const bool has_p = (sect >= 1 && sect <= 3);
        float* sdst = (sect == 0) ? (float*)(ws + WS_QS) : (sect == 3) ? (float*)(ws + WS_XRS) : out + (sect == 1 ? O_SK : O_SV) + (size_t)l * NB * WBUF * 512;
        const float qs_ = (sect == 0) ? QSCALE : 1.0f;
#pragma unroll
        for (int ai = 0; ai < 2; ++ai) {
            if (ai == 1) { asm volatile("" ::: "memory"); B.begin(bgr); }
            if (samp && ai == 1) continue;
#pragma unroll
            for (int m = 0; m < 4; ++m) {
                const int rloc = ai * 128 + wr * 64 + m * 16 + fr, row = row0 + u.pm * 256 + rloc;
                const float rs = rtab[rloc];
                f32x4 cs = {1.f, 1.f, 1.f, 1.f}, sn = {0.f, 0.f, 0.f, 0.f};
                if (dorope) {
                    const int pos = samp ? (MP + (row & 3)) : row;
                    const float* rp = rope + (size_t)pos * 16;
                    cs = *(const f32x4*)rp; sn = *(const f32x4*)(rp + 8);
                }
#pragma unroll
                for (int bj = 0; bj < 2; ++bj) {
                    f32x4 v0 = acc[ai][bj][m][0] * rs, v1 = acc[ai][bj][m][1] * rs;
                    if (rl) { const f32x4 x1 = v0, x2 = v1; v0 = x1 * cs - x2 * sn; v1 = x2 * cs + x1 * sn; }
                    if (sect == 4) {
#pragma unroll
                        for (int e = 0; e < 4; ++e) { v0[e] = gelu_tanh(v0[e]); v1[e] = gelu_tanh(v1[e]); }
                    }
                    if (!samp || sect == 4) {
                        u32x2 w0, w1; w0.x = cvtpk(v0[0] * qs_, v0[1] * qs_); w0.y = cvtpk(v0[2] * qs_, v0[3] * qs_); w1.x = cvtpk(v1[0] * qs_, v1[1] * qs_); w1.y = cvtpk(v1[2] * qs_, v1[3] * qs_);
                        bf16_t* bp = bdst + (size_t)row * 512 + 128 * bj;
                        if (dorope) { *(u32x2*)(bp + ca0) = w0; *(u32x2*)(bp + ca1) = w1; }
                        else { *(u32x4*)(bp + ca0) = (u32x4){w0.x, w0.y, w1.x, w1.y}; }
                        if (has_p && row >= prow0) { float* o = pdst + (size_t)(row - prow0) * 512 + 128 * bj; *(f32x4*)(o + ca0) = v0; *(f32x4*)(o + ca1) = v1; }
                    } else {
                        const int s = row - MP;
                        const size_t srow = (sect == 1 || sect == 2) ? ((size_t)(s >> 2) * WBUF + (WBUF - NT) + (s & 3)) : (size_t)s;
                        float* o = sdst + srow * 512 + 128 * bj; *(f32x4*)(o + ca0) = v0; *(f32x4*)(o + ca1) = v1;
                    }
                }
                if (m & 1) asm volatile("" ::: "memory");
            }
        }
    }
};

struct EpiRes {
    static constexpr bool PERM = true, AFTER_DRAIN = false;
    const float* xin_p; const float* xin_s;
    const bf16_t* XBin; bf16_t* XBout; float* ssqp_out; int row0; bool samp;
    template <class Bg> __device__ __forceinline__ void operator()(const f32x4 (&acc)[2][2][4][2], const Unit& u, int wr, int wc, int fr, int fq, int ui, const Bg& B, typename Bg::Regs& bgr) const {
        const int cb = u.pn * 256 + wc * 32 + 8 * fq;
#pragma unroll
        for (int ai = 0; ai < 2; ++ai) {
            if (ai == 1) { asm volatile("" ::: "memory"); B.begin(bgr); }
            if (samp && ai == 1) continue;
#pragma unroll
            for (int m = 0; m < 4; ++m) {
                const int row = row0 + u.pm * 256 + ai * 128 + wr * 64 + m * 16 + fr;
                float ss = 0.f;
#pragma unroll
                for (int bj = 0; bj < 2; ++bj) {
                    const int c0 = cb + 128 * bj;
                    f32x4 a0, a1;
                    if (xin_p) { const float* xr_ = samp ? (xin_s + (size_t)(row - MP) * DM) : (xin_p + (size_t)row * DM); a0 = *(const f32x4*)(xr_ + c0); a1 = *(const f32x4*)(xr_ + c0 + 4); }
                    else { const u32x4 xw = *(const u32x4*)(XBin + (size_t)row * DM + c0);
                        a0 = (f32x4){__builtin_bit_cast(float, xw.x << 16), __builtin_bit_cast(float, xw.x & 0xffff0000u), __builtin_bit_cast(float, xw.y << 16), __builtin_bit_cast(float, xw.y & 0xffff0000u)};
                        a1 = (f32x4){__builtin_bit_cast(float, xw.z << 16), __builtin_bit_cast(float, xw.z & 0xffff0000u), __builtin_bit_cast(float, xw.w << 16), __builtin_bit_cast(float, xw.w & 0xffff0000u)}; }
                    const f32x4 v0 = acc[ai][bj][m][0] + a0, v1 = acc[ai][bj][m][1] + a1;
                    u32x4 w; w.x = cvtpk(v0[0], v0[1]); w.y = cvtpk(v0[2], v0[3]); w.z = cvtpk(v1[0], v1[1]); w.w = cvtpk(v1[2], v1[3]);
                    *(u32x4*)(XBout + (size_t)row * DM + c0) = w;
                    ss += (v0[0] * v0[0] + v0[1] * v0[1]) + (v0[2] * v0[2] + v0[3] * v0[3]) + (v1[0] * v1[0] + v1[1] * v1[1]) + (v1[2] * v1[2] + v1[3] * v1[3]);
                }
                ss += __shfl_xor(ss, 16); ss += __shfl_xor(ss, 32);
                if (fq == 0) ssqp_out[(size_t)row * 16 + u.pn * 4 + wc] = ss;
                if (m & 1) asm volatile("" ::: "memory");
            }
        }
    }
};

struct EpiG3 {
    static constexpr bool PERM = true, AFTER_DRAIN = false;
    LAS unsigned char* lds; bf16_t* H; int row0; bool samp;
    template <class Bg> __device__ __forceinline__ void operator()(const f32x4 (&acc)[2][2][4][2], const Unit& u, int wr, int wc, int fr, int fq, int ui, const Bg& B, typename Bg::Regs& bgr) const {
        const int c0 = u.pn * 128 + wc * 32 + 8 * fq;
        const LAS float* rtab = (const LAS float*)(lds + RSTD_OFF) + ui * 256;
#pragma unroll
        for (int ai = 0; ai < 2; ++ai) {
            if (ai == 1) { asm volatile("" ::: "memory"); B.begin(bgr); }
            if (samp && ai == 1) continue;
#pragma unroll
            for (int m = 0; m < 4; ++m) {
                const int row = row0 + u.pm * 256 + ai * 128 + wr * 64 + m * 16 + fr;
                const float rs = rtab[ai * 128 + wr * 64 + m * 16 + fr];
                float hv[8];
#pragma unroll
                for (int n = 0; n < 2; ++n)
#pragma unroll
                    for (int e = 0; e < 4; ++e) { const float g = acc[ai][0][m][n][e] * rs, up = acc[ai][1][m][n][e] * rs; hv[4 * n + e] = g * up * sigmoidf_(g); }
                u32x4 w; w.x = cvtpk(hv[0], hv[1]); w.y = cvtpk(hv[2], hv[3]); w.z = cvtpk(hv[4], hv[5]); w.w = cvtpk(hv[6], hv[7]);
                *(u32x4*)(H + (size_t)row * DFF + c0) = w;
                asm volatile("" ::: "memory");
            }
        }
    }
};

#define XB_TMO      128
#define XB_XCNT(j)  (256  + 64 * (j))
#define XB_XSUB(j)  (1280 + 64 * (j))
#define XB_XGEN(j)  (2304 + 64 * (j))
#define XB_TOP      3328
#define XB_TOPGEN   3392
#define XCD_BAR_WORDS 3456
#define XB_SPIN_CAP (1u << 18)
__device__ __forceinline__ unsigned xb_ld(unsigned* p)              { return __hip_atomic_load(p, __ATOMIC_RELAXED, __HIP_MEMORY_SCOPE_AGENT); }
__device__ __forceinline__ unsigned xb_add(unsigned* p, unsigned v) { return __hip_atomic_fetch_add(p, v, __ATOMIC_RELAXED, __HIP_MEMORY_SCOPE_AGENT); }
__device__ __forceinline__ unsigned xb_xcc_id() { return (unsigned)__builtin_amdgcn_s_getreg((3 << 11) | 20) & 0xFu; }
#define XB_SPIN(cond, bar) do { unsigned _sp = 0; while (cond) { __builtin_amdgcn_s_sleep(1); \
    if ((++_sp & 255u) == 0u) { if (xb_ld(&(bar)[XB_TMO])) break; if (_sp > XB_SPIN_CAP) { atomicAdd(&(bar)[XB_TMO], 1u); break; } } } } while (0)
struct XcdBarrier { unsigned* bar; unsigned x; volatile LAS unsigned* st; };
__device__ __forceinline__ XcdBarrier xcd_barrier_post(unsigned* bar, volatile LAS unsigned* st) {
    XcdBarrier b; b.bar = bar; b.x = xb_xcc_id(); b.st = st;
    if (threadIdx.x == 0) (void)xb_add(&bar[XB_XCNT(b.x)], 1u);
    return b;
}
__device__ __forceinline__ void xcd_barrier_complete(unsigned* bar, unsigned x, unsigned& nloc, unsigned& nx) {
    const unsigned G = gridDim.x * gridDim.y * gridDim.z;
    unsigned sum, cnt, mine, sp = 0u;
    for (;;) {
        sum = 0u; cnt = 0u; mine = 0u;
#pragma unroll
        for (unsigned j = 0; j < 16; ++j) { const unsigned c = xb_ld(&bar[XB_XCNT(j)]); sum += c; cnt += (c > 0u) ? 1u : 0u; mine = (j == x) ? c : mine; }
        if (sum == G) break;
        __builtin_amdgcn_s_sleep(1);
        if ((++sp & 255u) == 0u) { if (xb_ld(&bar[XB_TMO])) break; if (sp > XB_SPIN_CAP) { atomicAdd(&bar[XB_TMO], 1u); break; } }
    }
    nloc = mine > 0u ? mine : 1u; nx = cnt > 0u ? cnt : 1u;
}
__device__ __forceinline__ void xcd_barrier(const XcdBarrier& b) {
    asm volatile("s_waitcnt vmcnt(0)" ::: "memory");
    __syncthreads();
    if (threadIdx.x == 0) {
        unsigned* bar = b.bar;
        __builtin_amdgcn_s_waitcnt(0);
        unsigned nloc = b.st[0], nx = b.st[1];
        if (nloc == 0u) { xcd_barrier_complete(bar, b.x, nloc, nx); b.st[0] = nloc; b.st[1] = nx; }
        const unsigned old = xb_add(&bar[XB_XSUB(b.x)], 1u);
        const unsigned gen = old / nloc;
        if (old + 1u == (gen + 1u) * nloc) {
            __builtin_amdgcn_fence(__ATOMIC_RELEASE, "agent");
            asm volatile("s_waitcnt vmcnt(0)" ::: "memory");
            const unsigned og = xb_add(&bar[XB_TOP], 1u);
            const unsigned tg = og / nx;
            if (og + 1u == (tg + 1u) * nx) xb_add(&bar[XB_TOPGEN], 1u);
            else XB_SPIN(xb_ld(&bar[XB_TOPGEN]) == tg, bar);
            __builtin_amdgcn_fence(__ATOMIC_ACQUIRE, "agent");
            xb_add(&bar[XB_XGEN(b.x)], 1u);
            asm volatile("s_waitcnt vmcnt(0)" ::: "memory");
        } else {
            XB_SPIN(xb_ld(&bar[XB_XGEN(b.x)]) == gen, bar);
            __builtin_amdgcn_fence(__ATOMIC_ACQUIRE, "agent");
            asm volatile("s_waitcnt vmcnt(0)" ::: "memory");
        }
    }
    __syncthreads();
}

__device__ __forceinline__ float wave_sum(float v) {
#pragma unroll
    for (int o = 1; o < 64; o <<= 1) v += __shfl_xor(v, o);
    return v;
}
__device__ __forceinline__ float wave_max(float v) {
#pragma unroll
    for (int o = 1; o < 64; o <<= 1) v = fmaxf(v, __shfl_xor(v, o));
    return v;
}
__device__ __forceinline__ void transpose_item(const float* W, int K, int N, bf16_t* WT, int item, const float* g, int rowmode, LAS float* scr, int lane) {
    const int nblk = N / 32, kb = item / nblk, nb = item % nblk, k0 = 64 * kb, n0 = 32 * nb;
    {
        f32x4 v[8]; float gk[8];
#pragma unroll
        for (int i = 0; i < 8; ++i) { const int kk = (lane >> 3) + 8 * i; v[i] = *(const f32x4*)(W + (size_t)(k0 + kk) * N + n0 + 4 * (lane & 7)); gk[i] = g ? g[k0 + kk] : 1.0f; }
#pragma unroll
        for (int i = 0; i < 8; ++i) { const int kk = (lane >> 3) + 8 * i; LAS float* d = scr + kk * 33 + 4 * (lane & 7); d[0] = v[i][0] * gk[i]; d[1] = v[i][1] * gk[i]; d[2] = v[i][2] * gk[i]; d[3] = v[i][3] * gk[i]; }
    }
    LDS_WAIT(); asm volatile("" ::: "memory");
    const int c = lane & 7;
#pragma unroll
    for (int j = 0; j < 4; ++j) { const int n = (lane >> 3) + 8 * j; const LAS float* s = scr + (8 * c) * 33 + n;
        u32x4 o; o.x = pk2(s[0 * 33], s[1 * 33]); o.y = pk2(s[2 * 33], s[3 * 33]); o.z = pk2(s[4 * 33], s[5 * 33]); o.w = pk2(s[6 * 33], s[7 * 33]);
        const int nn = n0 + n; int row;
        if (rowmode == 0) row = nn;
        else if (rowmode == 3) { const int d = nn & 63; row = (nn < 1024 && d < 16) ? ((nn & ~15) + 8 * ((d >> 2) & 1) + 4 * (d >> 3) + (d & 3)) : nn; }
        else row = 256 * (nn >> 7) + (nn & 127) + (rowmode == 2 ? 128 : 0);
        *(u32x4*)(WT + (size_t)row * K + k0 + 8 * c) = o; }
    LDS_WAIT(); asm volatile("" ::: "memory");
}
__device__ __forceinline__ void xrow_to_bf16(const float* xrow, bf16_t* orow, float* ssq16, int lane) {
    f32x4 v[4]; float s = 0.f;
    if (xrow) {
        const f32x4* xr = (const f32x4*)xrow + lane;
#pragma unroll
        for (int j = 0; j < 4; ++j) { v[j] = xr[64 * j]; s += (v[j].x * v[j].x + v[j].y * v[j].y) + (v[j].z * v[j].z + v[j].w * v[j].w); }
    } else {
#pragma unroll
        for (int j = 0; j < 4; ++j) v[j] = (f32x4){0.f, 0.f, 0.f, 0.f};
    }
    s = wave_sum(s);
    unsigned long long* o8 = (unsigned long long*)orow + lane;
#pragma unroll
    for (int j = 0; j < 4; ++j) o8[64 * j] = (unsigned long long)pk2(v[j].x, v[j].y) | ((unsigned long long)pk2(v[j].z, v[j].w) << 32);
    if (lane < 16) ssq16[lane] = (lane == 0) ? s : 0.f;
}
__device__ __forceinline__ void sincos_d(double x, float& c, float& s) {
    const double k = __builtin_rint(x * 0.6366197723675814);
    double r = __builtin_fma(-k, 1.5707963267948966, x); r = __builtin_fma(-k, 6.123233995736766e-17, r);
    const int q = ((int)k) & 3;
    const double r2 = r * r;
    double sp = -7.6471637318198164759e-13; sp = sp * r2 + 1.6059043836821614599e-10; sp = sp * r2 - 2.5052108385441718775e-08; sp = sp * r2 + 2.7557319223985890653e-06;
    sp = sp * r2 - 1.9841269841269841270e-04; sp = sp * r2 + 8.3333333333333333333e-03; sp = sp * r2 - 1.6666666666666666667e-01; const double sn = r + r * r2 * sp;
    double cp = 4.7794773323873852974e-14; cp = cp * r2 - 1.1470745597729724714e-11; cp = cp * r2 + 2.0876756987868098979e-09; cp = cp * r2 - 2.7557319223985890653e-07;
    cp = cp * r2 + 2.4801587301587301587e-05; cp = cp * r2 - 1.3888888888888888889e-03; cp = cp * r2 + 4.1666666666666666667e-02; cp = cp * r2 - 0.5; const double cn = 1.0 + r2 * cp;
    const double sv = (q == 0) ? sn : (q == 1) ? cn : (q == 2) ? -sn : -cn;
    const double cv = (q == 0) ? cn : (q == 1) ? -sn : (q == 2) ? -cn : sn;
    c = (float)cv; s = (float)sv;
}

constexpr int WCV_I_IN = (DM / 64) * (DIN / 32), WCV_I_OUT = (DM / 64) * (DM / 32), WCV_I_F = (DM / 64) * (DFF / 32), WCV_I_D = (DFF / 64) * (DM / 32);
constexpr int WCV_I_LAYER = WCV_I_IN + WCV_I_OUT + 2 * WCV_I_F + WCV_I_D, WCV_TOTAL = NLAYER * WCV_I_LAYER, WCV_FIRST = WCV_I_LAYER;
__device__ __forceinline__ void weight_convert_items(const Args& a, LAS float* scr, int it0, int it1, int gw, int ngw, int lane) {
    unsigned char* ws = a.ws;
    for (int it = it0 + gw; it < it1; it += ngw) {
        const int l = it / WCV_I_LAYER; int r = it % WCV_I_LAYER;
        unsigned char* wl = ws + WS_W + (size_t)l * W_LAYER;
        if (r < WCV_I_IN) { transpose_item(a.in[7] + (size_t)l * DM * DIN, DM, DIN, (bf16_t*)(wl + W_IN), r, a.in[6] + l * DM, 3, scr, lane); continue; } r -= WCV_I_IN;
        if (r < WCV_I_OUT) { transpose_item(a.in[15] + (size_t)l * DM * DM, DM, DM, (bf16_t*)(wl + W_OUT), r, nullptr, 0, scr, lane); continue; } r -= WCV_I_OUT;
        if (r < WCV_I_F) { transpose_item(a.in[17] + (size_t)l * DM * DFF, DM, DFF, (bf16_t*)(wl + W_GU), r, a.in[16] + l * DM, 1, scr, lane); continue; } r -= WCV_I_F;
        if (r < WCV_I_F) { transpose_item(a.in[18] + (size_t)l * DM * DFF, DM, DFF, (bf16_t*)(wl + W_GU), r, a.in[16] + l * DM, 2, scr, lane); continue; } r -= WCV_I_F;
        transpose_item(a.in[19] + (size_t)l * DFF * DM, DFF, DM, (bf16_t*)(wl + W_FD), r, nullptr, 0, scr, lane);
    }
}
__device__ __forceinline__ void phase_prologue(const Args& a, LAS unsigned char* lds) {
    const int tid = pg8::opaque_tid(), lane = tid & 63, wave = __builtin_amdgcn_readfirstlane(tid >> 6);
    const int G = gridDim.x, gw = blockIdx.x * 8 + wave, NGW = G * 8;
    LAS float* scr = (LAS float*)(lds + wave * 16384);
    unsigned char* ws = a.ws;
    weight_convert_items(a, scr, 0, WCV_FIRST, gw, NGW, lane);
    {
        bf16_t* XBA = (bf16_t*)(ws + WS_XBA); float* ssq0 = (float*)(ws + WS_SSQP);
        for (int m = gw; m < MTOT; m += NGW) {
            const float* xr = (m < MP) ? (a.in[0] + (size_t)m * DM) : (m < MROWS) ? (a.in[1] + (size_t)(m - MP) * DM) : nullptr;
            xrow_to_bf16(xr, XBA + (size_t)m * DM, ssq0 + (size_t)m * 16, lane);
        }
    }
    const int gt = blockIdx.x * 512 + tid, NGT = G * 512;
    {
        float* rope = (float*)(ws + WS_ROPE);
        for (int e = gt; e < ROPE_ROWS * 8; e += NGT) {
            const int pos = e >> 3, i = e & 7;
            const double inv = (i == 0) ? 1.0 : (i == 1) ? 0.19392274474868576 : (i == 2) ? 0.03760603093086393 : (i == 3) ? 0.007292664737217109 :
                               (i == 4) ? 0.001414213562373095 : (i == 5) ? 0.0002742481756762073 : (i == 6) ? 5.318295896944988e-05 : 1.031338537721246e-05;
            float c, s; sincos_d((double)pos * inv, c, s);
            rope[(size_t)pos * 16 + i] = c; rope[(size_t)pos * 16 + 8 + i] = s;
        }
    }
    {
        bf16_t* wgt = (bf16_t*)(ws + WS_WGT);
        for (int e = gt; e < NLAYER * 2 * 8 * 64 * 64; e += NGT) {
            const int c = e & 63, d = (e >> 6) & 63, n = (e >> 12) & 7, gate = (e >> 15) & 1, l = e >> 16;
            const float* src = a.in[gate ? 12 : 10] + (size_t)((l * 8 + n) * 64 + c) * 64 + d;
            wgt[e] = (bf16_t)f2bf(*src);
        }
        float* sp = (float*)(ws + WS_SP);
        for (int e = gt; e < NLAYER * DR; e += NGT) { const float lam = a.in[14][e]; const float y = expf(-lam); sp[e] = (y < 0.03f) ? y * (1.0f - y * (0.5f - y * (0.33333333f - y * (0.25f - 0.2f * y)))) : logf(1.0f + y); }
    }
}

namespace cpy {
constexpr unsigned CR = 14, CPB = (unsigned)(WBUF - NT) * 2u / CR;
static_assert((WBUF - NT) * 2 % CR == 0, "copy chunking");
constexpr unsigned NCHUNKS = 2u * NLAYER * NB * CPB;
constexpr int LDS_NEXT = MISC_OFF + 128;
#ifndef CPQ_G1A
#define CPQ_G1A 8u
#endif
#ifndef CPQ_G1B
#define CPQ_G1B 18u
#endif
#ifndef CPQ_G3
#define CPQ_G3 32u
#endif
constexpr unsigned BG_G1_WGS = 32, BG_G3_WGS = 8;
constexpr unsigned Q_G1A = CPQ_G1A, Q_G1B = CPQ_G1B, Q_G3 = CPQ_G3;
static_assert(Q_G1A % 2 == 0 && Q_G1B % 2 == 0 && Q_G3 % 2 == 0, "stream() moves two chunks per trip");
constexpr unsigned C1 = BG_G1_WGS * 8u * Q_G1A, C2 = C1 + BG_G3_WGS * 8u * Q_G3, C3 = C2 + BG_G1_WGS * 8u * Q_G1B, PIGGY0 = C3 + BG_G3_WGS * 8u * Q_G3;
static_assert(PIGGY0 <= NCHUNKS, "copy quotas");
struct Bg {
    const float* ck; const float* cv; float* out; LAS unsigned char* lds;
    struct Regs { f32x4 v[CR]; unsigned id, nxt; };
    __device__ __forceinline__ void addr(unsigned c, const char*& src, char*& dst) const {
        const unsigned t = c / (NLAYER * NB * CPB), rr = c - t * (NLAYER * NB * CPB), blk = rr / CPB, k = rr - blk * CPB;
        src = (const char*)(t ? cv : ck) + (size_t)blk * (WBUF * 2048u) + NT * 2048u + (size_t)k * (CR * 1024u);
        dst = (char*)(out + (t ? O_SV : O_SK)) + (size_t)blk * (WBUF * 2048u) + (size_t)k * (CR * 1024u);
    }
    __device__ __forceinline__ void begin(Regs& r) const {
        const int tid = pg8::opaque_tid(), lane = tid & 63, w = __builtin_amdgcn_readfirstlane(tid >> 6);
        const unsigned k = (unsigned)__builtin_amdgcn_readfirstlane(((volatile LAS unsigned*)(lds + LDS_NEXT))[w]);
        const unsigned id = PIGGY0 + (blockIdx.x * 8u + (unsigned)w) + k * (gridDim.x * 8u);
        r.id = id < NCHUNKS ? id : NCHUNKS - 1u; r.nxt = id < NCHUNKS ? 1u : 0u;
        const char* s; char* d; addr(r.id, s, d);
#pragma unroll
        for (int i = 0; i < (int)CR; ++i) r.v[i] = __builtin_nontemporal_load((const f32x4*)(s + i * 1024) + lane);
        if (lane == 0) ((LAS unsigned*)(lds + LDS_NEXT))[w] = k + 1u;
    }
    __device__ __forceinline__ void end(Regs& r) const {
        const int lane = pg8::opaque_tid() & 63;
        const char* s; char* d; addr(r.id, s, d);
#pragma unroll
        for (int i = 0; i < (int)CR; ++i) __builtin_nontemporal_store(r.v[i], (f32x4*)(d + i * 1024) + lane);
    }
    __device__ __forceinline__ void prime(Regs& r) const { begin(r); }
    __device__ __forceinline__ void rotate(Regs& r) const { end(r); begin(r); }
    __device__ __forceinline__ void stream(unsigned c0, unsigned n) const {
        const int lane = pg8::opaque_tid() & 63;
        for (unsigned c = c0; c < c0 + n; c += 2) {
            f32x4 va[CR], vb[CR];
            const char *sa, *sb; char *da, *db; addr(c, sa, da); addr(c + 1, sb, db);
#pragma unroll
            for (int i = 0; i < (int)CR; ++i) va[i] = __builtin_nontemporal_load((const f32x4*)(sa + i * 1024) + lane);
#pragma unroll
            for (int i = 0; i < (int)CR; ++i) vb[i] = __builtin_nontemporal_load((const f32x4*)(sb + i * 1024) + lane);
#pragma unroll
            for (int i = 0; i < (int)CR; ++i) __builtin_nontemporal_store(va[i], (f32x4*)(da + i * 1024) + lane);
#pragma unroll
            for (int i = 0; i < (int)CR; ++i) __builtin_nontemporal_store(vb[i], (f32x4*)(db + i * 1024) + lane);
        }
    }
    __device__ __forceinline__ void drain() const {
        Regs r;
        for (;;) { begin(r); end(r); LDS_WAIT(); if (!r.nxt) break; }
    }
};
}

namespace att {
constexpr int KCH = 6144;
constexpr int K_OFF = 0, V_OFF = 8 * KCH, VHALF = 384 * 64, WS_OFF = V_OFF + 2 * VHALF, OST_OFF = WS_OFF + 8 * 256, LDS_END = OST_OFF + 8 * 4096;
static_assert(LDS_END <= MISC_OFF, "attention LDS map");
typedef short v4i16_t __attribute__((ext_vector_type(4)));
__device__ __forceinline__ s16x4 vtr(const LAS unsigned char* p) { return __builtin_bit_cast(s16x4, __builtin_amdgcn_ds_read_tr16_b64_v4i16((LAS v4i16_t*)p)); }
__device__ __forceinline__ int crow(int r, int hi) { return (r & 3) + 8 * (r >> 2) + 4 * hi; }

template <class Bg> __device__ __forceinline__ void unit(LAS unsigned char* lds, const bf16_t* Q, const bf16_t* K, const bf16_t* V, bf16_t* O, float* LSE, int dsh, int r, int jb, int h, const Bg& B, typename Bg::Regs& bgr) {
    const int tid = pg8::opaque_tid(), lane = tid & 63, r32 = lane & 31, hi = lane >> 5;
    const int w = __builtin_amdgcn_readfirstlane(tid >> 6);
    const int i0 = jb * 256, kb = i0 - 128;
#pragma unroll
    for (int t = 0; t < 6; ++t) {
        int idx = kb + 64 * t + lane; idx = idx < 0 ? 0 : idx;
        const size_t tok = ((size_t)idx << dsh) + r;
        __builtin_amdgcn_global_load_lds((const unsigned*)(K + tok * 512 + h * 64 + w * 8), (LAS unsigned*)(lds + K_OFF + w * KCH + t * 1024), 16, 0, 0);
    }
#pragma unroll
    for (int t = 0; t < 6; ++t) {
        const int p = w * 6 + t, dh = p / 24, rg = p % 24;
        int idx = kb + 16 * rg + (lane >> 2); idx = idx < 0 ? 0 : idx;
        const size_t tok = ((size_t)idx << dsh) + r;
        __builtin_amdgcn_global_load_lds((const unsigned*)(V + tok * 512 + h * 64 + dh * 32 + (lane & 3) * 8), (LAS unsigned*)(lds + V_OFF + dh * VHALF + rg * 1024), 16, 0, 0);
    }
    const size_t qtok = ((size_t)(i0 + 32 * w + r32) << dsh) + r;
    bf16x8 qr[4];
#pragma unroll
    for (int d0 = 0; d0 < 4; ++d0) qr[d0] = *(const bf16x8*)(Q + qtok * 512 + h * 64 + d0 * 16 + hi * 8);
    VM_WAIT();
    __syncthreads();
    B.rotate(bgr);
    const float NEG = -INFINITY;
#define ATT_SCORES(s, acc) do { const LAS unsigned char* kp_ = lds + K_OFF + hi * KCH + (32 * (w + (s)) + r32) * 16; \
        acc = (f32x16){0.f, 0.f, 0.f, 0.f, 0.f, 0.f, 0.f, 0.f, 0.f, 0.f, 0.f, 0.f, 0.f, 0.f, 0.f, 0.f}; \
        _Pragma("unroll") for (int d0 = 0; d0 < 4; ++d0) { const bf16x8 kf_ = *(const LAS bf16x8*)(kp_ + d0 * 2 * KCH); acc = __builtin_amdgcn_mfma_f32_32x32x16_bf16(kf_, qr[d0], acc, 0, 0, 0); } \
          \
        if ((s) == 0) { _Pragma("unroll") for (int rr = 0; rr < 16; ++rr) if (crow(rr, hi) < r32) acc[rr] = NEG; } \
        if ((s) == 4) { _Pragma("unroll") for (int rr = 0; rr < 16; ++rr) if (crow(rr, hi) > r32) acc[rr] = NEG; } \
        if (jb == 0 && (s) < 4 && w + (s) <= 3) { _Pragma("unroll") for (int rr = 0; rr < 16; ++rr) acc[rr] = NEG; } } while (0)
    float mx = NEG;
#pragma unroll
    for (int s = 0; s < 5; ++s) {
        f32x16 sc; ATT_SCORES(s, sc);
#pragma unroll
        for (int rr = 0; rr < 16; ++rr) mx = fmaxf(mx, sc[rr]);
        __builtin_amdgcn_sched_barrier(0);
    }
    mx = fmaxf(mx, __shfl_xor(mx, 32));
    float ls = 0.f;
    f32x16 o[2];
    o[0] = (f32x16){0.f, 0.f, 0.f, 0.f, 0.f, 0.f, 0.f, 0.f, 0.f, 0.f, 0.f, 0.f, 0.f, 0.f, 0.f, 0.f}; o[1] = o[0];
    const LAS unsigned char* vb = lds + V_OFF + ((lane >> 4) & 1) * 32 + (lane & 3) * 8 + (4 * hi + ((lane & 15) >> 2)) * 64;
#pragma unroll
    for (int s = 0; s < 5; ++s) {
        f32x16 p; ATT_SCORES(s, p);
#pragma unroll
        for (int rr = 0; rr < 16; ++rr) { const float e = fexp2(p[rr] - mx); p[rr] = e; ls += e; }
#pragma unroll
        for (int ks = 0; ks < 2; ++ks) {
            u32x4 pw; pw.x = cvtpk(p[8 * ks + 0], p[8 * ks + 1]); pw.y = cvtpk(p[8 * ks + 2], p[8 * ks + 3]); pw.z = cvtpk(p[8 * ks + 4], p[8 * ks + 5]); pw.w = cvtpk(p[8 * ks + 6], p[8 * ks + 7]);
            const bf16x8 pa = __builtin_bit_cast(bf16x8, pw);
            const LAS unsigned char* vrow = vb + (32 * (w + s) + 16 * ks) * 64;
#pragma unroll
            for (int d0 = 0; d0 < 2; ++d0) {
                const s16x4 lo = vtr(vrow + d0 * VHALF), hh = vtr(vrow + d0 * VHALF + 512);
                const bf16x8 vf = {lo[0], lo[1], lo[2], lo[3], hh[0], hh[1], hh[2], hh[3]};
                o[d0] = __builtin_amdgcn_mfma_f32_32x32x16_bf16(pa, vf, o[d0], 0, 0, 0);
            }
        }
        __builtin_amdgcn_sched_barrier(0);
    }
#undef ATT_SCORES
    ls += __shfl_xor(ls, 32);
    LAS float* wsf = (LAS float*)(lds + WS_OFF) + w * 64;
    if (hi == 0) wsf[r32] = ls;
    LDS_WAIT();
    LAS bf16_t* stg = (LAS bf16_t*)(lds + OST_OFF) + w * 2048;
#pragma unroll
    for (int rr = 0; rr < 16; ++rr) {
        const int orow = crow(rr, hi); const float rl = frcp(wsf[orow]);
        stg[orow * 64 + r32] = (bf16_t)f2bf(o[0][rr] * rl); stg[orow * 64 + 32 + r32] = (bf16_t)f2bf(o[1][rr] * rl);
    }
    LDS_WAIT();
#pragma unroll
    for (int i = 0; i < 4; ++i) {
        const int row = i * 8 + (lane >> 3), ch = lane & 7;
        const u32x4 v = *(const LAS u32x4*)(stg + row * 64 + ch * 8);
        const size_t tok = ((size_t)(i0 + 32 * w + row) << dsh) + r;
        *(u32x4*)(O + tok * 512 + h * 64 + ch * 8) = v;
    }
    if (hi == 0) LSE[qtok * 8 + h] = mx + __builtin_amdgcn_logf(ls);
    LDS_WAIT();
    __syncthreads();
}
}

namespace rg {
constexpr int XC_STRIDE = 1040;
constexpr int XC_BYTES = 64 * XC_STRIDE;
constexpr int NCHUNK = MP / 64;
__device__ __forceinline__ int crow(int r, int hi) { return (r & 3) + 8 * (r >> 2) + 4 * hi; }
__device__ __forceinline__ float expm1_(float x) {
    const float p = x * (1.0f + x * (0.5f + x * (0.16666667f + x * (0.041666668f + x * (0.008333334f + x * 0.0013888889f)))));
    return (x > -0.25f) ? p : (expf(x) - 1.0f);
}
__device__ __forceinline__ void task(LAS unsigned char* lds, const Args& a, int l, int tk) {
    const int tid = pg8::opaque_tid(), lane = tid & 63, r32 = lane & 31, hi = lane >> 5;
    const int w = __builtin_amdgcn_readfirstlane(tid >> 6);
    unsigned char* ws = a.ws;
    const bf16_t* XR = (const bf16_t*)(ws + WS_XR);
    bf16_t* HL = (bf16_t*)(ws + WS_HL); bf16_t* CA = (bf16_t*)(ws + WS_CA);
    const bf16_t* WT = (const bf16_t*)(ws + WS_WGT) + (size_t)l * (2 * 8 * 64 * 64);
    const float* cw = a.in[8] + l * 4 * DR; const float* cbias = a.in[9] + l * DR;
    const float* bga = a.in[11] + l * DR; const float* bgx = a.in[13] + l * DR; const float* sp = (const float*)(ws + WS_SP) + l * DR;
    float* AGGA = (float*)(ws + WS_AGGA) + (size_t)l * NCHUNK * DR; float* AGGH = (float*)(ws + WS_AGGH) + (size_t)l * NCHUNK * DR; float* CARRY = (float*)(ws + WS_CARRY) + (size_t)l * NCHUNK * DR;
    const int tg = tid >> 6, cg = tid & 63;
    const int t0 = tk * 64;
    {
        float cwj[4][8], cbv[8];
#pragma unroll
        for (int j = 0; j < 4; ++j) { const f32x4 x0 = *(const f32x4*)(cw + j * DR + cg * 8), x1 = *(const f32x4*)(cw + j * DR + cg * 8 + 4);
#pragma unroll
            for (int e = 0; e < 4; ++e) { cwj[j][e] = x0[e]; cwj[j][4 + e] = x1[e]; } }
        { const f32x4 x0 = *(const f32x4*)(cbias + cg * 8), x1 = *(const f32x4*)(cbias + cg * 8 + 4);
#pragma unroll
            for (int e = 0; e < 4; ++e) { cbv[e] = x0[e]; cbv[4 + e] = x1[e]; } }
        u32x4 raw[11];
#pragma unroll
        for (int j = 0; j < 11; ++j) { const int t = t0 + 8 * tg - 3 + j; raw[j] = (t >= 0) ? *(const u32x4*)(XR + (size_t)t * 512 + cg * 8) : (u32x4){0u, 0u, 0u, 0u}; }
#pragma unroll
        for (int tt = 0; tt < 8; ++tt) {
            float xc[8];
#pragma unroll
            for (int e = 0; e < 8; ++e) xc[e] = cbv[e];
#pragma unroll
            for (int j = 0; j < 4; ++j) {
                const u32x4 rw = raw[tt + j];
#pragma unroll
                for (int e2 = 0; e2 < 4; ++e2) { const unsigned wv = rw[e2]; xc[2 * e2] += cwj[j][2 * e2] * __builtin_bit_cast(float, wv << 16); xc[2 * e2 + 1] += cwj[j][2 * e2 + 1] * __builtin_bit_cast(float, wv & 0xffff0000u); }
            }
            u32x4 o; o.x = cvtpk(xc[0], xc[1]); o.y = cvtpk(xc[2], xc[3]); o.z = cvtpk(xc[4], xc[5]); o.w = cvtpk(xc[6], xc[7]);
            *(LAS u32x4*)(lds + (8 * tg + tt) * XC_STRIDE + cg * 16) = o;
        }
    }
    LDS_WAIT();
    __syncthreads();
#pragma unroll
    for (int nt = 0; nt < 2; ++nt) {
        const int c = 64 * w + 32 * nt + r32;
        f32x16 ar[2], ab[2];
#pragma unroll
        for (int mt = 0; mt < 2; ++mt) { ar[mt] = (f32x16){0.f, 0.f, 0.f, 0.f, 0.f, 0.f, 0.f, 0.f, 0.f, 0.f, 0.f, 0.f, 0.f, 0.f, 0.f, 0.f}; ab[mt] = ar[mt]; }
#pragma unroll
        for (int ks = 0; ks < 4; ++ks) {
            const bf16x8 ba = *(const bf16x8*)(WT + ((size_t)(0 * 8 + w) * 64 + 32 * nt + r32) * 64 + 16 * ks + 8 * hi);
            const bf16x8 bx = *(const bf16x8*)(WT + ((size_t)(1 * 8 + w) * 64 + 32 * nt + r32) * 64 + 16 * ks + 8 * hi);
#pragma unroll
            for (int mt = 0; mt < 2; ++mt) {
                const bf16x8 af = *(const LAS bf16x8*)(lds + (32 * mt + r32) * XC_STRIDE + (64 * w + 16 * ks + 8 * hi) * 2);
                ar[mt] = __builtin_amdgcn_mfma_f32_32x32x16_bf16(af, ba, ar[mt], 0, 0, 0);
                ab[mt] = __builtin_amdgcn_mfma_f32_32x32x16_bf16(af, bx, ab[mt], 0, 0, 0);
            }
        }
        const float vbga = bga[c] * -1.4426950408889634f, vbgx = bgx[c] * -1.4426950408889634f, vsp2 = sp[c] * (-8.0f * 1.4426950408889634f);
        LAS bf16_t* stg = (LAS bf16_t*)(lds + XC_BYTES) + w * 4096;
        LAS bf16_t* stgw = stg + 4 * hi * 32 + r32;
#pragma unroll
        for (int mt = 0; mt < 2; ++mt)
#pragma unroll
            for (int rr = 0; rr < 16; ++rr) {
                const int tkn = 32 * mt + crow(rr, hi);
                const float xcv = bf2f(*(const LAS bf16_t*)(lds + tkn * XC_STRIDE + c * 2));
                const float rg_ = frcp(1.0f + fexp2(ar[mt][rr] * -1.4426950408889634f + vbga)), ig_ = frcp(1.0f + fexp2(ab[mt][rr] * -1.4426950408889634f + vbgx));
                const float av = fexp2(rg_ * vsp2);
                const float bv = sqrtf(fmaxf(1.0f - av * av, 0.f)) * (ig_ * xcv);
                ar[mt][rr] = av; ab[mt][rr] = bv;
            }
        float GA[8], GH[8];
#pragma unroll
        for (int mt = 0; mt < 2; ++mt)
#pragma unroll
            for (int k = 0; k < 4; ++k) {
                float A = 1.f, H = 0.f;
#pragma unroll
                for (int e = 0; e < 4; ++e) { const float av = ar[mt][4 * k + e], bv = ab[mt][4 * k + e]; H = av * H + bv; A = A * av; ar[mt][4 * k + e] = A; ab[mt][4 * k + e] = H; }
                GA[mt * 4 + k] = A; GH[mt * 4 + k] = H;
            }
        float OA[8], OH[8];
#pragma unroll
        for (int q = 0; q < 8; ++q) { OA[q] = __shfl_xor(GA[q], 32); OH[q] = __shfl_xor(GH[q], 32); }
        float curH = 0.f, curA = 1.f;
#pragma unroll
        for (int mt = 0; mt < 2; ++mt)
#pragma unroll
            for (int k = 0; k < 4; ++k) {
                const int q = mt * 4 + k;
                const float ga0 = hi ? OA[q] : GA[q], gh0 = hi ? OH[q] : GH[q];
                const float ga1 = hi ? GA[q] : OA[q], gh1 = hi ? GH[q] : OH[q];
                const float midH = gh0 + ga0 * curH, midA = curA * ga0;
                const float cinH = hi ? midH : curH, cinA = hi ? midA : curA;
#pragma unroll
                for (int e = 0; e < 4; ++e) {
                    const float Al = ar[mt][4 * k + e], Hl = ab[mt][4 * k + e];
                    const float hv = Hl + Al * cinH, cav = Al * cinA;
                    stgw[(32 * mt + 8 * k + e) * 32] = (bf16_t)f2bf(hv); stgw[2048 + (32 * mt + 8 * k + e) * 32] = (bf16_t)f2bf(cav);
                }
                curH = gh1 + ga1 * midH; curA = midA * ga1;
            }
        if (hi == 0) { AGGA[(size_t)tk * DR + c] = curA; AGGH[(size_t)tk * DR + c] = curH; }
        LDS_WAIT();
#pragma unroll
        for (int i = 0; i < 4; ++i) {
            const int row = i * 16 + (lane >> 2), seg = lane & 3;
            const u32x4 vh = *(const LAS u32x4*)(stg + row * 32 + seg * 8), vc = *(const LAS u32x4*)(stg + 2048 + row * 32 + seg * 8);
            const size_t off = (size_t)(t0 + row) * 512 + 64 * w + 32 * nt + seg * 8;
            *(u32x4*)(HL + off) = vh; *(u32x4*)(CA + off) = vc;
        }
        LDS_WAIT();
    }
    float* PREA = (float*)(ws + WS_PREA) + (size_t)l * NCHUNK * DR; float* PREH = CARRY;
    float* GA_ = (float*)(ws + WS_GAGG) + (size_t)l * 3 * 16 * DR; float* GH_ = GA_ + 16 * DR; float* GC_ = GA_ + 32 * DR;
    unsigned* ctr = (unsigned*)(ws + WS_CTL) + CW_RG;
    const int grp = tk >> 4;
    VM_WAIT();
    __syncthreads();
    volatile LAS unsigned* flag = (volatile LAS unsigned*)(lds + MISC_OFF + 64);
    if (tid == 0) {
        __builtin_amdgcn_fence(__ATOMIC_RELEASE, "agent");
        asm volatile("s_waitcnt vmcnt(0)" ::: "memory");
        const unsigned old = __hip_atomic_fetch_add(ctr + 128 + 64 * (16 * l + grp), 1u, __ATOMIC_RELAXED, __HIP_MEMORY_SCOPE_AGENT);
        const unsigned last = (old == 15u) ? 1u : 0u;
        if (last) { __builtin_amdgcn_fence(__ATOMIC_ACQUIRE, "agent"); asm volatile("s_waitcnt vmcnt(0)" ::: "memory"); }
        flag[0] = last;
    }
    LDS_WAIT();
    __syncthreads();
    if (flag[0]) {
        float va[16], vh[16];
#pragma unroll
        for (int j = 0; j < 16; ++j) { va[j] = AGGA[(size_t)(16 * grp + j) * DR + tid]; vh[j] = AGGH[(size_t)(16 * grp + j) * DR + tid]; }
        float A = 1.f, H = 0.f;
#pragma unroll
        for (int j = 0; j < 16; ++j) { PREA[(size_t)(16 * grp + j) * DR + tid] = A; PREH[(size_t)(16 * grp + j) * DR + tid] = H; H = vh[j] + va[j] * H; A = A * va[j]; }
        GA_[grp * DR + tid] = A; GH_[grp * DR + tid] = H;
        VM_WAIT();
        __syncthreads();
        if (tid == 0) {
            __builtin_amdgcn_fence(__ATOMIC_RELEASE, "agent");
            asm volatile("s_waitcnt vmcnt(0)" ::: "memory");
            const unsigned old = __hip_atomic_fetch_add(ctr + 64 * l, 1u, __ATOMIC_RELAXED, __HIP_MEMORY_SCOPE_AGENT);
            const unsigned last = (old == 15u) ? 1u : 0u;
            if (last) { __builtin_amdgcn_fence(__ATOMIC_ACQUIRE, "agent"); asm volatile("s_waitcnt vmcnt(0)" ::: "memory"); }
            flag[1] = last;
        }
        LDS_WAIT();
        __syncthreads();
        if (flag[1]) {
            float ga[16], gh[16];
#pragma unroll
            for (int j = 0; j < 16; ++j) { ga[j] = GA_[j * DR + tid]; gh[j] = GH_[j * DR + tid]; }
            float h = 0.f;
#pragma unroll
            for (int j = 0; j < 16; ++j) { GC_[j * DR + tid] = h; h = gh[j] + ga[j] * h; }
            a.out[O_PH + (size_t)l * DR + tid] = h;
        }
    }
    __syncthreads();
}
}

__device__ __forceinline__ void phase_fin(const Args& a, int l, int wg, int nwg) {
    unsigned char* ws = a.ws;
    const bf16_t* OG = (const bf16_t*)(ws + WS_OG); const float* LSE = (const float*)(ws + WS_LSE);
    const bf16_t* HL = (const bf16_t*)(ws + WS_HL); const bf16_t* CA = (const bf16_t*)(ws + WS_CA); const bf16_t* GY = (const bf16_t*)(ws + WS_GY);
    const float* CARRY = (const float*)(ws + WS_CARRY) + (size_t)l * rg::NCHUNK * DR;
    const float* PREA = (const float*)(ws + WS_PREA) + (size_t)l * rg::NCHUNK * DR; const float* GC = (const float*)(ws + WS_GAGG) + (size_t)l * 3 * 16 * DR + 32 * DR;
    bf16_t* MIX = (bf16_t*)(ws + WS_MIX);
    const size_t gt = (size_t)wg * 512 + pg8::opaque_tid(), NGT = (size_t)nwg * 512;
    for (size_t it = gt; it < (size_t)MP * 128; it += NGT) {
        const int tok = (int)(it >> 7), grp = (int)(it & 127);
#ifdef DBG_NO_ATT
        if (grp < 64) { *(u32x4*)(MIX + (size_t)tok * DM + grp * 8) = (u32x4){0u, 0u, 0u, 0u}; continue; }
#endif
#ifdef DBG_NO_RNN
        if (grp >= 64) { *(u32x4*)(MIX + (size_t)tok * DM + grp * 8) = (u32x4){0u, 0u, 0u, 0u}; continue; }
#endif
        if (grp < 64) {
            const int h = grp >> 3;
            const float l0 = LSE[(size_t)tok * 8 + h], l1 = LSE[(size_t)MP * 8 + (size_t)tok * 8 + h], l2 = LSE[(size_t)2 * MP * 8 + (size_t)tok * 8 + h];
            const float m = fmaxf(l0, fmaxf(l1, l2));
            float w0 = fexp2(l0 - m), w1 = fexp2(l1 - m), w2 = fexp2(l2 - m);
            const float inv = frcp(w0 + w1 + w2); w0 *= inv; w1 *= inv; w2 *= inv;
            const size_t off = (size_t)tok * 512 + grp * 8;
            const u32x4 o0 = *(const u32x4*)(OG + off), o1 = *(const u32x4*)(OG + (OG_STRIDE / 2) + off), o2 = *(const u32x4*)(OG + 2 * (OG_STRIDE / 2) + off);
            u32x4 r;
#pragma unroll
            for (int e = 0; e < 4; ++e) {
                const float lo = w0 * __builtin_bit_cast(float, o0[e] << 16) + w1 * __builtin_bit_cast(float, o1[e] << 16) + w2 * __builtin_bit_cast(float, o2[e] << 16);
                const float hh = w0 * __builtin_bit_cast(float, o0[e] & 0xffff0000u) + w1 * __builtin_bit_cast(float, o1[e] & 0xffff0000u) + w2 * __builtin_bit_cast(float, o2[e] & 0xffff0000u);
                r[e] = cvtpk(lo, hh);
            }
            *(u32x4*)(MIX + (size_t)tok * DM + grp * 8) = r;
        } else {
            const int cg = grp - 64;
            const size_t off = (size_t)tok * 512 + cg * 8;
            const u32x4 hl = *(const u32x4*)(HL + off), ca = *(const u32x4*)(CA + off), gy = *(const u32x4*)(GY + off);
            const float* ph_ = CARRY + (size_t)(tok >> 6) * DR + cg * 8; const float* pa_ = PREA + (size_t)(tok >> 6) * DR + cg * 8; const float* gc_ = GC + (size_t)(tok >> 10) * DR + cg * 8;
            const f32x4 c0 = *(const f32x4*)ph_ + *(const f32x4*)pa_ * *(const f32x4*)gc_, c1 = *(const f32x4*)(ph_ + 4) + *(const f32x4*)(pa_ + 4) * *(const f32x4*)(gc_ + 4);
            u32x4 r;
#pragma unroll
            for (int e = 0; e < 4; ++e) {
                const float clo = (e < 2) ? c0[2 * e] : c1[2 * e - 4], chi = (e < 2) ? c0[2 * e + 1] : c1[2 * e - 3];
                const float lo = (__builtin_bit_cast(float, hl[e] << 16) + __builtin_bit_cast(float, ca[e] << 16) * clo) * __builtin_bit_cast(float, gy[e] << 16);
                const float hh = (__builtin_bit_cast(float, hl[e] & 0xffff0000u) + __builtin_bit_cast(float, ca[e] & 0xffff0000u) * chi) * __builtin_bit_cast(float, gy[e] & 0xffff0000u);
                r[e] = cvtpk(lo, hh);
            }
            *(u32x4*)(MIX + (size_t)tok * DM + 512 + cg * 8) = r;
        }
    }
}

__device__ __forceinline__ void dbg_zero_sample_mix(const Args& a, int lo_col, int hi_col) {
    bf16_t* MIX = (bf16_t*)(a.ws + WS_MIX);
    for (size_t i = (size_t)blockIdx.x * 512 + threadIdx.x; i < (size_t)MS * DM; i += (size_t)gridDim.x * 512) { const int c = (int)(i & 1023); if (c >= lo_col && c < hi_col) MIX[(size_t)MP * DM + i] = 0; }
}
namespace sat {
constexpr int NE = 388, NG = 97;
__device__ __forceinline__ const float* row_ptr(const float* cache, const float* fresh, int t, int e) {
    const int ee = e < 387 ? e : 0, g = ee / 129, m = ee - g * 129;
    const int j = WBUF + t - (m << (2 * g));
    return (j >= WBUF) ? (fresh + (size_t)(j - WBUF) * 512) : (cache + (size_t)j * 512);
}
__device__ __forceinline__ void task(LAS unsigned char* lds, const Args& a, int l, int b, int h) {
    const int tid = pg8::opaque_tid(), lane = tid & 63, slot = lane >> 4, d4 = lane & 15;
    const int w = __builtin_amdgcn_readfirstlane(tid >> 6), t = w >> 1, half = w & 1;
    unsigned char* ws = a.ws;
    LAS float* qsh = (LAS float*)lds;
    LAS float* sc = qsh + 256;
    LAS float* sums = sc + 4 * NE;
    LAS float* part = sums + 16;
    if (tid < 256) qsh[tid] = ((const float*)(ws + WS_QS))[(size_t)(b * 4 + (tid >> 6)) * 512 + h * 64 + (tid & 63)] * 0.125f;
    LDS_WAIT();
    __syncthreads();
    const size_t cbase = ((size_t)(l * NB + b) * WBUF) * 512 + h * 64;
    const float* ck = a.in[2] + cbase; const float* cv = a.in[3] + cbase;
    const float* nk = a.out + O_SK + cbase + (size_t)(WBUF - NT) * 512; const float* nv = a.out + O_SV + cbase + (size_t)(WBUF - NT) * 512;
    const f32x4 qv = *(const LAS f32x4*)(qsh + t * 64 + 4 * d4);
    for (int g0 = half; g0 < NG; g0 += 16) {
        f32x4 kv[8];
#pragma unroll
        for (int i = 0; i < 8; ++i) { const int grp = g0 + 2 * i; const int e = 4 * (grp < NG ? grp : 0) + slot; kv[i] = *(const f32x4*)(row_ptr(ck, nk, t, e) + 4 * d4); }
#pragma unroll
        for (int i = 0; i < 8; ++i) {
            const int grp = g0 + 2 * i;
            float s = (kv[i][0] * qv[0] + kv[i][1] * qv[1]) + (kv[i][2] * qv[2] + kv[i][3] * qv[3]);
            s += __shfl_xor(s, 1); s += __shfl_xor(s, 2); s += __shfl_xor(s, 4); s += __shfl_xor(s, 8);
            const int e = 4 * grp + slot;
            if (grp < NG && d4 == 0) sc[t * NE + e] = (e < 387) ? s : -INFINITY;
        }
    }
    LDS_WAIT();
    __syncthreads();
    if (w < 4) {
        float mx = -INFINITY;
        for (int e = lane; e < NE; e += 64) mx = fmaxf(mx, sc[w * NE + e]);
        mx = wave_max(mx);
        float sum = 0.f;
        for (int e = lane; e < NE; e += 64) { const float pe = expf(sc[w * NE + e] - mx); sc[w * NE + e] = pe; sum += pe; }
        sum = wave_sum(sum);
        if (lane == 0) sums[w] = sum;
    }
    LDS_WAIT();
    __syncthreads();
    f32x4 acc = {0.f, 0.f, 0.f, 0.f};
    for (int g0 = half; g0 < NG; g0 += 16) {
        f32x4 vv[8]; float pe[8];
#pragma unroll
        for (int i = 0; i < 8; ++i) { const int grp = g0 + 2 * i; const int e = 4 * (grp < NG ? grp : 0) + slot; vv[i] = *(const f32x4*)(row_ptr(cv, nv, t, e) + 4 * d4); pe[i] = (grp < NG) ? sc[t * NE + e] : 0.f; }
#pragma unroll
        for (int i = 0; i < 8; ++i) acc += vv[i] * pe[i];
    }
#pragma unroll
    for (int c = 0; c < 4; ++c) { acc[c] += __shfl_xor(acc[c], 16); acc[c] += __shfl_xor(acc[c], 32); }
    if (lane < 16) *(LAS f32x4*)(part + w * 64 + 4 * lane) = acc;
    LDS_WAIT();
    __syncthreads();
    if (tid < 256) {
        const int tt = tid >> 6, d = tid & 63;
        const float o = (part[(2 * tt) * 64 + d] + part[(2 * tt + 1) * 64 + d]) / sums[tt];
        ((bf16_t*)(ws + WS_MIX))[(size_t)(MP + b * 4 + tt) * DM + h * 64 + d] = (bf16_t)f2bf(o);
    }
    __syncthreads();
}
}

__device__ __forceinline__ void srglru_task(LAS unsigned char* lds, const Args& a, int l, int b) {
    const int c = pg8::opaque_tid();
    unsigned char* ws = a.ws;
    const float* xrs = (const float*)(ws + WS_XRS) + (size_t)b * 4 * DR;
    const float* sconv = a.in[4] + (size_t)(l * NB + b) * 3 * DR;
    float xp[7];
#pragma unroll
    for (int j = 0; j < 3; ++j) xp[j] = sconv[j * DR + c];
#pragma unroll
    for (int j = 0; j < 4; ++j) xp[3 + j] = xrs[j * DR + c];
    const float* cw = a.in[8] + l * 4 * DR;
    const float w0 = cw[c], w1 = cw[DR + c], w2 = cw[2 * DR + c], w3 = cw[3 * DR + c], cb = a.in[9][l * DR + c];
    float xc[4];
    LAS float* xcs = (LAS float*)lds;
    __syncthreads();
#pragma unroll
    for (int t = 0; t < 4; ++t) { xc[t] = w0 * xp[t] + w1 * xp[t + 1] + w2 * xp[t + 2] + w3 * xp[t + 3] + cb; xcs[t * DR + c] = xc[t]; }
    LDS_WAIT();
    __syncthreads();
    const int n = c >> 6, d = c & 63;
    const float* wa = a.in[10] + (size_t)(l * 8 + n) * 4096 + d; const float* wx = a.in[12] + (size_t)(l * 8 + n) * 4096 + d;
    float pa[4] = {0.f, 0.f, 0.f, 0.f}, px[4] = {0.f, 0.f, 0.f, 0.f};
#pragma unroll 8
    for (int k = 0; k < 64; ++k) {
        const float va = wa[k * 64], vx = wx[k * 64];
#pragma unroll
        for (int t = 0; t < 4; ++t) { const float xv = xcs[t * DR + n * 64 + k]; pa[t] += xv * va; px[t] += xv * vx; }
    }
    const float vbga = a.in[11][l * DR + c], vbgx = a.in[13][l * DR + c], vsp = ((const float*)(ws + WS_SP))[l * DR + c];
    float h = a.in[5][(size_t)(l * NB + b) * DR + c];
    const bf16_t* GY = (const bf16_t*)(ws + WS_GY); bf16_t* MIX = (bf16_t*)(ws + WS_MIX);
#pragma unroll
    for (int t = 0; t < 4; ++t) {
        const float rg_ = 1.0f / (1.0f + expf(-(pa[t] + vbga))), ig_ = 1.0f / (1.0f + expf(-(px[t] + vbgx)));
        const float la = -8.0f * rg_ * vsp;
        const float av = expf(la), bv = sqrtf(-rg::expm1_(2.0f * la)) * (ig_ * xc[t]);
        h = av * h + bv;
        const size_t row = (size_t)MP + b * 4 + t;
        MIX[row * DM + 512 + c] = (bf16_t)f2bf(h * bf2f(GY[row * 512 + c]));
    }
    a.out[O_SH + (size_t)(l * NB + b) * DR + c] = h;
#pragma unroll
    for (int j = 0; j < 3; ++j) a.out[O_SC + ((size_t)(l * NB + b) * 3 + j) * DR + c] = xp[4 + j];
    __syncthreads();
}

__device__ __forceinline__ void phase_final(const Args& a, int wg, int nwg) {
    unsigned char* ws = a.ws;
    const int tid = pg8::opaque_tid(), lane = tid & 63, wave = tid >> 6;
    const int gw = wg * 8 + wave, NGW = nwg * 8;
    const bf16_t* XB = (const bf16_t*)(ws + WS_XBA); const float* ssqp = (const float*)(ws + WS_SSQP + 4 * SSQP_STRIDE);
    const float* gf = a.in[20];
    f32x4 g0[2], g1[2];
#pragma unroll
    for (int j = 0; j < 2; ++j) { g0[j] = *((const f32x4*)gf + 2 * lane + 128 * j); g1[j] = *((const f32x4*)gf + 2 * lane + 128 * j + 1); }
    for (int m = gw; m < MP; m += NGW) {
        const float rs = row_rstd(ssqp, m);
        f32x4* o = (f32x4*)(a.out + O_YP + (size_t)m * DM);
#pragma unroll
        for (int j = 0; j < 2; ++j) {
            const u32x4 xw = *((const u32x4*)(XB + (size_t)m * DM) + lane + 64 * j);
            const f32x4 a0 = {__builtin_bit_cast(float, xw.x << 16), __builtin_bit_cast(float, xw.x & 0xffff0000u), __builtin_bit_cast(float, xw.y << 16), __builtin_bit_cast(float, xw.y & 0xffff0000u)};
            const f32x4 a1 = {__builtin_bit_cast(float, xw.z << 16), __builtin_bit_cast(float, xw.z & 0xffff0000u), __builtin_bit_cast(float, xw.w << 16), __builtin_bit_cast(float, xw.w & 0xffff0000u)};
            o[2 * lane + 128 * j] = a0 * rs * g0[j]; o[2 * lane + 128 * j + 1] = a1 * rs * g1[j];
        }
    }
}
__device__ __forceinline__ void skinny_down(const Args& a, int l) {
    unsigned char* ws = a.ws;
    const int tid = pg8::opaque_tid(), lane = tid & 63, i = lane & 15, kq = lane >> 4;
    const int w = __builtin_amdgcn_readfirstlane(tid >> 6);
    const bf16_t* Hs = (const bf16_t*)(ws + WS_H) + (size_t)MP * DFF;
    const bf16_t* Wt = (const bf16_t*)(ws + WS_W + (size_t)l * W_LAYER + W_FD);
    float* ACC = (float*)(ws + WS_ACC);
    for (int it = blockIdx.x; it < 256; it += gridDim.x) {
        const int ns = it & 31, ks = it >> 5;
        const bf16_t* ap = Hs + (size_t)(16 * w + i) * DFF + ks * 352 + 8 * kq;
        const bf16_t* bp = Wt + (size_t)(32 * ns + i) * DFF + ks * 352 + 8 * kq;
        bf16x8 af[11], b0[11], b1[11];
#pragma unroll
        for (int s = 0; s < 11; ++s) { af[s] = *(const bf16x8*)(ap + 32 * s); b0[s] = *(const bf16x8*)(bp + 32 * s); b1[s] = *(const bf16x8*)(bp + (size_t)16 * DFF + 32 * s); }
        f32x4 c0 = {0.f, 0.f, 0.f, 0.f}, c1 = c0;
#pragma unroll
        for (int s = 0; s < 11; ++s) { c0 = __builtin_amdgcn_mfma_f32_16x16x32_bf16(af[s], b0[s], c0, 0, 0, 0); c1 = __builtin_amdgcn_mfma_f32_16x16x32_bf16(af[s], b1[s], c1, 0, 0, 0); }
        float* o = ACC + (size_t)ks * MS * DM + (size_t)(16 * w + 4 * kq) * DM + 32 * ns + i;
#pragma unroll
        for (int r = 0; r < 4; ++r) { o[(size_t)r * DM] = c0[r]; o[(size_t)r * DM + 16] = c1[r]; }
    }
}
__device__ __forceinline__ void sample_final(const Args& a) {
    unsigned char* ws = a.ws;
    const int tid = pg8::opaque_tid(), lane = tid & 63, wave = tid >> 6;
    const bf16_t* XB = (const bf16_t*)(ws + WS_XBB) + (size_t)MP * DM; const float* ACC = (const float*)(ws + WS_ACC);
    const float* gf = a.in[20];
    for (int s = blockIdx.x * 8 + wave; s < MS; s += gridDim.x * 8) {
        f32x4 v[4]; float ss = 0.f;
#pragma unroll
        for (int j = 0; j < 2; ++j) {
            const u32x4 xw = *((const u32x4*)(XB + (size_t)s * DM) + lane + 64 * j);
            v[2 * j] = (f32x4){__builtin_bit_cast(float, xw.x << 16), __builtin_bit_cast(float, xw.x & 0xffff0000u), __builtin_bit_cast(float, xw.y << 16), __builtin_bit_cast(float, xw.y & 0xffff0000u)};
            v[2 * j + 1] = (f32x4){__builtin_bit_cast(float, xw.z << 16), __builtin_bit_cast(float, xw.z & 0xffff0000u), __builtin_bit_cast(float, xw.w << 16), __builtin_bit_cast(float, xw.w & 0xffff0000u)};
#pragma unroll
            for (int ks = 0; ks < 8; ++ks) { const f32x4* ap = (const f32x4*)(ACC + (size_t)ks * MS * DM + (size_t)s * DM) + 2 * lane + 128 * j; v[2 * j] += ap[0]; v[2 * j + 1] += ap[1]; }
            ss += (v[2 * j].x * v[2 * j].x + v[2 * j].y * v[2 * j].y) + (v[2 * j].z * v[2 * j].z + v[2 * j].w * v[2 * j].w) + (v[2 * j + 1].x * v[2 * j + 1].x + v[2 * j + 1].y * v[2 * j + 1].y) + (v[2 * j + 1].z * v[2 * j + 1].z + v[2 * j + 1].w * v[2 * j + 1].w);
        }
        ss = wave_sum(ss);
        const float rs = 1.0f / sqrtf(ss * (1.0f / DM) + RMS_EPS);
#pragma unroll
        for (int j = 0; j < 2; ++j) { f32x4* o = (f32x4*)(a.out + O_YS + (size_t)s * DM) + 2 * lane + 128 * j; const f32x4* gp = (const f32x4*)gf + 2 * lane + 128 * j; o[0] = v[2 * j] * rs * gp[0]; o[1] = v[2 * j + 1] * rs * gp[1]; }
    }
}

constexpr int N_PHASES = 16;
#ifndef MK_ONE_LAUNCH
#define MK_ONE_LAUNCH 1
#endif

__global__ void __launch_bounds__(512, 2) mk_fwd(Args a_unused) {
    extern __shared__ __attribute__((aligned(16))) unsigned char lds_raw[];
    LAS unsigned char* lds = (LAS unsigned char*)lds_raw;
    { const int tid0 = threadIdx.x; for (int u = tid0; u < (LDS_BYTES - MISC_OFF) / 4; u += 512) ((LAS unsigned*)(lds + MISC_OFF))[u] = 0u; }
    __syncthreads();
#ifndef REPM
#define REPM 0
#endif
#define NREP(b) (((REPM >> (b)) & 1) ? 2 : 1)
#define IN(k) phase_on(k)
#define MAKE_BG(a) const cpy::Bg bg{a.in[2], a.in[3], a.out, lds}
#if MK_ONE_LAUNCH
    { XcdBarrier b0 = xcd_barrier_post((unsigned*)((unsigned char*)kargs()->ws + WS_CTL) + CW_BAR, (volatile LAS unsigned*)(lds + MISC_OFF + 32)); (void)b0; }
#define SEAM(k) do { if (IN(k) && IN((k) + 1)) { XcdBarrier b_; b_.bar = (unsigned*)((unsigned char*)kargs()->ws + WS_CTL) + CW_BAR; b_.x = xb_xcc_id(); b_.st = (volatile LAS unsigned*)(lds + MISC_OFF + 32); xcd_barrier(b_); } } while (0)
#else
#define SEAM(k) do { } while (0)
#endif
    const int bid = (int)blockIdx.x, G = (int)gridDim.x;

#define S_G1(jj, R) do { pg8::Gemm g{(const bf16_t*)(ws + WS_XBA) + (size_t)MP * DM, (const bf16_t*)(wl + W_IN), 256, DIN, DM}; PanelOrder S{jj, R, DIN / 256}; \
        fill_rstd_table(lds, (const float*)(ws + WS_SSQP + (size_t)(l == 0 ? 0 : 2) * SSQP_STRIDE) + (size_t)MP * 16, S); EpiG1 E{lds, ws, a.out, l, MP, true}; \
        pg8::gemm_phase<EpiG1, PanelOrder, true, true>(lds, g, S, E); } while (0)
#define S_G2(jj, R) do { pg8::Gemm g{(const bf16_t*)(ws + WS_MIX) + (size_t)MP * DM, (const bf16_t*)(wl + W_OUT), 256, DM, DM}; PanelOrder S{jj, R, DM / 256}; \
        EpiRes E{l == 0 ? a.in[0] : nullptr, a.in[1], (const bf16_t*)(ws + WS_XBA), (bf16_t*)(ws + WS_XBB), (float*)(ws + WS_SSQP + (size_t)(l == 0 ? 1 : 3) * SSQP_STRIDE), MP, true}; \
        pg8::gemm_phase<EpiRes, PanelOrder, true, true>(lds, g, S, E); } while (0)
#define S_G3(jj, R) do { pg8::Gemm g{(const bf16_t*)(ws + WS_XBB) + (size_t)MP * DM, (const bf16_t*)(wl + W_GU), 256, NGU, DM}; PanelOrder S{jj, R, NGU / 256}; \
        fill_rstd_table(lds, (const float*)(ws + WS_SSQP + (size_t)(l == 0 ? 1 : 3) * SSQP_STRIDE) + (size_t)MP * 16, S); EpiG3 E{lds, (bf16_t*)(ws + WS_H), MP, true}; \
        pg8::gemm_phase<EpiG3, PanelOrder, true, true>(lds, g, S, E); } while (0)
#define S_G4(jj, R, LL) do { unsigned char* wl4_ = ws + WS_W + (size_t)(LL) * W_LAYER; pg8::Gemm g{(const bf16_t*)(ws + WS_H) + (size_t)MP * DFF, (const bf16_t*)(wl4_ + W_FD), 256, DM, DFF}; PanelOrder S{jj, R, DM / 256}; \
        EpiRes E{nullptr, nullptr, (const bf16_t*)(ws + WS_XBB), (bf16_t*)(ws + WS_XBA), (float*)(ws + WS_SSQP + (size_t)((LL) == 0 ? 2 : 4) * SSQP_STRIDE), MP, true}; \
        pg8::gemm_phase<EpiRes, PanelOrder, true, true>(lds, g, S, E); } while (0)

    if (IN(0)) for (int rep_ = 0; rep_ < NREP(0); ++rep_) { LOAD_ARGS(a); MAKE_BG(a); phase_prologue(a, lds); SEAM(0); }
#ifdef DBG_EXTRA_BARRIERS
    for (int eb_ = 0; eb_ < DBG_EXTRA_BARRIERS; ++eb_) { SEAM(0); }
#endif

    for (int l = 0; l < NLAYER; ++l) {
        const int pb = 1 + 6 * l;
        if (IN(pb)) for (int rep_ = 0; rep_ < NREP(1); ++rep_) {
            LOAD_ARGS(a); MAKE_BG(a); unsigned char* ws = a.ws; unsigned char* wl = ws + WS_W + (size_t)l * W_LAYER;
            const int jr = (bid >= G - 8) ? bid - (G - 8) : -1;
            const int NBG = (int)cpy::BG_G1_WGS, GP = G - 8 - NBG;
            if (bid < GP) {
                pg8::Gemm g{(const bf16_t*)(ws + WS_XBA), (const bf16_t*)(wl + W_IN), MP, DIN, DM}; pg8::StaticOrder S; S.init(MP, DIN, GP, bid);
                fill_rstd_table(lds, (const float*)(ws + WS_SSQP + (size_t)(l == 0 ? 0 : 2) * SSQP_STRIDE), S);
                EpiG1 E{lds, ws, a.out, l, 0, false};
                pg8::gemm_phase<EpiG1, pg8::StaticOrder, true, true>(lds, g, S, E);
            }
            if (bid >= GP && bid < G - 8) {
                const int tb = pg8::opaque_tid(), wv = __builtin_amdgcn_readfirstlane(tb >> 6), bw = (bid - GP) * 8 + wv;
                if (l == 0) weight_convert_items(a, (LAS float*)(lds + wv * 16384), WCV_FIRST, WCV_TOTAL, bw, NBG * 8, tb & 63);
                if (l == 0) bg.stream((unsigned)bw * cpy::Q_G1A, cpy::Q_G1A); else bg.stream(cpy::C2 + (unsigned)bw * cpy::Q_G1B, cpy::Q_G1B);
            }
            if (l == 0) { S_G1(jr, 8); }
            if (l == 1) { S_G4(jr, 8, 0); }
            SEAM(pb);
        }
        if (IN(pb + 1)) for (int rep_ = 0; rep_ < NREP(2); ++rep_) {
            LOAD_ARGS(a); MAKE_BG(a); unsigned char* ws = a.ws; unsigned char* wl = ws + WS_W + (size_t)l * W_LAYER;
            const int R = (l == 0) ? 0 : 10, Gp = G - R;
            if (bid < Gp) {
                for (int r2_ = 0; r2_ < NREP(8); ++r2_) for (int t = bid; t < rg::NCHUNK; t += Gp) rg::task(lds, a, l, t);
                if (l == 0 && bid >= 64 && bid < 64 + NB) srglru_task(lds, a, l, bid - 64);
                __syncthreads();
                cpy::Bg::Regs bgr; bg.prime(bgr);
                for (int r2_ = 0; r2_ < NREP(10); ++r2_) for (int u = bid; u < 1536; u += Gp) {
                    const int g = u >> 9, rem = u & 511, h = rem & 7, rj = rem >> 3;
                    const int dsh = 2 * g, bpc = 64 >> dsh, r = rj / bpc, jb = rj % bpc;
                    att::unit(lds, (const bf16_t*)(ws + WS_Q), (const bf16_t*)(ws + WS_K), (const bf16_t*)(ws + WS_V),
                              (bf16_t*)(ws + WS_OG + (size_t)g * OG_STRIDE), (float*)(ws + WS_LSE) + (size_t)g * MP * 8, dsh, r, jb, h, bg, bgr);
                }
                bg.end(bgr);
                __syncthreads();
                if (l == 0) for (int r2_ = 0; r2_ < NREP(11); ++r2_) for (int t = bid; t < NB * NH; t += Gp) sat::task(lds, a, l, t >> 3, t & 7);
            }
            if (l == 1) { S_G1(bid >= Gp ? bid - Gp : -1, 10); }
            SEAM(pb + 1);
        }
        if (IN(pb + 2)) for (int rep_ = 0; rep_ < NREP(3); ++rep_) {
            LOAD_ARGS(a); MAKE_BG(a); unsigned char* ws = a.ws; unsigned char* wl = ws + WS_W + (size_t)l * W_LAYER;
            const int R = (l == 0) ? 4 : 0, Gp = G - R;
            if (bid < Gp) {
                if (l == 1) { if (bid < NB) srglru_task(lds, a, l, bid); __syncthreads(); for (int t = bid; t < NB * NH; t += Gp) sat::task(lds, a, l, t >> 3, t & 7); }
                phase_fin(a, l, bid, Gp);
            }
            if (l == 0) { S_G2(bid >= Gp ? bid - Gp : -1, 4); }
            SEAM(pb + 2);
        }
        if (IN(pb + 3)) for (int rep_ = 0; rep_ < NREP(4); ++rep_) {
            LOAD_ARGS(a); MAKE_BG(a); unsigned char* ws = a.ws; unsigned char* wl = ws + WS_W + (size_t)l * W_LAYER;
            pg8::Gemm g{(const bf16_t*)(ws + WS_MIX), (const bf16_t*)(wl + W_OUT), MP, DM, DM}; pg8::StaticOrder S; S.init(MP, DM, G, bid);
            EpiRes E{l == 0 ? a.in[0] : nullptr, a.in[1], (const bf16_t*)(ws + WS_XBA), (bf16_t*)(ws + WS_XBB), (float*)(ws + WS_SSQP + (size_t)(l == 0 ? 1 : 3) * SSQP_STRIDE), 0, false};
            pg8::gemm_phase<EpiRes, pg8::StaticOrder, true, true>(lds, g, S, E);
            SEAM(pb + 3);
        }
        if (IN(pb + 4)) for (int rep_ = 0; rep_ < NREP(5); ++rep_) {
            LOAD_ARGS(a); MAKE_BG(a); unsigned char* ws = a.ws; unsigned char* wl = ws + WS_W + (size_t)l * W_LAYER;
            const int jr = (bid >= G - 8) ? bid - (G - 8) : -1;
            const int NBG = (int)cpy::BG_G3_WGS, GP = G - 8 - NBG;
            if (bid < GP) {
                pg8::Gemm g{(const bf16_t*)(ws + WS_XBB), (const bf16_t*)(wl + W_GU), MP, NGU, DM}; pg8::StaticOrder S; S.init(MP, NGU, GP, bid);
                fill_rstd_table(lds, (const float*)(ws + WS_SSQP + (size_t)(l == 0 ? 1 : 3) * SSQP_STRIDE), S);
                EpiG3 E{lds, (bf16_t*)(ws + WS_H), 0, false};
                pg8::gemm_phase<EpiG3, pg8::StaticOrder, true, true>(lds, g, S, E);
            }
            if (bid >= GP && bid < G - 8) {
                const int tb = pg8::opaque_tid(), wv = __builtin_amdgcn_readfirstlane(tb >> 6), bw = (bid - GP) * 8 + wv;
                bg.stream((l == 0 ? cpy::C1 : cpy::C3) + (unsigned)bw * cpy::Q_G3, cpy::Q_G3);
            }
            if (l == 0) { S_G3(jr, 8); }
            if (l == 1) { S_G2(jr, 8); }
            SEAM(pb + 4);
        }
        if (IN(pb + 5)) for (int rep_ = 0; rep_ < NREP(6); ++rep_) {
            LOAD_ARGS(a); MAKE_BG(a); unsigned char* ws = a.ws; unsigned char* wl = ws + WS_W + (size_t)l * W_LAYER;
            pg8::Gemm g{(const bf16_t*)(ws + WS_H), (const bf16_t*)(wl + W_FD), MP, DM, DFF}; pg8::StaticOrder S; S.init(MP, DM, G, bid);
            EpiRes E{nullptr, nullptr, (const bf16_t*)(ws + WS_XBB), (bf16_t*)(ws + WS_XBA), (float*)(ws + WS_SSQP + (size_t)(l == 0 ? 2 : 4) * SSQP_STRIDE), 0, false};
            pg8::gemm_phase<EpiRes, pg8::StaticOrder, true, true>(lds, g, S, E);
            SEAM(pb + 5);
        }
    }
    if (IN(13)) {
        LOAD_ARGS(a); MAKE_BG(a); unsigned char* ws = a.ws; const int l = 1; unsigned char* wl = ws + WS_W + (size_t)l * W_LAYER;
        if (bid < G - 22) phase_final(a, bid, G - 22);
        { S_G3(bid >= G - 22 ? bid - (G - 22) : -1, 22); }
        SEAM(13);
    }
    if (IN(14)) { LOAD_ARGS(a); skinny_down(a, 1); SEAM(14); }
    if (IN(15)) { LOAD_ARGS(a); MAKE_BG(a); sample_final(a); bg.drain(); }
#undef IN
#undef SEAM
}

extern "C" void kernel_launch(void* const* d_in, const int* in_sizes, int n_in, void* d_out, int out_size, void* d_ws, size_t ws_size, hipStream_t stream) {
    static int grid = 0;
    if (grid == 0) {
        if (n_in != 21 || (size_t)out_size != O_END || ws_size < WS_END) { fprintf(stderr, "kernel_launch: unexpected shapes (n_in %d, out %d, ws %zu); nothing launched\n", n_in, out_size, ws_size); grid = -1; return; }
        int dev = 0, cus = 0, per_cu = 0;
        if (hipGetDevice(&dev) != hipSuccess || hipDeviceGetAttribute(&cus, hipDeviceAttributeMultiprocessorCount, dev) != hipSuccess) { grid = -1; return; }
        if (hipFuncSetAttribute((const void*)mk_fwd, hipFuncAttributeMaxDynamicSharedMemorySize, LDS_BYTES) != hipSuccess) { fprintf(stderr, "kernel_launch: hipFuncSetAttribute failed\n"); grid = -1; return; }
        if (hipOccupancyMaxActiveBlocksPerMultiprocessor(&per_cu, (const void*)mk_fwd, 512, LDS_BYTES) != hipSuccess || per_cu < 1) { fprintf(stderr, "kernel_launch: occupancy query says %d blocks per CU\n", per_cu); }
        (void)hipGetLastError();
        grid = cus;
    }
    if (grid < 0) return;
    hipMemsetAsync((char*)d_ws + WS_CTL, 0, CTL_ZERO_BYTES, stream);
    Args a{};
    for (int i = 0; i < 21; ++i) a.in[i] = (const float*)d_in[i];
    a.out = (float*)d_out; a.ws = (unsigned char*)d_ws;
#if MK_ONE_LAUNCH
    a.ph_lo = 0; a.ph_hi = N_PHASES;
    hipLaunchKernelGGL(mk_fwd, dim3(grid), dim3(512), LDS_BYTES, stream, a);
#else
    for (int p = 0; p < N_PHASES; ++p) { a.ph_lo = p; a.ph_hi = p + 1; hipLaunchKernelGGL(mk_fwd, dim3(grid), dim3(512), LDS_BYTES, stream, a); }
#endif
}
```

```cpp
#define MK_ONE_LAUNCH 1
#define CPQ_G1A 2u
#include <hip/hip_runtime.h>
#include <cstdio>
#include <cstdint>

namespace pg8 {
#define PG8_LAS __attribute__((address_space(3)))
typedef unsigned short bf16_t;
typedef short bf16x8 __attribute__((ext_vector_type(8)));
typedef float f32x4 __attribute__((ext_vector_type(4)));
typedef unsigned u32x4 __attribute__((ext_vector_type(4)));
constexpr int BM = 256, BK = 64, HALF = 128, HTB = HALF * BK * 2  , STAGE_BYTES = 8 * HTB, NXCD = 8, WGM = 8;

__host__ __device__ __forceinline__ int lds_byte(int r, int c) { const int st = (r >> 4) * 2 + (c >> 5), rr = r & 15, cc = c & 31, ob = rr * 64 + cc * 2; return st * 1024 + (ob ^ (((ob >> 9) & 1) << 5)); }
__host__ __device__ __forceinline__ void stage_rc(int b, int& R, int& C) { const int st = b / 1024, sb = b % 1024, swz = sb ^ (((sb >> 9) & 1) << 5); R = (st >> 1) * 16 + swz / 64; C = (st & 1) * 32 + (swz % 64) / 2; }
__host__ __device__ __forceinline__ int perm32(int rho) { const int n = rho >> 4, i = rho & 15; return 8 * (i >> 2) + 4 * n + (i & 3); }

struct Unit { int pm, pn; };
struct Gemm { const bf16_t* A; const bf16_t* Bt; int M, N, K; };

struct StaticOrder {
    int nM, nN, nwg, G, c;
    __host__ __device__ void init(int M, int N, int G_, int c_) { nM = M / BM; nN = N / BM; nwg = nM * nN; G = G_; c = c_; }
    __host__ __device__ bool next(int i, Unit& u) const {
        const long L = (long)i * G + c; if (L >= nwg) return false;
        int wgid = (int)L; { const int q = nwg / NXCD, r = nwg % NXCD, xcd = wgid % NXCD, off = wgid / NXCD; wgid = (xcd < r ? xcd * (q + 1) : r * (q + 1) + (xcd - r) * q) + off; }
        const int nig = WGM * nN, gid = wgid / nig, fm = gid * WGM, gsz = (nM - fm) < WGM ? (nM - fm) : WGM;
        u.pm = fm + ((wgid % nig) % gsz); u.pn = (wgid % nig) / gsz; return true;
    }
    __device__ __forceinline__ void a_ready(const Unit&) const {}
    __device__ __forceinline__ void done(const Unit&) const {}
};

__device__ __forceinline__ int opaque_tid() { int t = threadIdx.x; asm volatile("" : "+v"(t)); return t; }
__device__ __forceinline__ unsigned cvt_pk_bf16(float lo, float hi) { unsigned r; asm volatile("v_cvt_pk_bf16_f32 %0, %1, %2" : "=v"(r) : "v"(lo), "v"(hi)); return r; }

struct NoBg { struct Regs {}; __device__ __forceinline__ void begin(Regs&) const {} __device__ __forceinline__ void begin(Regs&, const Unit&) const {} __device__ __forceinline__ void end(Regs&) const {} };
#ifndef PG8_GLL
#define PG8_GLL false
#endif
template <class Epi, class Sched, bool ALIGN_EPI = false, bool SP2 = false, class Bg = NoBg, bool GLL = PG8_GLL>
__device__ __forceinline__ void gemm_phase(PG8_LAS unsigned char* lds, const Gemm g, const Sched& S, const Epi& E, const Bg& B = Bg()) {
    const int tid = opaque_tid(), wid = __builtin_amdgcn_readfirstlane(tid >> 6), lane = tid & 63, wr = wid >> 2, wc = wid & 3, fr = lane & 15, fq = lane >> 4;
    const int K = g.K, nt = K / BK;
    unsigned voffA[2], voffB[2];
#pragma unroll
    for (int i = 0; i < 2; ++i) { int R, C; stage_rc(tid * 16 + i * 8192, R, C); const int Rb = Epi::PERM ? ((R & ~31) + perm32(R & 31)) : R;
        voffA[i] = (unsigned)(R * K + C) * 2u; voffB[i] = (unsigned)(Rb * K + C) * 2u; }
    const unsigned kstep = (unsigned)(BK * 2);
    const unsigned hstep = (unsigned)HALF * K * 2;
    const unsigned tstep = 2 * hstep;
    const __amdgpu_buffer_rsrc_t rsA = __builtin_amdgcn_make_buffer_rsrc((void*)g.A, 0, (int)((unsigned)g.M * (unsigned)K * 2u), 0x00020000);
    const __amdgpu_buffer_rsrc_t rsB = __builtin_amdgcn_make_buffer_rsrc((void*)g.Bt, 0, (int)((unsigned)g.N * (unsigned)K * 2u), 0x00020000);
    const unsigned ldsw = (unsigned)wid * 1024u;
    const int aoff = lds_byte(wr * 64 + fr, fq * 8), boff = lds_byte(wc * 32 + fr, fq * 8);
#define PG8_SA(b, h) (((b) * 2 + (h)) * HTB)
#define PG8_SB(b, h) ((4 + (b) * 2 + (h)) * HTB)
#define PG8_STAGE(bufoff, gbase, voff) do { _Pragma("unroll") for (int _i = 0; _i < 2; ++_i) \
        { if constexpr (GLL) __builtin_amdgcn_global_load_lds((const unsigned*)((const char*)(PG8_BASE_##voff) + (size_t)(gbase) + (voff)[_i]), (PG8_LAS unsigned*)(lds + (bufoff) + ldsw + _i * 8192), 16, 0, 0); \
          else __builtin_amdgcn_raw_ptr_buffer_load_lds(PG8_RSRC_##voff, (PG8_LAS void*)(lds + (bufoff) + ldsw + _i * 8192), 16, (int)(voff)[_i], (int)(gbase), 0, 0); } } while (0)
#define PG8_BASE_voffA g.A
#define PG8_BASE_voffB g.Bt
#define PG8_RSRC_voffA rsA
#define PG8_RSRC_voffB rsB
#define PG8_LDA(dst, b, h) do { _Pragma("unroll") for (int m = 0; m < 4; ++m) _Pragma("unroll") for (int k = 0; k < 2; ++k) dst[m][k] = *(const PG8_LAS bf16x8*)(lds + PG8_SA(b, h) + aoff + m * 2048 + k * 1024); } while (0)
#define PG8_LDB(dst, b, h) do { _Pragma("unroll") for (int n = 0; n < 2; ++n) _Pragma("unroll") for (int k = 0; k < 2; ++k) dst[n][k] = *(const PG8_LAS bf16x8*)(lds + PG8_SB(b, h) + boff + n * 2048 + k * 1024); } while (0)
#define PG8_MMA(ai, bj, At, Bt) do { __builtin_amdgcn_s_setprio(1); _Pragma("unroll") for (int m = 0; m < 4; ++m) _Pragma("unroll") for (int n = 0; n < 2; ++n) _Pragma("unroll") for (int k = 0; k < 2; ++k) \
        acc[ai][bj][m][n] = __builtin_amdgcn_mfma_f32_16x16x32_bf16(Bt[n][k], At[m][k], acc[ai][bj][m][n], 0, 0, 0); __builtin_amdgcn_s_setprio(0); } while (0)
#define PG8_WAIT_V(n) asm volatile("s_waitcnt vmcnt(" #n ")" ::: "memory")
#define PG8_WAIT_L(n) asm volatile("s_waitcnt lgkmcnt(" #n ")" ::: "memory")
#define PG8_BAR __builtin_amdgcn_s_barrier()
#define PG8_SCHED __builtin_amdgcn_sched_barrier(0)
    Unit cur, nxt; int ui = 0;
    if (!S.next(0, cur)) return;
    f32x4 acc[2][2][4][2];
#pragma unroll
    for (int a = 0; a < 2; ++a)
#pragma unroll
        for (int b = 0; b < 2; ++b)
#pragma unroll
            for (int m = 0; m < 4; ++m)
#pragma unroll
                for (int n = 0; n < 2; ++n) acc[a][b][m][n] = (f32x4){0.f, 0.f, 0.f, 0.f};
    bf16x8 At[4][2], B0[2][2], B1[2][2];
    unsigned cA = (unsigned)cur.pm * tstep, cB = (unsigned)cur.pn * tstep;
    S.a_ready(cur);
    if constexpr (SP2) {
        PG8_STAGE(PG8_SB(0, 0), cB, voffB); PG8_STAGE(PG8_SB(0, 1), cB + hstep, voffB); PG8_STAGE(PG8_SA(0, 0), cA, voffA); PG8_STAGE(PG8_SA(0, 1), cA + hstep, voffA);
        if (wr == 1) PG8_BAR;
        PG8_WAIT_V(2); PG8_BAR;
        PG8_STAGE(PG8_SB(1, 0), cB + kstep, voffB); PG8_STAGE(PG8_SA(1, 0), cA + kstep, voffA); PG8_STAGE(PG8_SB(1, 1), cB + hstep + kstep, voffB);
        PG8_WAIT_V(6); PG8_BAR;
    } else {
        PG8_STAGE(PG8_SB(0, 0), cB, voffB); PG8_STAGE(PG8_SA(0, 0), cA, voffA); PG8_STAGE(PG8_SB(0, 1), cB + hstep, voffB); PG8_STAGE(PG8_SA(0, 1), cA + hstep, voffA);
        if (wr == 1) PG8_BAR;
        PG8_WAIT_V(4); PG8_BAR;
        PG8_STAGE(PG8_SB(1, 0), cB + kstep, voffB); PG8_STAGE(PG8_SA(1, 0), cA + kstep, voffA); PG8_STAGE(PG8_SB(1, 1), cB + hstep + kstep, voffB);
        PG8_WAIT_V(6); PG8_BAR;
    }
    for (;;) {
        const bool has_next = S.next(ui + 1, nxt);
        const unsigned nA = has_next ? (unsigned)nxt.pm * tstep : cA, nB = has_next ? (unsigned)nxt.pn * tstep : cB;
        for (int t = 0; t < nt; t += 2) {
            const bool last = (t == nt - 2);
            const unsigned a1 = cA + (unsigned)(t + 1) * kstep;
            const unsigned a2 = last ? nA : cA + (unsigned)(t + 2) * kstep, b2 = last ? nB : cB + (unsigned)(t + 2) * kstep;
            const unsigned a3 = a2 + kstep, b3 = b2 + kstep;
            if (last && has_next) S.a_ready(nxt);
            if constexpr (SP2) {
            PG8_LDB(B0, 0, 0); PG8_LDB(B1, 0, 1); PG8_SCHED; PG8_LDA(At, 0, 0); PG8_STAGE(PG8_SA(1, 1), a1 + hstep, voffA);
            PG8_WAIT_V(8); PG8_WAIT_L(0); PG8_BAR; PG8_MMA(0, 0, At, B0); PG8_MMA(0, 1, At, B1); PG8_BAR; PG8_SCHED;
            PG8_LDA(At, 0, 1); PG8_STAGE(PG8_SB(0, 0), b2, voffB); PG8_STAGE(PG8_SB(0, 1), b2 + hstep, voffB); PG8_STAGE(PG8_SA(0, 0), a2, voffA);
            PG8_WAIT_V(8); PG8_WAIT_L(0); PG8_BAR; PG8_MMA(1, 0, At, B0); PG8_MMA(1, 1, At, B1); PG8_BAR; PG8_SCHED;
            PG8_LDB(B0, 1, 0); PG8_LDB(B1, 1, 1); PG8_SCHED; PG8_LDA(At, 1, 0); PG8_STAGE(PG8_SA(0, 1), a2 + hstep, voffA);
            PG8_WAIT_V(8); PG8_WAIT_L(0); PG8_BAR; PG8_MMA(0, 0, At, B0); PG8_MMA(0, 1, At, B1); PG8_BAR; PG8_SCHED;
            PG8_LDA(At, 1, 1); PG8_STAGE(PG8_SB(1, 0), b3, voffB); PG8_STAGE(PG8_SB(1, 1), b3 + hstep, voffB); PG8_STAGE(PG8_SA(1, 0), a3, voffA);
            PG8_WAIT_V(8); PG8_WAIT_L(0); PG8_BAR; PG8_MMA(1, 0, At, B0); PG8_MMA(1, 1, At, B1); PG8_BAR; PG8_SCHED;
            } else {
            PG8_LDB(B0, 0, 0); PG8_SCHED; PG8_LDA(At, 0, 0); PG8_STAGE(PG8_SA(1, 1), a1 + hstep, voffA);
            PG8_WAIT_L(8); PG8_BAR; PG8_WAIT_L(0); PG8_MMA(0, 0, At, B0); PG8_BAR; PG8_SCHED;
            PG8_LDB(B1, 0, 1); PG8_STAGE(PG8_SB(0, 0), b2, voffB);
            PG8_BAR; PG8_WAIT_L(0); PG8_MMA(0, 1, At, B1); PG8_BAR;
            PG8_LDA(At, 0, 1); PG8_STAGE(PG8_SA(0, 0), a2, voffA);
            PG8_BAR; PG8_WAIT_L(0); PG8_MMA(1, 0, At, B0); PG8_BAR; PG8_SCHED;
            PG8_STAGE(PG8_SB(0, 1), b2 + hstep, voffB);
            PG8_WAIT_V(6); PG8_BAR; PG8_MMA(1, 1, At, B1); PG8_BAR;
            PG8_LDB(B0, 1, 0); PG8_SCHED; PG8_LDA(At, 1, 0); PG8_STAGE(PG8_SA(0, 1), a2 + hstep, voffA);
            PG8_WAIT_L(8); PG8_BAR; PG8_WAIT_L(0); PG8_MMA(0, 0, At, B0); PG8_BAR; PG8_SCHED;
            PG8_LDB(B1, 1, 1); PG8_STAGE(PG8_SB(1, 0), b3, voffB);
            PG8_BAR; PG8_WAIT_L(0); PG8_MMA(0, 1, At, B1); PG8_BAR;
            PG8_LDA(At, 1, 1); PG8_STAGE(PG8_SA(1, 0), a3, voffA);
            PG8_BAR; PG8_WAIT_L(0); PG8_MMA(1, 0, At, B0); PG8_BAR; PG8_SCHED;
            PG8_STAGE(PG8_SB(1, 1), b3 + hstep, voffB);
            PG8_WAIT_V(6); PG8_BAR; PG8_MMA(1, 1, At, B1); PG8_BAR;
            }
        }
        if constexpr (ALIGN_EPI) { if (wr == 0) PG8_BAR; }
        if constexpr (!Epi::AFTER_DRAIN) { typename Bg::Regs bgr; E(acc, cur, wr, wc, fr, fq, ui, B, bgr); B.end(bgr); S.done(cur); }
        if (!has_next) break;
#pragma unroll
        for (int a = 0; a < 2; ++a)
#pragma unroll
            for (int b = 0; b < 2; ++b)
#pragma unroll
                for (int m = 0; m < 4; ++m)
#pragma unroll
                    for (int n = 0; n < 2; ++n) acc[a][b][m][n] = (f32x4){0.f, 0.f, 0.f, 0.f};
        cur = nxt; cA = nA; cB = nB; ++ui;
        if constexpr (ALIGN_EPI) { if (wr == 1) PG8_BAR; }
    }
    PG8_WAIT_V(0);
    if constexpr (!ALIGN_EPI) { if (wr == 0) PG8_BAR; }
    PG8_BAR;
#undef PG8_SA
#undef PG8_SB
#undef PG8_STAGE
#undef PG8_BASE_voffA
#undef PG8_BASE_voffB
#undef PG8_RSRC_voffA
#undef PG8_RSRC_voffB
#undef PG8_LDA
#undef PG8_LDB
#undef PG8_MMA
#undef PG8_WAIT_V
#undef PG8_WAIT_L
#undef PG8_BAR
#undef PG8_SCHED
}
}

#define LAS __attribute__((address_space(3)))
#define GAS __attribute__((address_space(1)))
typedef unsigned short bf16_t;
typedef short bf16x8 __attribute__((ext_vector_type(8)));
typedef short s16x4 __attribute__((ext_vector_type(4)));
typedef float f32x4 __attribute__((ext_vector_type(4)));
typedef float f32x16 __attribute__((ext_vector_type(16)));
typedef unsigned u32x4 __attribute__((ext_vector_type(4)));
typedef unsigned u32x2 __attribute__((ext_vector_type(2)));

constexpr int MP = 16384;
constexpr int MS = 128;
constexpr int MROWS = MP + MS;
constexpr int MTOT = 16640;
constexpr int DM = 1024, DIN = 2560, DA = 512, DR = 512, DFF = 2816, NGU = 2 * DFF;
constexpr int NH = 8, HD = 64, WBUF = 2048, NB = 32, NT = 4, NLAYER = 2;
constexpr int ROPE_ROWS = MP + NT;
constexpr float RMS_EPS = 1e-6f;
constexpr float QSCALE = 0.18033688011112042f;

constexpr size_t O_YP = 0, O_YS = 16777216, O_PK = 16908288, O_PV = 19005440, O_PC = 21102592, O_PH = 21105664,
                 O_SK = 21106688, O_SV = 88215552, O_SC = 155324416, O_SH = 155422720, O_END = 155455488;

constexpr size_t MiB = 1u << 20;
constexpr size_t WS_CTL = 0, CTL_ZERO_BYTES = 1 * MiB;
constexpr size_t WS_ROPE = 1 * MiB;
constexpr size_t WS_WGT = 3 * MiB;
constexpr size_t WS_SP = WS_WGT + 512 * 1024;
constexpr size_t WS_W = 5 * MiB, W_LAYER = 24 * MiB;
constexpr size_t W_IN = 0, W_OUT = 5242880, W_GU = 7340032, W_FD = 18874368;
constexpr size_t WS_SSQP = 53 * MiB, SSQP_STRIDE = 1114112;
constexpr size_t WS_QS = 59 * MiB;
constexpr size_t WS_XRS = WS_QS + 512 * 1024;
constexpr size_t WS_LSE = 60 * MiB;
constexpr size_t WS_XBA = 62 * MiB;
constexpr size_t WS_XBB = 95 * MiB;
constexpr size_t WS_X = 128 * MiB;
constexpr size_t WS_Q = 193 * MiB, WS_K = 210 * MiB, WS_V = 227 * MiB, WS_XR = 244 * MiB, WS_GY = 261 * MiB, WS_HL = 278 * MiB, WS_CA = 295 * MiB;
constexpr size_t WS_OG = 312 * MiB, OG_STRIDE = 16 * MiB;
constexpr size_t WS_MIX = 360 * MiB;
constexpr size_t WS_H = 393 * MiB;
constexpr size_t WS_AGGA = 483 * MiB, WS_AGGH = 484 * MiB, WS_CARRY = 485 * MiB;
constexpr size_t WS_ACC = 486 * MiB;
constexpr size_t WS_XP = 491 * MiB;
constexpr size_t WS_PREA = 556 * MiB;
constexpr size_t WS_GAGG = 557 * MiB;
constexpr size_t WS_END = 558 * MiB;

constexpr int CW_BAR = 4096;
constexpr int CW_SG = 12288;
constexpr int CW_RG = 16384;

constexpr int LDS_BYTES = 155648;
constexpr int MISC_OFF = 150 * 1024;

struct Args { const float* in[21]; float* out; unsigned char* ws; int ph_lo, ph_hi; };
typedef const volatile __attribute__((address_space(4))) Args* KArgsPtr;
__device__ __forceinline__ KArgsPtr kargs() { return (KArgsPtr)__builtin_amdgcn_kernarg_segment_ptr(); }
#define LOAD_ARGS(a) Args a; { KArgsPtr k_ = kargs(); _Pragma("unroll") for (int i_ = 0; i_ < 21; ++i_) a.in[i_] = (const float*)k_->in[i_]; a.out = (float*)k_->out; a.ws = (unsigned char*)k_->ws; a.ph_lo = 0; a.ph_hi = 0; }
__device__ __forceinline__ bool phase_on(int k) { KArgsPtr k_ = kargs(); const int lo = k_->ph_lo, hi = k_->ph_hi; return lo <= k && k < hi; }

__device__ __forceinline__ unsigned f2bf(float f) { unsigned u = __builtin_bit_cast(unsigned, f); return (u + 0x7fffu + ((u >> 16) & 1u)) >> 16; }
__device__ __forceinline__ unsigned pk2(float lo, float hi) { return f2bf(lo) | (f2bf(hi) << 16); }
__device__ __forceinline__ float bf2f(unsigned short b) { return __builtin_bit_cast(float, (unsigned)b << 16); }
__device__ __forceinline__ unsigned cvtpk(float lo, float hi) { return pg8::cvt_pk_bf16(lo, hi); }
__device__ __forceinline__ float fexp2(float x) { return __builtin_amdgcn_exp2f(x); }
__device__ __forceinline__ float frcp(float x) { return __builtin_amdgcn_rcpf(x); }
__device__ __forceinline__ float sigmoidf_(float x) { return frcp(1.0f + fexp2(-1.4426950408889634f * x)); }
__device__ __forceinline__ float gelu_tanh(float x) {
    const float u = x * (1.0f + 0.044715f * x * x);
    return x * frcp(1.0f + fexp2(-2.3022081565f * u));
}
#define LDS_WAIT() asm volatile("s_waitcnt lgkmcnt(0)" ::: "memory")
#define VM_WAIT() asm volatile("s_waitcnt vmcnt(0)" ::: "memory")

#ifndef EPI_FENCE_RES
#define EPI_FENCE_RES 1
#endif
#ifndef EPI_FENCE_G1
#define EPI_FENCE_G1 1
#endif
using pg8::Unit;
__device__ __forceinline__ float row_rstd(const float* ssqp, int row) {
    const f32x4* p = (const f32x4*)(ssqp + (size_t)row * 16);
    const f32x4 a = p[0], b = p[1], c = p[2], d = p[3];
    const f32x4 s = (a + b) + (c + d);
    const float ss = (s[0] + s[1]) + (s[2] + s[3]);
    return 1.0f / sqrtf(ss * (1.0f / DM) + RMS_EPS);
}

constexpr int RSTD_OFF = 131072, RSTD_MAX_UNITS = 8;
template <class Sched>
__device__ __forceinline__ void fill_rstd_table(LAS unsigned char* lds, const float* ssqp  , const Sched& S) {
    const int tid = pg8::opaque_tid();
    Unit u;
    for (int i = 0; i < RSTD_MAX_UNITS && S.next(i, u); ++i) {
        const int row = u.pm * 256 + (tid >> 1);
        const f32x4* p = (const f32x4*)(ssqp + (size_t)row * 16) + (tid & 1) * 2;
        const f32x4 s = p[0] + p[1];
        float ss = (s[0] + s[1]) + (s[2] + s[3]);
        ss += __shfl_xor(ss, 1);
        if ((tid & 1) == 0) ((LAS float*)(lds + RSTD_OFF))[i * 256 + (tid >> 1)] = 1.0f / sqrtf(ss * (1.0f / DM) + RMS_EPS);
    }
    LDS_WAIT();
    __syncthreads();
}

struct PanelOrder {
    int j, R, nN;
    __device__ __forceinline__ bool next(int i, Unit& u) const { const int id = j + i * R; if (j < 0 || id >= nN) return false; u.pm = 0; u.pn = id; return true; }
    __device__ __forceinline__ void a_ready(const Unit&) const {}
    __device__ __forceinline__ void done(const Unit&) const {}
};

template <int DBGV = 0> struct EpiG1T {
    static constexpr bool PERM = true, AFTER_DRAIN = false;
    LAS unsigned char* lds; unsigned char* ws; float* out; int l; int row0; bool samp;
    template <class Bg> __device__ __forceinline__ void operator()(const f32x4 (&acc)[2][2][4][2], const Unit& u, int wr, int wc, int fr, int fq, int ui, const Bg& B, typename Bg::Regs& bgr) const {
        const int sect = u.pn >> 1;
        const LAS float* rtab = (const LAS float*)(lds + RSTD_OFF) + ui * 256;
        const bool dorope = (sect <= 1) && ((wc & 1) == 0);
        const bool rl = dorope && (fq < 2);
        const int cbase = (u.pn & 1) * 256 + wc * 32;
        const int ca0 = cbase + (rl ? 4 * fq : 8 * fq), ca1 = cbase + (rl ? 8 + 4 * fq : 8 * fq + 4);
        const float* rope = (const float*)(ws + WS_ROPE) + 4 * (fq & 1);
        bf16_t* bdst = (bf16_t*)(ws + (sect == 0 ? WS_Q : sect == 1 ? WS_K : sect == 2 ? WS_V : sect == 3 ? WS_XR : WS_GY));
        float* pdst = out + (sect == 1 ? O_PK + (size_t)l * WBUF * 512 : sect == 2 ? O_PV + (size_t)l * WBUF * 512 : O_PC + (size_t)l * 3 * 512);
        const int prow0 = (sect == 3) ? (MP - 3) : (MP - WBUF);
        const bool has_p = (sect >= 1 && sect <= 3);
        float* sdst = (sect == 0) ? (float*)(ws + WS_QS) : (sect == 3) ? (float*)(ws + WS_XRS) : out + (sect == 1 ? O_SK : O_SV) + (size_t)l * NB * WBUF * 512;
        const float qs_ = (sect == 0) ? QSCALE : 1.0f;
#pragma unroll
        for (int ai = 0; ai < 2; ++ai) {
            if (ai == 1) { asm volatile("" ::: "memory"); B.begin(bgr, u); }
            if (samp && ai == 1) continue;
#pragma unroll
            for (int m = 0; m < 4; ++m) {
                const int rloc = ai * 128 + wr * 64 + m * 16 + fr, row = row0 + u.pm * 256 + rloc;
                const float rs = rtab[rloc];
                f32x4 cs = {1.f, 1.f, 1.f, 1.f}, sn = {0.f, 0.f, 0.f, 0.f};
                if (dorope) {
                    const int pos = samp ? (MP + (row & 3)) : row;
                    const float* rp = rope + (size_t)pos * 16;
                    cs = *(const f32x4*)rp; sn = *(const f32x4*)(rp + 8);
                }
#pragma unroll
                for (int bj = 0; bj < 2; ++bj) {
                    f32x4 v0 = acc[ai][bj][m][0] * rs, v1 = acc[ai][bj][m][1] * rs;
                    if (rl) { const f32x4 x1 = v0, x2 = v1; v0 = x1 * cs - x2 * sn; v1 = x2 * cs + x1 * sn; }
                    if (sect == 4) {
#pragma unroll
                        for (int e = 0; e < 4; ++e) { v0[e] = gelu_tanh(v0[e]); v1[e] = gelu_tanh(v1[e]); }
                    }
                    if (!samp || sect == 4) {
                        u32x2 w0, w1; w0.x = cvtpk(v0[0] * qs_, v0[1] * qs_); w0.y = cvtpk(v0[2] * qs_, v0[3] * qs_); w1.x = cvtpk(v1[0] * qs_, v1[1] * qs_); w1.y = cvtpk(v1[2] * qs_, v1[3] * qs_);
                        bf16_t* bp = bdst + (size_t)row * 512 + 128 * bj;
                        if (DBGV == 1) { asm volatile("" :: "v"(w0), "v"(w1)); }
                        else if (dorope) { *(u32x2*)(bp + ca0) = w0; *(u32x2*)(bp + ca1) = w1; }
                        else { *(u32x4*)(bp + ca0) = (u32x4){w0.x, w0.y, w1.x, w1.y}; }
                        if (has_p && row >= prow0) { float* o = pdst + (size_t)(row - prow0) * 512 + 128 * bj; *(f32x4*)(o + ca0) = v0; *(f32x4*)(o + ca1) = v1; }
                    } else {
                        const int s = row - MP;
                        const size_t srow = (sect == 1 || sect == 2) ? ((size_t)(s >> 2) * WBUF + (WBUF - NT) + (s & 3)) : (size_t)s;
                        float* o = sdst + srow * 512 + 128 * bj; *(f32x4*)(o + ca0) = v0; *(f32x4*)(o + ca1) = v1;
                    }
                }
                if (EPI_FENCE_G1 && (m & 1)) asm volatile("" ::: "memory");
            }
        }
    }
};

typedef EpiG1T<0> EpiG1;

struct EpiRes {
    static constexpr bool PERM = true, AFTER_DRAIN = false;
    const float* xin_p; const float* xin_s;
    const bf16_t* XBin; bf16_t* XBout; float* ssqp_out; int row0; bool samp;
    template <class Bg> __device__ __forceinline__ void operator()(const f32x4 (&acc)[2][2][4][2], const Unit& u, int wr, int wc, int fr, int fq, int ui, const Bg& B, typename Bg::Regs& bgr) const {
        const int cb = u.pn * 256 + wc * 32 + 8 * fq;
#pragma unroll
        for (int ai = 0; ai < 2; ++ai) {
            if (ai == 1) { B.begin(bgr, u); }
            if (samp && ai == 1) continue;
            u32x4 xw[4][2];
#pragma unroll
            for (int m = 0; m < 4; ++m) {
                const int row = row0 + u.pm * 256 + ai * 128 + wr * 64 + m * 16 + fr;
#pragma unroll
                for (int bj = 0; bj < 2; ++bj) xw[m][bj] = *(const u32x4*)(XBin + (size_t)row * DM + cb + 128 * bj);
            }
#pragma unroll
            for (int m = 0; m < 4; ++m) {
                const int row = row0 + u.pm * 256 + ai * 128 + wr * 64 + m * 16 + fr;
                float ss = 0.f;
#pragma unroll
                for (int bj = 0; bj < 2; ++bj) {
                    const int c0 = cb + 128 * bj;
                    const u32x4 w_ = xw[m][bj];
                    const f32x4 a0 = {__builtin_bit_cast(float, w_.x << 16), __builtin_bit_cast(float, w_.x & 0xffff0000u), __builtin_bit_cast(float, w_.y << 16), __builtin_bit_cast(float, w_.y & 0xffff0000u)};
                    const f32x4 a1 = {__builtin_bit_cast(float, w_.z << 16), __builtin_bit_cast(float, w_.z & 0xffff0000u), __builtin_bit_cast(float, w_.w << 16), __builtin_bit_cast(float, w_.w & 0xffff0000u)};
                    const f32x4 v0 = acc[ai][bj][m][0] + a0, v1 = acc[ai][bj][m][1] + a1;
                    u32x4 w; w.x = cvtpk(v0[0], v0[1]); w.y = cvtpk(v0[2], v0[3]); w.z = cvtpk(v1[0], v1[1]); w.w = cvtpk(v1[2], v1[3]);
                    *(u32x4*)(XBout + (size_t)row * DM + c0) = w;
                    ss += (v0[0] * v0[0] + v0[1] * v0[1]) + (v0[2] * v0[2] + v0[3] * v0[3]) + (v1[0] * v1[0] + v1[1] * v1[1]) + (v1[2] * v1[2] + v1[3] * v1[3]);
                }
                ss += __shfl_xor(ss, 16); ss += __shfl_xor(ss, 32);
                if (fq == 0) ssqp_out[(size_t)row * 16 + u.pn * 4 + wc] = ss;
            }
        }
    }
};

#ifndef EPI_RIDER_AT
#define EPI_RIDER_AT 0
#endif
struct EpiG3 {
    static constexpr bool PERM = true, AFTER_DRAIN = false;
    LAS unsigned char* lds; bf16_t* H; int row0; bool samp;
    template <class Bg> __device__ __forceinline__ void operator()(const f32x4 (&acc)[2][2][4][2], const Unit& u, int wr, int wc, int fr, int fq, int ui, const Bg& B, typename Bg::Regs& bgr) const {
        const int c0 = u.pn * 128 + wc * 32 + 8 * fq;
        const LAS float* rtab = (const LAS float*)(lds + RSTD_OFF) + ui * 256;
#pragma unroll
        for (int ai = 0; ai < 2; ++ai) {
            if (ai == EPI_RIDER_AT) { asm volatile("" ::: "memory"); B.begin(bgr, u); }
            if (samp && ai == 1) continue;
#pragma unroll
            for (int m = 0; m < 4; ++m) {
                const int row = row0 + u.pm * 256 + ai * 128 + wr * 64 + m * 16 + fr;
                const float rs = rtab[ai * 128 + wr * 64 + m * 16 + fr];
                float hv[8];
#pragma unroll
                for (int n = 0; n < 2; ++n)
#pragma unroll
                    for (int e = 0; e < 4; ++e) { const float g = acc[ai][0][m][n][e] * rs, up = acc[ai][1][m][n][e] * rs; hv[4 * n + e] = g * up * sigmoidf_(g); }
                u32x4 w; w.x = cvtpk(hv[0], hv[1]); w.y = cvtpk(hv[2], hv[3]); w.z = cvtpk(hv[4], hv[5]); w.w = cvtpk(hv[6], hv[7]);
                *(u32x4*)(H + (size_t)row * DFF + c0) = w;
                asm volatile("" ::: "memory");
            }
        }
    }
};

struct EpiNull {
    static constexpr bool PERM = true, AFTER_DRAIN = false;
    template <class Bg> __device__ __forceinline__ void operator()(const f32x4 (&acc)[2][2][4][2], const Unit& u, int wr, int wc, int fr, int fq, int ui, const Bg& B, typename Bg::Regs& bgr) const {
#pragma unroll
        for (int ai = 0; ai < 2; ++ai)
#pragma unroll
            for (int bj = 0; bj < 2; ++bj)
#pragma unroll
                for (int m = 0; m < 4; ++m)
#pragma unroll
                    for (int n = 0; n < 2; ++n) asm volatile("" :: "v"(acc[ai][bj][m][n]));
    }
};

#define XB_TMO      128
#define XB_XCNT(j)  (256  + 64 * (j))
#define XB_XSUB(j)  (1280 + 64 * (j))
#define XB_XGEN(j)  (2304 + 64 * (j))
#define XB_TOP      3328
#define XB_TOPGEN   3392
#define XCD_BAR_WORDS 3456
#define XB_SPIN_CAP (1u << 18)
__device__ __forceinline__ unsigned xb_ld(unsigned* p)              { return __hip_atomic_load(p, __ATOMIC_RELAXED, __HIP_MEMORY_SCOPE_AGENT); }
__device__ __forceinline__ unsigned xb_add(unsigned* p, unsigned v) { return __hip_atomic_fetch_add(p, v, __ATOMIC_RELAXED, __HIP_MEMORY_SCOPE_AGENT); }
__device__ __forceinline__ unsigned xb_xcc_id() { return (unsigned)__builtin_amdgcn_s_getreg((3 << 11) | 20) & 0xFu; }
#define XB_SPIN(cond, bar) do { unsigned _sp = 0; while (cond) { __builtin_amdgcn_s_sleep(1); \
    if ((++_sp & 255u) == 0u) { if (xb_ld(&(bar)[XB_TMO])) break; if (_sp > XB_SPIN_CAP) { atomicAdd(&(bar)[XB_TMO], 1u); break; } } } } while (0)
struct XcdBarrier { unsigned* bar; unsigned x; volatile LAS unsigned* st; };
__device__ __forceinline__ XcdBarrier xcd_barrier_post(unsigned* bar, volatile LAS unsigned* st) {
    XcdBarrier b; b.bar = bar; b.x = xb_xcc_id(); b.st = st;
    if (threadIdx.x == 0) (void)xb_add(&bar[XB_XCNT(b.x)], 1u);
    return b;
}
__device__ __forceinline__ void xcd_barrier_complete(unsigned* bar, unsigned x, unsigned& nloc, unsigned& nx) {
    const unsigned G = gridDim.x * gridDim.y * gridDim.z;
    unsigned sum, cnt, mine, sp = 0u;
    for (;;) {
        sum = 0u; cnt = 0u; mine = 0u;
#pragma unroll
        for (unsigned j = 0; j < 16; ++j) { const unsigned c = xb_ld(&bar[XB_XCNT(j)]); sum += c; cnt += (c > 0u) ? 1u : 0u; mine = (j == x) ? c : mine; }
        if (sum == G) break;
        __builtin_amdgcn_s_sleep(1);
        if ((++sp & 255u) == 0u) { if (xb_ld(&bar[XB_TMO])) break; if (sp > XB_SPIN_CAP) { atomicAdd(&bar[XB_TMO], 1u); break; } }
    }
    nloc = mine > 0u ? mine : 1u; nx = cnt > 0u ? cnt : 1u;
}
__device__ __forceinline__ void xcd_barrier(const XcdBarrier& b) {
    asm volatile("s_waitcnt vmcnt(0)" ::: "memory");
    __syncthreads();
    if (threadIdx.x == 0) {
        unsigned* bar = b.bar;
        __builtin_amdgcn_s_waitcnt(0);
        unsigned nloc = b.st[0], nx = b.st[1];
        if (nloc == 0u) { xcd_barrier_complete(bar, b.x, nloc, nx); b.st[0] = nloc; b.st[1] = nx; }
        const unsigned old = xb_add(&bar[XB_XSUB(b.x)], 1u);
        const unsigned gen = old / nloc;
        if (old + 1u == (gen + 1u) * nloc) {
            __builtin_amdgcn_fence(__ATOMIC_RELEASE, "agent");
            asm volatile("s_waitcnt vmcnt(0)" ::: "memory");
            const unsigned og = xb_add(&bar[XB_TOP], 1u);
            const unsigned tg = og / nx;
            if (og + 1u == (tg + 1u) * nx) xb_add(&bar[XB_TOPGEN], 1u);
            else XB_SPIN(xb_ld(&bar[XB_TOPGEN]) == tg, bar);
            __builtin_amdgcn_fence(__ATOMIC_ACQUIRE, "agent");
            xb_add(&bar[XB_XGEN(b.x)], 1u);
            asm volatile("s_waitcnt vmcnt(0)" ::: "memory");
        } else {
            XB_SPIN(xb_ld(&bar[XB_XGEN(b.x)]) == gen, bar);
            __builtin_amdgcn_fence(__ATOMIC_ACQUIRE, "agent");
            asm volatile("s_waitcnt vmcnt(0)" ::: "memory");
        }
    }
    __syncthreads();
}

__device__ __forceinline__ float wave_sum(float v) {
#pragma unroll
    for (int o = 1; o < 64; o <<= 1) v += __shfl_xor(v, o);
    return v;
}
__device__ __forceinline__ float wave_max(float v) {
#pragma unroll
    for (int o = 1; o < 64; o <<= 1) v = fmaxf(v, __shfl_xor(v, o));
    return v;
}
struct WItem { const float* W; int K, N; bf16_t* WT; int item; const float* g; int rowmode; };
__device__ __forceinline__ void ti_load(const WItem& t, int lane, f32x4 (&v)[8], float (&gk)[8]) {
    const int nblk = t.N / 32, kb = t.item / nblk, nb = t.item % nblk, k0 = 64 * kb, n0 = 32 * nb;
#pragma unroll
    for (int i = 0; i < 8; ++i) { const int kk = (lane >> 3) + 8 * i; v[i] = *(const f32x4*)(t.W + (size_t)(k0 + kk) * t.N + n0 + 4 * (lane & 7)); gk[i] = t.g ? t.g[k0 + kk] : 1.0f; }
}
__device__ __forceinline__ void ti_store(const WItem& t, LAS float* scr, int lane, const f32x4 (&v)[8], const float (&gk)[8]) {
    const int nblk = t.N / 32, kb = t.item / nblk, nb = t.item % nblk, k0 = 64 * kb, n0 = 32 * nb;
#pragma unroll
    for (int i = 0; i < 8; ++i) { const int kk = (lane >> 3) + 8 * i; LAS float* d = scr + kk * 33 + 4 * (lane & 7); d[0] = v[i][0] * gk[i]; d[1] = v[i][1] * gk[i]; d[2] = v[i][2] * gk[i]; d[3] = v[i][3] * gk[i]; }
    LDS_WAIT(); asm volatile("" ::: "memory");
    const int c = lane & 7;
#pragma unroll
    for (int j = 0; j < 4; ++j) { const int n = (lane >> 3) + 8 * j; const LAS float* s = scr + (8 * c) * 33 + n;
        u32x4 o; o.x = pk2(s[0 * 33], s[1 * 33]); o.y = pk2(s[2 * 33], s[3 * 33]); o.z = pk2(s[4 * 33], s[5 * 33]); o.w = pk2(s[6 * 33], s[7 * 33]);
        const int nn = n0 + n; int row;
        if (t.rowmode == 0) row = nn;
        else if (t.rowmode == 3) { const int d = nn & 63; row = (nn < 1024 && d < 16) ? ((nn & ~15) + 8 * ((d >> 2) & 1) + 4 * (d >> 3) + (d & 3)) : nn; }
        else row = 256 * (nn >> 7) + (nn & 127) + (t.rowmode == 2 ? 128 : 0);
        *(u32x4*)(t.WT + (size_t)row * t.K + k0 + 8 * c) = o; }
    LDS_WAIT(); asm volatile("" ::: "memory");
}
__device__ __forceinline__ void xrow_to_bf16(const float* xrow, bf16_t* orow, float* ssq16, int lane) {
    f32x4 v[4]; float s = 0.f;
    if (xrow) {
        const f32x4* xr = (const f32x4*)xrow + lane;
#pragma unroll
        for (int j = 0; j < 4; ++j) { v[j] = xr[64 * j]; s += (v[j].x * v[j].x + v[j].y * v[j].y) + (v[j].z * v[j].z + v[j].w * v[j].w); }
    } else {
#pragma unroll
        for (int j = 0; j < 4; ++j) v[j] = (f32x4){0.f, 0.f, 0.f, 0.f};
    }
    s = wave_sum(s);
    unsigned long long* o8 = (unsigned long long*)orow + lane;
#pragma unroll
    for (int j = 0; j < 4; ++j) o8[64 * j] = (unsigned long long)pk2(v[j].x, v[j].y) | ((unsigned long long)pk2(v[j].z, v[j].w) << 32);
    if (lane < 16) ssq16[lane] = (lane == 0) ? s : 0.f;
}
__device__ __forceinline__ void sincos_d(double x, float& c, float& s) {
    const double k = __builtin_rint(x * 0.6366197723675814);
    double r = __builtin_fma(-k, 1.5707963267948966, x); r = __builtin_fma(-k, 6.123233995736766e-17, r);
    const int q = ((int)k) & 3;
    const double r2 = r * r;
    double sp = -7.6471637318198164759e-13; sp = sp * r2 + 1.6059043836821614599e-10; sp = sp * r2 - 2.5052108385441718775e-08; sp = sp * r2 + 2.7557319223985890653e-06;
    sp = sp * r2 - 1.9841269841269841270e-04; sp = sp * r2 + 8.3333333333333333333e-03; sp = sp * r2 - 1.6666666666666666667e-01; const double sn = r + r * r2 * sp;
    double cp = 4.7794773323873852974e-14; cp = cp * r2 - 1.1470745597729724714e-11; cp = cp * r2 + 2.0876756987868098979e-09; cp = cp * r2 - 2.7557319223985890653e-07;
    cp = cp * r2 + 2.4801587301587301587e-05; cp = cp * r2 - 1.3888888888888888889e-03; cp = cp * r2 + 4.1666666666666666667e-02; cp = cp * r2 - 0.5; const double cn = 1.0 + r2 * cp;
    const double sv = (q == 0) ? sn : (q == 1) ? cn : (q == 2) ? -sn : -cn;
    const double cv = (q == 0) ? cn : (q == 1) ? -sn : (q == 2) ? -cn : sn;
    c = (float)cv; s = (float)sv;
}

constexpr int WCV_I_IN = (DM / 64) * (DIN / 32), WCV_I_OUT = (DM / 64) * (DM / 32), WCV_I_F = (DM / 64) * (DFF / 32), WCV_I_D = (DFF / 64) * (DM / 32);
constexpr int WCV_I_LAYER = WCV_I_IN + WCV_I_OUT + 2 * WCV_I_F + WCV_I_D, WCV_TOTAL = NLAYER * WCV_I_LAYER, WCV_FIRST = WCV_I_LAYER;
__device__ __forceinline__ WItem witem_decode(const Args& a, int it) {
    unsigned char* ws = a.ws;
    const int l = it / WCV_I_LAYER; int r = it % WCV_I_LAYER;
    unsigned char* wl = ws + WS_W + (size_t)l * W_LAYER;
    if (r < WCV_I_IN) return WItem{a.in[7] + (size_t)l * DM * DIN, DM, DIN, (bf16_t*)(wl + W_IN), r, a.in[6] + l * DM, 3};
    r -= WCV_I_IN;
    if (r < WCV_I_OUT) return WItem{a.in[15] + (size_t)l * DM * DM, DM, DM, (bf16_t*)(wl + W_OUT), r, nullptr, 0};
    r -= WCV_I_OUT;
    if (r < WCV_I_F) return WItem{a.in[17] + (size_t)l * DM * DFF, DM, DFF, (bf16_t*)(wl + W_GU), r, a.in[16] + l * DM, 1};
    r -= WCV_I_F;
    if (r < WCV_I_F) return WItem{a.in[18] + (size_t)l * DM * DFF, DM, DFF, (bf16_t*)(wl + W_GU), r, a.in[16] + l * DM, 2};
    r -= WCV_I_F;
    return WItem{a.in[19] + (size_t)l * DFF * DM, DFF, DM, (bf16_t*)(wl + W_FD), r, nullptr, 0};
}
__device__ __forceinline__ void weight_convert_items(const Args& a, LAS float* scr, int it0, int it1, int gw, int ngw, int lane) {
    for (int it = it0 + gw; it < it1; it += 2 * ngw) {
        const bool has2 = it + ngw < it1;
        const WItem ta = witem_decode(a, it), tb = witem_decode(a, has2 ? it + ngw : it);
        f32x4 va[8], vb[8]; float ga[8], gb[8];
        ti_load(ta, lane, va, ga);
        ti_load(tb, lane, vb, gb);
        ti_store(ta, scr, lane, va, ga);
        if (has2) ti_store(tb, scr, lane, vb, gb);
    }
}
__device__ __forceinline__ void phase_prologue(const Args& a, LAS unsigned char* lds) {
    const int tid = pg8::opaque_tid(), lane = tid & 63, wave = __builtin_amdgcn_readfirstlane(tid >> 6);
    const int G = gridDim.x, gw = blockIdx.x * 8 + wave, NGW = G * 8;
    LAS float* scr = (LAS float*)(lds + wave * 16384);
    unsigned char* ws = a.ws;
    weight_convert_items(a, scr, 0, WCV_FIRST, gw, NGW, lane);
    {
        bf16_t* XBA = (bf16_t*)(ws + WS_XBA); float* ssq0 = (float*)(ws + WS_SSQP);
        for (int m = gw; m < MTOT; m += NGW) {
            const float* xr = (m < MP) ? (a.in[0] + (size_t)m * DM) : (m < MROWS) ? (a.in[1] + (size_t)(m - MP) * DM) : nullptr;
            xrow_to_bf16(xr, XBA + (size_t)m * DM, ssq0 + (size_t)m * 16, lane);
        }
    }
    const int gt = blockIdx.x * 512 + tid, NGT = G * 512;
    {
        float* rope = (float*)(ws + WS_ROPE);
        for (int e = gt; e < ROPE_ROWS * 8; e += NGT) {
            const int pos = e >> 3, i = e & 7;
            const double inv = (i == 0) ? 1.0 : (i == 1) ? 0.19392274474868576 : (i == 2) ? 0.03760603093086393 : (i == 3) ? 0.007292664737217109 :
                               (i == 4) ? 0.001414213562373095 : (i == 5) ? 0.0002742481756762073 : (i == 6) ? 5.318295896944988e-05 : 1.031338537721246e-05;
            float c, s; sincos_d((double)pos * inv, c, s);
            rope[(size_t)pos * 16 + i] = c; rope[(size_t)pos * 16 + 8 + i] = s;
        }
    }
    {
        bf16_t* wgt = (bf16_t*)(ws + WS_WGT);
        for (int e = gt; e < NLAYER * 2 * 8 * 64 * 64; e += NGT) {
            const int c = e & 63, d = (e >> 6) & 63, n = (e >> 12) & 7, gate = (e >> 15) & 1, l = e >> 16;
            const float* src = a.in[gate ? 12 : 10] + (size_t)((l * 8 + n) * 64 + c) * 64 + d;
            wgt[e] = (bf16_t)f2bf(*src);
        }
        float* sp = (float*)(ws + WS_SP);
        for (int e = gt; e < NLAYER * DR; e += NGT) { const float lam = a.in[14][e]; const float y = expf(-lam); sp[e] = (y < 0.03f) ? y * (1.0f - y * (0.5f - y * (0.33333333f - y * (0.25f - 0.2f * y)))) : logf(1.0f + y); }
    }
}

namespace cpy {
constexpr unsigned CR = 14, CPB = (unsigned)(WBUF - NT) * 2u / CR;
static_assert((WBUF - NT) * 2 % CR == 0, "copy chunking");
constexpr unsigned NCHUNKS = 2u * NLAYER * NB * CPB;
constexpr int LDS_NEXT = MISC_OFF + 128;
#ifndef CPQ_G1A
#define CPQ_G1A 8u
#endif
#ifndef CPQ_G1B
#define CPQ_G1B 18u
#endif
#ifndef CPQ_G3
#define CPQ_G3 32u
#endif
#ifndef CPQ_G3W
#define CPQ_G3W 8
#endif
constexpr unsigned BG_G1_WGS = 32, BG_G3_WGS = CPQ_G3W;
constexpr unsigned Q_G1A = CPQ_G1A, Q_G1B = CPQ_G1B, Q_G3 = CPQ_G3;
constexpr unsigned C1 = BG_G1_WGS * 8u * Q_G1A, C2 = C1 + BG_G3_WGS * 8u * Q_G3, C3 = C2 + BG_G1_WGS * 8u * Q_G1B, C4 = C3 + BG_G3_WGS * 8u * Q_G3;
#ifndef CPQ_S3
#define CPQ_S3 6u
#endif
#ifndef CPQ_SF
#define CPQ_SF 2u
#endif
#ifndef CPQ_SM
#define CPQ_SM 2u
#endif
#ifndef CPQ_SR
#define CPQ_SR 8u
#endif
constexpr unsigned G3_UNITS = (MP / 256) * (NGU / 256), GP3 = 256u - 8u - BG_G3_WGS, S3_FIRST = G3_UNITS % GP3, S3_WGS = S3_FIRST ? GP3 - S3_FIRST : 0u;
constexpr unsigned SF_WGS = 252u, MIX1_GP = 246u, SM_FIRST = 1536u % MIX1_GP, SM_WGS = MIX1_GP - SM_FIRST, SR_WGS = 256u - MIX1_GP;
constexpr unsigned Q_S3 = CPQ_S3, Q_SF = CPQ_SF, Q_SM = CPQ_SM, Q_SR = CPQ_SR;
constexpr unsigned C5 = C4 + S3_WGS * 8u * Q_S3, C6 = C5 + S3_WGS * 8u * Q_S3, C7 = C6 + SF_WGS * 8u * Q_SF, C8 = C7 + SM_WGS * 8u * Q_SM, C9 = C8 + SR_WGS * 8u * Q_SR;
#ifndef CPY_EPI
#define CPY_EPI 1
#endif
constexpr unsigned PR = 7u, EPI_PIECES = CPY_EPI ? 2u * G3_UNITS * 8u : 0u, PIGGY0 = C9 + EPI_PIECES / 2u;
static_assert(PIGGY0 <= NCHUNKS, "copy quotas");
struct BgE {
    const float* ck; const float* cv; float* out; int l;
    struct Regs { f32x4 v[PR]; unsigned pc; };
    __device__ __forceinline__ void addr(unsigned pc, const char*& src, char*& dst) const {
        const unsigned c = C9 + (pc >> 1), half = pc & 1u;
        const unsigned t = c / (NLAYER * NB * CPB), rr = c - t * (NLAYER * NB * CPB), blk = rr / CPB, k = rr - blk * CPB;
        src = (const char*)(t ? cv : ck) + (size_t)blk * (WBUF * 2048u) + NT * 2048u + (size_t)k * (CR * 1024u) + half * (PR * 1024u);
        dst = (char*)(out + (t ? O_SV : O_SK)) + (size_t)blk * (WBUF * 2048u) + (size_t)k * (CR * 1024u) + half * (PR * 1024u);
    }
    __device__ __forceinline__ void begin(Regs& r, const pg8::Unit& u) const {
        const int tid = pg8::opaque_tid(), lane = tid & 63, w = __builtin_amdgcn_readfirstlane(tid >> 6);
        r.pc = (((unsigned)l * G3_UNITS + (unsigned)u.pm * (NGU / 256) + (unsigned)u.pn) << 3) + (unsigned)w;
        const char* s; char* d; addr(r.pc, s, d);
#pragma unroll
        for (int i = 0; i < (int)PR; ++i) r.v[i] = __builtin_nontemporal_load((const f32x4*)(s + i * 1024) + lane);
    }
    __device__ __forceinline__ void end(Regs& r) const {
        const int lane = pg8::opaque_tid() & 63;
        const char* s; char* d; addr(r.pc, s, d);
#pragma unroll
        for (int i = 0; i < (int)PR; ++i) __builtin_nontemporal_store(r.v[i], (f32x4*)(d + i * 1024) + lane);
    }
};
struct Bg {
    const float* ck; const float* cv; float* out; LAS unsigned char* lds;
#ifndef CPY_PGR
#define CPY_PGR 7u
#endif
    static constexpr unsigned PGR = CPY_PGR, PGP = CR / PGR, PG_FIRST = PGP * PIGGY0, PG_END = PGP * NCHUNKS;
    static_assert(CR % PGR == 0, "piggyback piece size");
    struct Regs { f32x4 v[PGR]; unsigned id, nxt; };
    __device__ __forceinline__ void addr(unsigned c, const char*& src, char*& dst) const {
        const unsigned t = c / (NLAYER * NB * CPB), rr = c - t * (NLAYER * NB * CPB), blk = rr / CPB, k = rr - blk * CPB;
        src = (const char*)(t ? cv : ck) + (size_t)blk * (WBUF * 2048u) + NT * 2048u + (size_t)k * (CR * 1024u);
        dst = (char*)(out + (t ? O_SV : O_SK)) + (size_t)blk * (WBUF * 2048u) + (size_t)k * (CR * 1024u);
    }
    __device__ __forceinline__ void paddr(unsigned pc, const char*& src, char*& dst) const { addr(pc / PGP, src, dst); const unsigned o = (pc % PGP) * (PGR * 1024u); src += o; dst += o; }
    __device__ __forceinline__ void begin(Regs& r) const {
        const int tid = pg8::opaque_tid(), lane = tid & 63, w = __builtin_amdgcn_readfirstlane(tid >> 6);
        const unsigned k = (unsigned)__builtin_amdgcn_readfirstlane(((volatile LAS unsigned*)(lds + LDS_NEXT))[w]);
        const unsigned id = PG_FIRST + (blockIdx.x * 8u + (unsigned)w) + k * (gridDim.x * 8u);
        r.id = id < PG_END ? id : PG_END - 1u; r.nxt = id < PG_END ? 1u : 0u;
        if (r.nxt) {
            const char* s; char* d; paddr(r.id, s, d);
#pragma unroll
            for (int i = 0; i < (int)PGR; ++i) r.v[i] = __builtin_nontemporal_load((const f32x4*)(s + i * 1024) + lane);
        }
        if (lane == 0) ((LAS unsigned*)(lds + LDS_NEXT))[w] = k + 1u;
    }
    __device__ __forceinline__ void end(Regs& r) const {
        const int lane = pg8::opaque_tid() & 63;
        if (r.nxt) {
            const char* s; char* d; paddr(r.id, s, d);
#pragma unroll
            for (int i = 0; i < (int)PGR; ++i) __builtin_nontemporal_store(r.v[i], (f32x4*)(d + i * 1024) + lane);
        }
    }
    __device__ __forceinline__ void prime(Regs& r) const { begin(r); }
    __device__ __forceinline__ void rotate(Regs& r) const { end(r); begin(r); }
    __device__ __forceinline__ void stream(unsigned c0, unsigned n) const {
        const int lane = pg8::opaque_tid() & 63;
        for (unsigned c = c0; c < c0 + n; c += 2) {
            f32x4 va[CR], vb[CR];
            const char *sa, *sb; char *da, *db; addr(c, sa, da); addr(c + 1, sb, db);
#pragma unroll
            for (int i = 0; i < (int)CR; ++i) va[i] = __builtin_nontemporal_load((const f32x4*)(sa + i * 1024) + lane);
#pragma unroll
            for (int i = 0; i < (int)CR; ++i) vb[i] = __builtin_nontemporal_load((const f32x4*)(sb + i * 1024) + lane);
#pragma unroll
            for (int i = 0; i < (int)CR; ++i) __builtin_nontemporal_store(va[i], (f32x4*)(da + i * 1024) + lane);
#pragma unroll
            for (int i = 0; i < (int)CR; ++i) __builtin_nontemporal_store(vb[i], (f32x4*)(db + i * 1024) + lane);
        }
    }
    __device__ __forceinline__ void drain() const {
        const int w = __builtin_amdgcn_readfirstlane(pg8::opaque_tid() >> 6);
        for (;;) {
            const unsigned k = (unsigned)__builtin_amdgcn_readfirstlane(((volatile LAS unsigned*)(lds + LDS_NEXT))[w]);
            if (PG_FIRST + (blockIdx.x * 8u + (unsigned)w) + k * (gridDim.x * 8u) >= PG_END) break;
            Regs r; begin(r); end(r); LDS_WAIT();
        }
    }
};
}

namespace att {
constexpr int KCH = 6144;
constexpr int K_OFF = 0, V_OFF = 8 * KCH, VHALF = 384 * 64, WS_OFF = V_OFF + 2 * VHALF, OST_OFF = WS_OFF + 8 * 256, LDS_END = OST_OFF + 8 * 4096;
static_assert(LDS_END <= MISC_OFF, "attention LDS map");
typedef short v4i16_t __attribute__((ext_vector_type(4)));
__device__ __forceinline__ s16x4 vtr(const LAS unsigned char* p) { return __builtin_bit_cast(s16x4, __builtin_amdgcn_ds_read_tr16_b64_v4i16((LAS v4i16_t*)p)); }
__device__ __forceinline__ int crow(int r, int hi) { return (r & 3) + 8 * (r >> 2) + 4 * hi; }

struct UnitP { int dsh, r, jb, h, g; };
__device__ __forceinline__ UnitP decode(int u) { UnitP p; p.g = u >> 9; const int rem = u & 511; p.h = rem & 7; const int rj = rem >> 3; p.dsh = 2 * p.g; p.r = rj >> (6 - p.dsh); p.jb = rj & ((64 >> p.dsh) - 1); return p; }
template <class Bg> __device__ __forceinline__ void run(LAS unsigned char* lds, const bf16_t* Q, const bf16_t* K, const bf16_t* V, bf16_t* OG, float* LSEB, int u0, int stride, const Bg& B) {
    const int tid = pg8::opaque_tid(), lane = tid & 63, r32 = lane & 31, hi = lane >> 5;
    const int w = __builtin_amdgcn_readfirstlane(tid >> 6);
    if (u0 >= 1536) return;
    const float NEG = -INFINITY;
    bf16x8 qr[4];
#define ATT_ISSUE(P) do { const int kb_ = (P).jb * 256 - 128; \
        _Pragma("unroll") for (int t = 0; t < 6; ++t) { int idx = kb_ + 64 * t + lane; idx = idx < 0 ? 0 : idx; const size_t tok = ((size_t)idx << (P).dsh) + (P).r; \
            __builtin_amdgcn_global_load_lds((const unsigned*)(K + tok * 512 + (P).h * 64 + w * 8), (LAS unsigned*)(lds + K_OFF + w * KCH + t * 1024), 16, 0, 0); } \
        _Pragma("unroll") for (int t = 0; t < 6; ++t) { const int p_ = w * 6 + t, dh = p_ / 24, rg_ = p_ % 24; int idx = kb_ + 16 * rg_ + (lane >> 2); idx = idx < 0 ? 0 : idx; const size_t tok = ((size_t)idx << (P).dsh) + (P).r; \
            __builtin_amdgcn_global_load_lds((const unsigned*)(V + tok * 512 + (P).h * 64 + dh * 32 + (lane & 3) * 8), (LAS unsigned*)(lds + V_OFF + dh * VHALF + rg_ * 1024), 16, 0, 0); } \
        { const size_t qtok_ = ((size_t)((P).jb * 256 + 32 * w + r32) << (P).dsh) + (P).r; \
          _Pragma("unroll") for (int d0 = 0; d0 < 4; ++d0) qr[d0] = *(const bf16x8*)(Q + qtok_ * 512 + (P).h * 64 + d0 * 16 + hi * 8); } } while (0)
#define ATT_LOADK(dst, s) do { const LAS unsigned char* kp_ = lds + K_OFF + hi * KCH + (32 * (w + (s)) + r32) * 16; \
        _Pragma("unroll") for (int d0 = 0; d0 < 4; ++d0) dst[d0] = *(const LAS bf16x8*)(kp_ + d0 * 2 * KCH); } while (0)
#define ATT_QK(acc, kf, s) do { acc = (f32x16){0.f, 0.f, 0.f, 0.f, 0.f, 0.f, 0.f, 0.f, 0.f, 0.f, 0.f, 0.f, 0.f, 0.f, 0.f, 0.f}; \
        _Pragma("unroll") for (int d0 = 0; d0 < 4; ++d0) acc = __builtin_amdgcn_mfma_f32_32x32x16_bf16(kf[d0], qr[d0], acc, 0, 0, 0); \
          \
          \
        if ((s) == 0) { int q_ = r32 - 4 * hi; asm volatile("" : "+v"(q_)); _Pragma("unroll") for (int rr = 0; rr < 16; ++rr) if (((rr & 3) + 8 * (rr >> 2)) < q_) acc[rr] = NEG; } \
        if ((s) == 4) { int q_ = r32 - 4 * hi; asm volatile("" : "+v"(q_)); _Pragma("unroll") for (int rr = 0; rr < 16; ++rr) if (((rr & 3) + 8 * (rr >> 2)) > q_) acc[rr] = NEG; } } while (0)
    UnitP cur = decode(u0);
    ATT_ISSUE(cur);
    typename Bg::Regs bgr; B.prime(bgr);
    const LAS unsigned char* vb = lds + V_OFF + ((lane >> 4) & 1) * 32 + (lane & 3) * 8 + (4 * hi + ((lane & 15) >> 2)) * 64;
#define ATT_EPI() do { \
            bf16_t* O = OG + (size_t)done.g * (OG_STRIDE / 2); float* LSE = LSEB + (size_t)done.g * MP * 8; \
            const int i0 = done.jb * 256; \
            LAS float* wsf = (LAS float*)(lds + WS_OFF) + w * 64; \
            if (hi == 0) wsf[r32] = ls; \
            LDS_WAIT(); \
            LAS bf16_t* stg = (LAS bf16_t*)(lds + OST_OFF) + w * 2048; \
            _Pragma("unroll") \
            for (int rr = 0; rr < 16; ++rr) { \
                const int orow = crow(rr, hi); const float rl = frcp(wsf[orow]); \
                const unsigned pk = cvtpk(o[0][rr] * rl, o[1][rr] * rl); \
                stg[orow * 64 + r32] = (bf16_t)(pk & 0xffffu); stg[orow * 64 + 32 + r32] = (bf16_t)(pk >> 16); \
            } \
            LDS_WAIT(); \
            _Pragma("unroll") \
            for (int i = 0; i < 4; ++i) { \
                const int row = i * 8 + (lane >> 3), ch = lane & 7; \
                const u32x4 v = *(const LAS u32x4*)(stg + row * 64 + ch * 8); \
                const size_t tok = ((size_t)(i0 + 32 * w + row) << done.dsh) + done.r; \
                *(u32x4*)(O + tok * 512 + done.h * 64 + ch * 8) = v; \
            } \
            const size_t qtok = ((size_t)(i0 + 32 * w + r32) << done.dsh) + done.r; \
            if (hi == 0) LSE[qtok * 8 + done.h] = mx + __builtin_amdgcn_logf(ls); \
            LDS_WAIT(); \
        } while (0)
    float mx = 0.f, ls = 0.f; f32x16 o[2]; UnitP done = cur; bool pend = false;
    for (int u = u0;;) {
        VM_WAIT();
        __syncthreads();
        if (pend) { ATT_EPI(); pend = false; }
        B.rotate(bgr);
        const int s_lo = (cur.jb == 0 && w < 4) ? 4 - w : 0;
        mx = 0.f; ls = 0.f;
        o[0] = (f32x16){0.f, 0.f, 0.f, 0.f, 0.f, 0.f, 0.f, 0.f, 0.f, 0.f, 0.f, 0.f, 0.f, 0.f, 0.f, 0.f}; o[1] = o[0];
        {
            LAS float* wsr = (LAS float*)(lds + WS_OFF) + w * 64;
            bf16x8 kf[4]; ATT_LOADK(kf, 4);
            for (int s = 4; s >= s_lo; --s) {
                const LAS unsigned char* vrow = vb + (32 * (w + s)) * 64;
                s16x4 vl[2][2], vh[2][2];
#pragma unroll
                for (int ks = 0; ks < 2; ++ks)
#pragma unroll
                    for (int d0 = 0; d0 < 2; ++d0) { vl[ks][d0] = vtr(vrow + ks * 1024 + d0 * VHALF); vh[ks][d0] = vtr(vrow + ks * 1024 + d0 * VHALF + 512); }
                bf16x8 kn[4];
                if (s > s_lo) ATT_LOADK(kn, s - 1);
                f32x16 p; ATT_QK(p, kf, s);
                if (s == 4) {
                    float ml = p[0];
#pragma unroll
                    for (int rr = 1; rr < 16; ++rr) ml = fmaxf(ml, p[rr]);
                    mx = fmaxf(ml, __shfl_xor(ml, 32));
                }
                float se = 0.f;
#pragma unroll
                for (int rr = 0; rr < 16; ++rr) { const float e = fexp2(p[rr] - mx); p[rr] = e; se += e; }
                if (__builtin_amdgcn_ballot_w64(!(se <= 1.8446744e19f)) != 0ull) {
                    ATT_QK(p, kf, s);
                    float ml = p[0];
#pragma unroll
                    for (int rr = 1; rr < 16; ++rr) ml = fmaxf(ml, p[rr]);
                    const float mn = fmaxf(mx, fmaxf(ml, __shfl_xor(ml, 32)));
                    const float al = fexp2(mx - mn);
                    if (hi == 0) wsr[r32] = al;
                    LDS_WAIT();
#pragma unroll
                    for (int rr = 0; rr < 16; ++rr) { const float a_ = wsr[crow(rr, hi)]; o[0][rr] *= a_; o[1][rr] *= a_; }
                    LDS_WAIT();
                    ls *= al; mx = mn;
                    se = 0.f;
#pragma unroll
                    for (int rr = 0; rr < 16; ++rr) { const float e = fexp2(p[rr] - mx); p[rr] = e; se += e; }
                }
                ls += se;
#pragma unroll
                for (int ks = 0; ks < 2; ++ks) {
                    u32x4 pw; pw.x = cvtpk(p[8 * ks + 0], p[8 * ks + 1]); pw.y = cvtpk(p[8 * ks + 2], p[8 * ks + 3]); pw.z = cvtpk(p[8 * ks + 4], p[8 * ks + 5]); pw.w = cvtpk(p[8 * ks + 6], p[8 * ks + 7]);
                    const bf16x8 pa = __builtin_bit_cast(bf16x8, pw);
#pragma unroll
                    for (int d0 = 0; d0 < 2; ++d0) {
                        const bf16x8 vf = {vl[ks][d0][0], vl[ks][d0][1], vl[ks][d0][2], vl[ks][d0][3], vh[ks][d0][0], vh[ks][d0][1], vh[ks][d0][2], vh[ks][d0][3]};
                        o[d0] = __builtin_amdgcn_mfma_f32_32x32x16_bf16(pa, vf, o[d0], 0, 0, 0);
                    }
                }
                if (s > s_lo) {
#pragma unroll
                    for (int d0 = 0; d0 < 4; ++d0) kf[d0] = kn[d0];
                }
            }
        }
        ls += __shfl_xor(ls, 32);
        LDS_WAIT();
        __syncthreads();
        done = cur;
        const int un = u + stride; const bool has_next = un < 1536;
        if (has_next) { cur = decode(un); ATT_ISSUE(cur); }
        if (w < 4) { ATT_EPI(); }
        if (w >= 4) pend = true;
        if (!has_next) break;
        u = un;
    }
    if (pend) { ATT_EPI(); }
#undef ATT_EPI
    B.end(bgr);
    __syncthreads();
#undef ATT_ISSUE
#undef ATT_LOADK
#undef ATT_QK
}
}

namespace rg {
constexpr int XC_STRIDE = 1040;
constexpr int XC_BYTES = 64 * XC_STRIDE;
constexpr int NCHUNK = MP / 64;
__device__ __forceinline__ int crow(int r, int hi) { return (r & 3) + 8 * (r >> 2) + 4 * hi; }
__device__ __forceinline__ float expm1_(float x) {
    const float p = x * (1.0f + x * (0.5f + x * (0.16666667f + x * (0.041666668f + x * (0.008333334f + x * 0.0013888889f)))));
    return (x > -0.25f) ? p : (expf(x) - 1.0f);
}
__device__ __forceinline__ void task(LAS unsigned char* lds, const Args& a, int l, int tk) {
    const int tid = pg8::opaque_tid(), lane = tid & 63, r32 = lane & 31, hi = lane >> 5;
    const int w = __builtin_amdgcn_readfirstlane(tid >> 6);
    unsigned char* ws = a.ws;
    const bf16_t* XR = (const bf16_t*)(ws + WS_XR);
    bf16_t* HL = (bf16_t*)(ws + WS_HL); bf16_t* CA = (bf16_t*)(ws + WS_CA);
    const bf16_t* WT = (const bf16_t*)(ws + WS_WGT) + (size_t)l * (2 * 8 * 64 * 64);
    const float* cw = a.in[8] + l * 4 * DR; const float* cbias = a.in[9] + l * DR;
    const float* bga = a.in[11] + l * DR; const float* bgx = a.in[13] + l * DR; const float* sp = (const float*)(ws + WS_SP) + l * DR;
    float* AGGA = (float*)(ws + WS_AGGA) + (size_t)l * NCHUNK * DR; float* AGGH = (float*)(ws + WS_AGGH) + (size_t)l * NCHUNK * DR; float* CARRY = (float*)(ws + WS_CARRY) + (size_t)l * NCHUNK * DR;
    const int tg = tid >> 6, cg = tid & 63;
    const int t0 = tk * 64;
    bf16x8 wba[2][4], wbx[2][4]; float cbga[2], cbgx[2], csp2[2];
#pragma unroll
    for (int nt = 0; nt < 2; ++nt) {
#pragma unroll
        for (int ks = 0; ks < 4; ++ks) {
            wba[nt][ks] = *(const bf16x8*)(WT + ((size_t)(0 * 8 + w) * 64 + 32 * nt + r32) * 64 + 16 * ks + 8 * hi);
            wbx[nt][ks] = *(const bf16x8*)(WT + ((size_t)(1 * 8 + w) * 64 + 32 * nt + r32) * 64 + 16 * ks + 8 * hi);
        }
        const int c = 64 * w + 32 * nt + r32;
        cbga[nt] = bga[c] * -1.4426950408889634f; cbgx[nt] = bgx[c] * -1.4426950408889634f; csp2[nt] = sp[c] * (-8.0f * 1.4426950408889634f);
    }
    {
        float cwj[4][8], cbv[8];
#pragma unroll
        for (int j = 0; j < 4; ++j) { const f32x4 x0 = *(const f32x4*)(cw + j * DR + cg * 8), x1 = *(const f32x4*)(cw + j * DR + cg * 8 + 4);
#pragma unroll
            for (int e = 0; e < 4; ++e) { cwj[j][e] = x0[e]; cwj[j][4 + e] = x1[e]; } }
        { const f32x4 x0 = *(const f32x4*)(cbias + cg * 8), x1 = *(const f32x4*)(cbias + cg * 8 + 4);
#pragma unroll
            for (int e = 0; e < 4; ++e) { cbv[e] = x0[e]; cbv[4 + e] = x1[e]; } }
        u32x4 raw[11];
#pragma unroll
        for (int j = 0; j < 11; ++j) { const int t = t0 + 8 * tg - 3 + j; raw[j] = (t >= 0) ? *(const u32x4*)(XR + (size_t)t * 512 + cg * 8) : (u32x4){0u, 0u, 0u, 0u}; }
#pragma unroll
        for (int tt = 0; tt < 8; ++tt) {
            float xc[8];
#pragma unroll
            for (int e = 0; e < 8; ++e) xc[e] = cbv[e];
#pragma unroll
            for (int j = 0; j < 4; ++j) {
                const u32x4 rw = raw[tt + j];
#pragma unroll
                for (int e2 = 0; e2 < 4; ++e2) { const unsigned wv = rw[e2]; xc[2 * e2] += cwj[j][2 * e2] * __builtin_bit_cast(float, wv << 16); xc[2 * e2 + 1] += cwj[j][2 * e2 + 1] * __builtin_bit_cast(float, wv & 0xffff0000u); }
            }
            u32x4 o; o.x = cvtpk(xc[0], xc[1]); o.y = cvtpk(xc[2], xc[3]); o.z = cvtpk(xc[4], xc[5]); o.w = cvtpk(xc[6], xc[7]);
            *(LAS u32x4*)(lds + (8 * tg + tt) * XC_STRIDE + cg * 16) = o;
        }
    }
    LDS_WAIT();
    __syncthreads();
#pragma unroll
    for (int nt = 0; nt < 2; ++nt) {
        const int c = 64 * w + 32 * nt + r32;
        f32x16 ar[2], ab[2];
#pragma unroll
        for (int mt = 0; mt < 2; ++mt) { ar[mt] = (f32x16){0.f, 0.f, 0.f, 0.f, 0.f, 0.f, 0.f, 0.f, 0.f, 0.f, 0.f, 0.f, 0.f, 0.f, 0.f, 0.f}; ab[mt] = ar[mt]; }
#pragma unroll
        for (int ks = 0; ks < 4; ++ks) {
            const bf16x8 ba = wba[nt][ks], bx = wbx[nt][ks];
#pragma unroll
            for (int mt = 0; mt < 2; ++mt) {
                const bf16x8 af = *(const LAS bf16x8*)(lds + (32 * mt + r32) * XC_STRIDE + (64 * w + 16 * ks + 8 * hi) * 2);
                ar[mt] = __builtin_amdgcn_mfma_f32_32x32x16_bf16(af, ba, ar[mt], 0, 0, 0);
                ab[mt] = __builtin_amdgcn_mfma_f32_32x32x16_bf16(af, bx, ab[mt], 0, 0, 0);
            }
        }
        const float vbga = cbga[nt], vbgx = cbgx[nt], vsp2 = csp2[nt];
        LAS bf16_t* stg = (LAS bf16_t*)(lds + XC_BYTES) + w * 4096;
        LAS bf16_t* stgw = stg + 4 * hi * 32 + r32;
#pragma unroll
        for (int mt = 0; mt < 2; ++mt)
#pragma unroll
            for (int rr = 0; rr < 16; ++rr) {
                const int tkn = 32 * mt + crow(rr, hi);
                const float xcv = bf2f(*(const LAS bf16_t*)(lds + tkn * XC_STRIDE + c * 2));
                const float rg_ = frcp(1.0f + fexp2(ar[mt][rr] * -1.4426950408889634f + vbga)), ig_ = frcp(1.0f + fexp2(ab[mt][rr] * -1.4426950408889634f + vbgx));
                const float av = fexp2(rg_ * vsp2);
                const float bv = sqrtf(fmaxf(1.0f - av * av, 0.f)) * (ig_ * xcv);
                ar[mt][rr] = av; ab[mt][rr] = bv;
            }
        float GA[8], GH[8];
#pragma unroll
        for (int mt = 0; mt < 2; ++mt)
#pragma unroll
            for (int k = 0; k < 4; ++k) {
                float A = 1.f, H = 0.f;
#pragma unroll
                for (int e = 0; e < 4; ++e) { const float av = ar[mt][4 * k + e], bv = ab[mt][4 * k + e]; H = av * H + bv; A = A * av; ar[mt][4 * k + e] = A; ab[mt][4 * k + e] = H; }
                GA[mt * 4 + k] = A; GH[mt * 4 + k] = H;
            }
        float OA[8], OH[8];
#pragma unroll
        for (int q = 0; q < 8; ++q) { OA[q] = __shfl_xor(GA[q], 32); OH[q] = __shfl_xor(GH[q], 32); }
        float curH = 0.f, curA = 1.f;
#pragma unroll
        for (int mt = 0; mt < 2; ++mt)
#pragma unroll
            for (int k = 0; k < 4; ++k) {
                const int q = mt * 4 + k;
                const float ga0 = hi ? OA[q] : GA[q], gh0 = hi ? OH[q] : GH[q];
                const float ga1 = hi ? GA[q] : OA[q], gh1 = hi ? GH[q] : OH[q];
                const float midH = gh0 + ga0 * curH, midA = curA * ga0;
                const float cinH = hi ? midH : curH, cinA = hi ? midA : curA;
#pragma unroll
                for (int e = 0; e < 4; ++e) {
                    const float Al = ar[mt][4 * k + e], Hl = ab[mt][4 * k + e];
                    const float hv = Hl + Al * cinH, cav = Al * cinA;
                    stgw[(32 * mt + 8 * k + e) * 32] = (bf16_t)f2bf(hv); stgw[2048 + (32 * mt + 8 * k + e) * 32] = (bf16_t)f2bf(cav);
                }
                curH = gh1 + ga1 * midH; curA = midA * ga1;
            }
        if (hi == 0) {
            __hip_atomic_store(AGGA + (size_t)tk * DR + c, curA, __ATOMIC_RELAXED, __HIP_MEMORY_SCOPE_AGENT); __hip_atomic_store(AGGH + (size_t)tk * DR + c, curH, __ATOMIC_RELAXED, __HIP_MEMORY_SCOPE_AGENT); }
        LDS_WAIT();
#pragma unroll
        for (int i = 0; i < 4; ++i) {
            const int row = i * 16 + (lane >> 2), seg = lane & 3;
            const u32x4 vh = *(const LAS u32x4*)(stg + row * 32 + seg * 8), vc = *(const LAS u32x4*)(stg + 2048 + row * 32 + seg * 8);
            const size_t off = (size_t)(t0 + row) * 512 + 64 * w + 32 * nt + seg * 8;
            *(u32x4*)(HL + off) = vh; *(u32x4*)(CA + off) = vc;
        }
        LDS_WAIT();
    }
    float* PREA = (float*)(ws + WS_PREA) + (size_t)l * NCHUNK * DR; float* PREH = CARRY;
    float* GA_ = (float*)(ws + WS_GAGG) + (size_t)l * 3 * 16 * DR; float* GH_ = GA_ + 16 * DR; float* GC_ = GA_ + 32 * DR;
    unsigned* ctr = (unsigned*)(ws + WS_CTL) + CW_RG;
    const int grp = tk >> 4;
    VM_WAIT();
    __syncthreads();
    volatile LAS unsigned* flag = (volatile LAS unsigned*)(lds + MISC_OFF + 64);
    if (tid == 0) {
        const unsigned old = __hip_atomic_fetch_add(ctr + 128 + 64 * (16 * l + grp), 1u, __ATOMIC_RELAXED, __HIP_MEMORY_SCOPE_AGENT);
        const unsigned last = (old == 15u) ? 1u : 0u;
        if (last) { __builtin_amdgcn_fence(__ATOMIC_ACQUIRE, "agent"); asm volatile("s_waitcnt vmcnt(0)" ::: "memory"); }
        flag[0] = last;
    }
    LDS_WAIT();
    __syncthreads();
    if (flag[0]) {
        float va[16], vh[16];
#pragma unroll
        for (int j = 0; j < 16; ++j) { va[j] = AGGA[(size_t)(16 * grp + j) * DR + tid]; vh[j] = AGGH[(size_t)(16 * grp + j) * DR + tid]; }
        float A = 1.f, H = 0.f;
#pragma unroll
        for (int j = 0; j < 16; ++j) { PREA[(size_t)(16 * grp + j) * DR + tid] = A; PREH[(size_t)(16 * grp + j) * DR + tid] = H; H = vh[j] + va[j] * H; A = A * va[j]; }
        __hip_atomic_store(GA_ + grp * DR + tid, A, __ATOMIC_RELAXED, __HIP_MEMORY_SCOPE_AGENT); __hip_atomic_store(GH_ + grp * DR + tid, H, __ATOMIC_RELAXED, __HIP_MEMORY_SCOPE_AGENT);
        VM_WAIT();
        __syncthreads();
        if (tid == 0) {
            const unsigned old = __hip_atomic_fetch_add(ctr + 64 * l, 1u, __ATOMIC_RELAXED, __HIP_MEMORY_SCOPE_AGENT);
            const unsigned last = (old == 15u) ? 1u : 0u;
            if (last) { __builtin_amdgcn_fence(__ATOMIC_ACQUIRE, "agent"); asm volatile("s_waitcnt vmcnt(0)" ::: "memory"); }
            flag[1] = last;
        }
        LDS_WAIT();
        __syncthreads();
        if (flag[1]) {
            float ga[16], gh[16];
#pragma unroll
            for (int j = 0; j < 16; ++j) { ga[j] = GA_[j * DR + tid]; gh[j] = GH_[j * DR + tid]; }
            float h = 0.f;
#pragma unroll
            for (int j = 0; j < 16; ++j) { GC_[j * DR + tid] = h; h = gh[j] + ga[j] * h; }
            a.out[O_PH + (size_t)l * DR + tid] = h;
        }
    }
    __syncthreads();
}
}

__device__ __forceinline__ void phase_fin(const Args& a, int l, int wg, int nwg) {
    unsigned char* ws = a.ws;
    const bf16_t* OG = (const bf16_t*)(ws + WS_OG); const float* LSE = (const float*)(ws + WS_LSE);
    const bf16_t* HL = (const bf16_t*)(ws + WS_HL); const bf16_t* CA = (const bf16_t*)(ws + WS_CA); const bf16_t* GY = (const bf16_t*)(ws + WS_GY);
    const float* CARRY = (const float*)(ws + WS_CARRY) + (size_t)l * rg::NCHUNK * DR;
    const float* PREA = (const float*)(ws + WS_PREA) + (size_t)l * rg::NCHUNK * DR; const float* GC = (const float*)(ws + WS_GAGG) + (size_t)l * 3 * 16 * DR + 32 * DR;
    bf16_t* MIX = (bf16_t*)(ws + WS_MIX);
    const size_t gt = (size_t)wg * 512 + pg8::opaque_tid(), NGT = (size_t)nwg * 512;
    constexpr int FU = 4;
    const int grp = (int)(gt & 127);
    const size_t NIT = (size_t)MP * 128;
    if (grp < 64) {
        const int h = grp >> 3;
        for (size_t it0 = gt; it0 < NIT; it0 += FU * NGT) {
            float lse[FU][3]; u32x4 og[FU][3];
#pragma unroll
            for (int u = 0; u < FU; ++u) {
                const size_t it = it0 + u * NGT; const size_t tok = (it < NIT ? it : gt) >> 7;
                const size_t off = tok * 512 + grp * 8;
#pragma unroll
                for (int g = 0; g < 3; ++g) { lse[u][g] = LSE[(size_t)g * MP * 8 + tok * 8 + h]; og[u][g] = *(const u32x4*)(OG + g * (OG_STRIDE / 2) + off); }
            }
#pragma unroll
            for (int u = 0; u < FU; ++u) {
                const size_t it = it0 + u * NGT; const size_t tok = it >> 7;
                const float m = fmaxf(lse[u][0], fmaxf(lse[u][1], lse[u][2]));
                float w0 = fexp2(lse[u][0] - m), w1 = fexp2(lse[u][1] - m), w2 = fexp2(lse[u][2] - m);
                const float inv = frcp(w0 + w1 + w2); w0 *= inv; w1 *= inv; w2 *= inv;
                u32x4 r;
#pragma unroll
                for (int e = 0; e < 4; ++e) {
                    const float lo = w0 * __builtin_bit_cast(float, og[u][0][e] << 16) + w1 * __builtin_bit_cast(float, og[u][1][e] << 16) + w2 * __builtin_bit_cast(float, og[u][2][e] << 16);
                    const float hh = w0 * __builtin_bit_cast(float, og[u][0][e] & 0xffff0000u) + w1 * __builtin_bit_cast(float, og[u][1][e] & 0xffff0000u) + w2 * __builtin_bit_cast(float, og[u][2][e] & 0xffff0000u);
                    r[e] = cvtpk(lo, hh);
                }
                if (it < NIT) *(u32x4*)(MIX + tok * DM + grp * 8) = r;
            }
        }
    } else {
        const int cg = grp - 64;
        for (size_t it0 = gt; it0 < NIT; it0 += FU * NGT) {
            u32x4 hl[FU], ca[FU], gy[FU]; f32x4 c0[FU], c1[FU];
#pragma unroll
            for (int u = 0; u < FU; ++u) {
                const size_t it = it0 + u * NGT; const size_t tok = (it < NIT ? it : gt) >> 7;
                const size_t off = tok * 512 + cg * 8;
                hl[u] = *(const u32x4*)(HL + off); ca[u] = *(const u32x4*)(CA + off); gy[u] = *(const u32x4*)(GY + off);
                const float* ph_ = CARRY + (tok >> 6) * DR + cg * 8; const float* pa_ = PREA + (tok >> 6) * DR + cg * 8; const float* gc_ = GC + (tok >> 10) * DR + cg * 8;
                c0[u] = *(const f32x4*)ph_ + *(const f32x4*)pa_ * *(const f32x4*)gc_; c1[u] = *(const f32x4*)(ph_ + 4) + *(const f32x4*)(pa_ + 4) * *(const f32x4*)(gc_ + 4);
            }
#pragma unroll
            for (int u = 0; u < FU; ++u) {
                const size_t it = it0 + u * NGT; const size_t tok = it >> 7;
                u32x4 r;
#pragma unroll
                for (int e = 0; e < 4; ++e) {
                    const float clo = (e < 2) ? c0[u][2 * e] : c1[u][2 * e - 4], chi = (e < 2) ? c0[u][2 * e + 1] : c1[u][2 * e - 3];
                    const float lo = (__builtin_bit_cast(float, hl[u][e] << 16) + __builtin_bit_cast(float, ca[u][e] << 16) * clo) * __builtin_bit_cast(float, gy[u][e] << 16);
                    const float hh = (__builtin_bit_cast(float, hl[u][e] & 0xffff0000u) + __builtin_bit_cast(float, ca[u][e] & 0xffff0000u) * chi) * __builtin_bit_cast(float, gy[u][e] & 0xffff0000u);
                    r[e] = cvtpk(lo, hh);
                }
                if (it < NIT) *(u32x4*)(MIX + tok * DM + 512 + cg * 8) = r;
            }
        }
    }
}

__device__ __forceinline__ void dbg_zero_sample_mix(const Args& a, int lo_col, int hi_col) {
    bf16_t* MIX = (bf16_t*)(a.ws + WS_MIX);
    for (size_t i = (size_t)blockIdx.x * 512 + threadIdx.x; i < (size_t)MS * DM; i += (size_t)gridDim.x * 512) { const int c = (int)(i & 1023); if (c >= lo_col && c < hi_col) MIX[(size_t)MP * DM + i] = 0; }
}
namespace sat {
constexpr int NE = 388, NG = 97;
__device__ __forceinline__ const float* row_ptr(const float* cache, const float* fresh, int t, int e) {
    const int ee = e < 387 ? e : 0, g = ee / 129, m = ee - g * 129;
    const int j = WBUF + t - (m << (2 * g));
    return (j >= WBUF) ? (fresh + (size_t)(j - WBUF) * 512) : (cache + (size_t)j * 512);
}
__device__ __forceinline__ void task(LAS unsigned char* lds, const Args& a, int l, int b, int h) {
    const int tid = pg8::opaque_tid(), lane = tid & 63, slot = lane >> 4, d4 = lane & 15;
    const int w = __builtin_amdgcn_readfirstlane(tid >> 6), t = w >> 1, half = w & 1;
    unsigned char* ws = a.ws;
    LAS float* sc = (LAS float*)lds + 256;
    LAS float* sums = sc + 4 * NE;
    LAS float* part = sums + 16;
#ifndef SAT_BD
#define SAT_BD 17
#endif
    constexpr int BD = SAT_BD, NBT = (49 + BD - 1) / BD;
    const size_t cbase = ((size_t)(l * NB + b) * WBUF) * 512 + h * 64;
    const float* ck = a.in[2] + cbase; const float* cv = a.in[3] + cbase;
    const float* nk = a.out + O_SK + cbase + (size_t)(WBUF - NT) * 512; const float* nv = a.out + O_SV + cbase + (size_t)(WBUF - NT) * 512;
    f32x4 qv = *(const f32x4*)((const float*)(ws + WS_QS) + (size_t)(b * 4 + t) * 512 + h * 64 + 4 * d4);
    qv = qv * 0.125f;
#pragma unroll 1
    for (int k = 0; k < NBT; ++k) {
        const int g0 = half + 2 * BD * k;
        f32x4 kv[BD];
#pragma unroll
        for (int i = 0; i < BD; ++i) { const int grp = g0 + 2 * i; const int e = 4 * (grp < NG ? grp : 0) + slot; kv[i] = *(const f32x4*)(row_ptr(ck, nk, t, e) + 4 * d4); }
#pragma unroll
        for (int i = 0; i < BD; ++i) {
            const int grp = g0 + 2 * i;
            float s = (kv[i][0] * qv[0] + kv[i][1] * qv[1]) + (kv[i][2] * qv[2] + kv[i][3] * qv[3]);
            s += __shfl_xor(s, 1); s += __shfl_xor(s, 2); s += __shfl_xor(s, 4); s += __shfl_xor(s, 8);
            const int e = 4 * grp + slot;
            if (grp < NG && d4 == 0) sc[t * NE + e] = (e < 387) ? s : -INFINITY;
        }
    }
    f32x4 vv[BD];
#pragma unroll
    for (int i = 0; i < BD; ++i) { const int e = 4 * (half + 2 * i) + slot; vv[i] = *(const f32x4*)(row_ptr(cv, nv, t, e) + 4 * d4); }
    LDS_WAIT();
    __builtin_amdgcn_s_barrier();
    asm volatile("" ::: "memory");
    if (w < 4) {
        float mx = -INFINITY;
        for (int e = lane; e < NE; e += 64) mx = fmaxf(mx, sc[w * NE + e]);
        mx = wave_max(mx);
        float sum = 0.f;
        for (int e = lane; e < NE; e += 64) { const float pe = expf(sc[w * NE + e] - mx); sc[w * NE + e] = pe; sum += pe; }
        sum = wave_sum(sum);
        if (lane == 0) sums[w] = sum;
    }
    LDS_WAIT();
    __builtin_amdgcn_s_barrier();
    asm volatile("" ::: "memory");
    f32x4 acc = {0.f, 0.f, 0.f, 0.f};
#pragma unroll
    for (int i = 0; i < BD; ++i) { const int e = 4 * (half + 2 * i) + slot; acc += vv[i] * sc[t * NE + e]; }
#pragma unroll 1
    for (int k = 1; k < NBT; ++k) {
        const int g0 = half + 2 * BD * k;
#pragma unroll
        for (int i = 0; i < BD; ++i) { const int grp = g0 + 2 * i; const int e = 4 * (grp < NG ? grp : 0) + slot; vv[i] = *(const f32x4*)(row_ptr(cv, nv, t, e) + 4 * d4); }
#pragma unroll
        for (int i = 0; i < BD; ++i) { const int grp = g0 + 2 * i; const int e = 4 * (grp < NG ? grp : 0) + slot; const float pe = (grp < NG) ? sc[t * NE + e] : 0.f; acc += vv[i] * pe; }
    }
#pragma unroll
    for (int c = 0; c < 4; ++c) { acc[c] += __shfl_xor(acc[c], 16); acc[c] += __shfl_xor(acc[c], 32); }
    if (lane < 16) *(LAS f32x4*)(part + w * 64 + 4 * lane) = acc;
    LDS_WAIT();
    __syncthreads();
    if (tid < 256) {
        const int tt = tid >> 6, d = tid & 63;
        const float o = (part[(2 * tt) * 64 + d] + part[(2 * tt + 1) * 64 + d]) / sums[tt];
        ((bf16_t*)(ws + WS_MIX))[(size_t)(MP + b * 4 + tt) * DM + h * 64 + d] = (bf16_t)f2bf(o);
    }
    __syncthreads();
}
}

#ifndef SRG_UNROLL
#define SRG_UNROLL 64
#endif
__device__ __forceinline__ void srglru_task(LAS unsigned char* lds, const Args& a, int l, int b, int n) {
    const int tid = pg8::opaque_tid(), d = tid & 63;
    const int wv = __builtin_amdgcn_readfirstlane(tid >> 6);
    unsigned char* ws = a.ws;
    const int c = n * 64 + d;
    __syncthreads();
    const float* xrs = (const float*)(ws + WS_XRS) + (size_t)b * 4 * DR;
    const float* sconv = a.in[4] + (size_t)(l * NB + b) * 3 * DR;
    float xp[7];
#pragma unroll
    for (int j = 0; j < 3; ++j) xp[j] = sconv[j * DR + c];
#pragma unroll
    for (int j = 0; j < 4; ++j) xp[3 + j] = xrs[j * DR + c];
    const float* cw = a.in[8] + l * 4 * DR;
    const float w0 = cw[c], w1 = cw[DR + c], w2 = cw[2 * DR + c], w3 = cw[3 * DR + c], cb = a.in[9][l * DR + c];
    const float* wa = a.in[10] + (size_t)(l * 8 + n) * 4096 + (size_t)(8 * wv) * 64 + d; const float* wx = a.in[12] + (size_t)(l * 8 + n) * 4096 + (size_t)(8 * wv) * 64 + d;
    float va[8], vx[8];
#pragma unroll
    for (int j = 0; j < 8; ++j) { va[j] = wa[j * 64]; vx[j] = wx[j * 64]; }
    float vbga = 0.f, vbgx = 0.f, vsp = 0.f, h = 0.f, gy[4] = {0.f, 0.f, 0.f, 0.f};
    const bf16_t* GY = (const bf16_t*)(ws + WS_GY); bf16_t* MIX = (bf16_t*)(ws + WS_MIX);
    if (wv == 0) {
        vbga = a.in[11][l * DR + c]; vbgx = a.in[13][l * DR + c]; vsp = ((const float*)(ws + WS_SP))[l * DR + c];
        h = a.in[5][(size_t)(l * NB + b) * DR + c];
#pragma unroll
        for (int t = 0; t < 4; ++t) gy[t] = bf2f(GY[((size_t)MP + b * 4 + t) * 512 + c]);
    }
    float xc[4];
#pragma unroll
    for (int t = 0; t < 4; ++t) xc[t] = w0 * xp[t] + w1 * xp[t + 1] + w2 * xp[t + 2] + w3 * xp[t + 3] + cb;
    float pa[4] = {0.f, 0.f, 0.f, 0.f}, px[4] = {0.f, 0.f, 0.f, 0.f};
#pragma unroll
    for (int j = 0; j < 8; ++j) {
#pragma unroll
        for (int t = 0; t < 4; ++t) { const float xv = __builtin_bit_cast(float, __builtin_amdgcn_readlane(__builtin_bit_cast(int, xc[t]), 8 * wv + j)); pa[t] += xv * va[j]; px[t] += xv * vx[j]; }
    }
    LAS float* part = (LAS float*)lds;
#pragma unroll
    for (int t = 0; t < 4; ++t) { part[(wv * 8 + t) * 64 + d] = pa[t]; part[(wv * 8 + 4 + t) * 64 + d] = px[t]; }
    LDS_WAIT();
    __syncthreads();
    if (wv == 0) {
#pragma unroll
        for (int t = 0; t < 4; ++t) {
            float sa = 0.f, sx = 0.f;
#pragma unroll
            for (int q = 0; q < 8; ++q) { sa += part[(q * 8 + t) * 64 + d]; sx += part[(q * 8 + 4 + t) * 64 + d]; }
            pa[t] = sa; px[t] = sx;
        }
#pragma unroll
        for (int t = 0; t < 4; ++t) {
            const float rg_ = 1.0f / (1.0f + expf(-(pa[t] + vbga))), ig_ = 1.0f / (1.0f + expf(-(px[t] + vbgx)));
            const float la = -8.0f * rg_ * vsp;
            const float av = expf(la), bv = sqrtf(-rg::expm1_(2.0f * la)) * (ig_ * xc[t]);
            h = av * h + bv;
            const size_t row = (size_t)MP + b * 4 + t;
            MIX[row * DM + 512 + c] = (bf16_t)f2bf(h * gy[t]);
        }
        a.out[O_SH + (size_t)(l * NB + b) * DR + c] = h;
#pragma unroll
        for (int j = 0; j < 3; ++j) a.out[O_SC + ((size_t)(l * NB + b) * 3 + j) * DR + c] = xp[4 + j];
    }
    __syncthreads();
}

__device__ __forceinline__ void phase_final(const Args& a, int wg, int nwg) {
    unsigned char* ws = a.ws;
    const int tid = pg8::opaque_tid(), lane = tid & 63, wave = tid >> 6;
    const int gw = wg * 8 + wave, NGW = nwg * 8;
    const bf16_t* XB = (const bf16_t*)(ws + WS_XBA); const float* ssqp = (const float*)(ws + WS_SSQP + 4 * SSQP_STRIDE);
    const float* gf = a.in[20];
    f32x4 g0[2], g1[2];
#pragma unroll
    for (int j = 0; j < 2; ++j) { g0[j] = *((const f32x4*)gf + 2 * lane + 128 * j); g1[j] = *((const f32x4*)gf + 2 * lane + 128 * j + 1); }
    for (int m = gw; m < MP; m += NGW) {
        const float rs = row_rstd(ssqp, m);
        f32x4* o = (f32x4*)(a.out + O_YP + (size_t)m * DM);
#pragma unroll
        for (int j = 0; j < 2; ++j) {
            const u32x4 xw = *((const u32x4*)(XB + (size_t)m * DM) + lane + 64 * j);
            const f32x4 a0 = {__builtin_bit_cast(float, xw.x << 16), __builtin_bit_cast(float, xw.x & 0xffff0000u), __builtin_bit_cast(float, xw.y << 16), __builtin_bit_cast(float, xw.y & 0xffff0000u)};
            const f32x4 a1 = {__builtin_bit_cast(float, xw.z << 16), __builtin_bit_cast(float, xw.z & 0xffff0000u), __builtin_bit_cast(float, xw.w << 16), __builtin_bit_cast(float, xw.w & 0xffff0000u)};
            o[2 * lane + 128 * j] = a0 * rs * g0[j]; o[2 * lane + 128 * j + 1] = a1 * rs * g1[j];
        }
    }
}
__device__ __forceinline__ void skinny_down(const Args& a, int l) {
    unsigned char* ws = a.ws;
    const int tid = pg8::opaque_tid(), lane = tid & 63, i = lane & 15, kq = lane >> 4;
    const int w = __builtin_amdgcn_readfirstlane(tid >> 6);
    const bf16_t* Hs = (const bf16_t*)(ws + WS_H) + (size_t)MP * DFF;
    const bf16_t* Wt = (const bf16_t*)(ws + WS_W + (size_t)l * W_LAYER + W_FD);
    float* ACC = (float*)(ws + WS_ACC);
    for (int it = blockIdx.x; it < 256; it += gridDim.x) {
        const int ns = it & 31, ks = it >> 5;
        const bf16_t* ap = Hs + (size_t)(16 * w + i) * DFF + ks * 352 + 8 * kq;
        const bf16_t* bp = Wt + (size_t)(32 * ns + i) * DFF + ks * 352 + 8 * kq;
        bf16x8 af[11], b0[11], b1[11];
#pragma unroll
        for (int s = 0; s < 11; ++s) { af[s] = *(const bf16x8*)(ap + 32 * s); b0[s] = *(const bf16x8*)(bp + 32 * s); b1[s] = *(const bf16x8*)(bp + (size_t)16 * DFF + 32 * s); }
        f32x4 c0 = {0.f, 0.f, 0.f, 0.f}, c1 = c0;
#pragma unroll
        for (int s = 0; s < 11; ++s) { c0 = __builtin_amdgcn_mfma_f32_16x16x32_bf16(af[s], b0[s], c0, 0, 0, 0); c1 = __builtin_amdgcn_mfma_f32_16x16x32_bf16(af[s], b1[s], c1, 0, 0, 0); }
        float* o = ACC + (size_t)ks * MS * DM + (size_t)(16 * w + 4 * kq) * DM + 32 * ns + i;
#pragma unroll
        for (int r = 0; r < 4; ++r) { o[(size_t)r * DM] = c0[r]; o[(size_t)r * DM + 16] = c1[r]; }
    }
}
__device__ __forceinline__ void sample_final(const Args& a, const float oscale = 1.0f) {
    unsigned char* ws = a.ws;
    const int tid = pg8::opaque_tid(), lane = tid & 63, wave = tid >> 6;
    const bf16_t* XB = (const bf16_t*)(ws + WS_XBB) + (size_t)MP * DM; const float* ACC = (const float*)(ws + WS_ACC);
    const float* gf = a.in[20];
    for (int s = blockIdx.x * 8 + wave; s < MS; s += gridDim.x * 8) {
        f32x4 v[4]; float ss = 0.f;
#pragma unroll
        for (int j = 0; j < 2; ++j) {
            const u32x4 xw = *((const u32x4*)(XB + (size_t)s * DM) + lane + 64 * j);
            v[2 * j] = (f32x4){__builtin_bit_cast(float, xw.x << 16), __builtin_bit_cast(float, xw.x & 0xffff0000u), __builtin_bit_cast(float, xw.y << 16), __builtin_bit_cast(float, xw.y & 0xffff0000u)};
            v[2 * j + 1] = (f32x4){__builtin_bit_cast(float, xw.z << 16), __builtin_bit_cast(float, xw.z & 0xffff0000u), __builtin_bit_cast(float, xw.w << 16), __builtin_bit_cast(float, xw.w & 0xffff0000u)};
#pragma unroll
            for (int ks = 0; ks < 8; ++ks) { const f32x4* ap = (const f32x4*)(ACC + (size_t)ks * MS * DM + (size_t)s * DM) + 2 * lane + 128 * j; v[2 * j] += ap[0]; v[2 * j + 1] += ap[1]; }
            ss += (v[2 * j].x * v[2 * j].x + v[2 * j].y * v[2 * j].y) + (v[2 * j].z * v[2 * j].z + v[2 * j].w * v[2 * j].w) + (v[2 * j + 1].x * v[2 * j + 1].x + v[2 * j + 1].y * v[2 * j + 1].y) + (v[2 * j + 1].z * v[2 * j + 1].z + v[2 * j + 1].w * v[2 * j + 1].w);
        }
        ss = wave_sum(ss);
        const float rs = 1.0f / sqrtf(ss * (1.0f / DM) + RMS_EPS);
#pragma unroll
        for (int j = 0; j < 2; ++j) { f32x4* o = (f32x4*)(a.out + O_YS + (size_t)s * DM) + 2 * lane + 128 * j; const f32x4* gp = (const f32x4*)gf + 2 * lane + 128 * j; o[0] = v[2 * j] * (rs * oscale) * gp[0]; o[1] = v[2 * j + 1] * (rs * oscale) * gp[1]; }
    }
}

constexpr int N_PHASES = 16;
#ifndef BG_SD
#define BG_SD 2
#endif
#ifndef MK_ONE_LAUNCH
#define MK_ONE_LAUNCH 1
#endif

__global__ void __launch_bounds__(512, 2) mk_fwd(Args a_unused) {
    extern __shared__ __attribute__((aligned(16))) unsigned char lds_raw[];
    LAS unsigned char* lds = (LAS unsigned char*)lds_raw;
    { const int tid0 = threadIdx.x; for (int u = tid0; u < (LDS_BYTES - MISC_OFF) / 4; u += 512) ((LAS unsigned*)(lds + MISC_OFF))[u] = 0u; }
    __syncthreads();
#ifndef REPM
#define REPM 0
#endif
#define NREP(b) (((REPM >> (b)) & 1) ? 2 : 1)
#define IN(k) phase_on(k)
#define MAKE_BG(a) const cpy::Bg bg{a.in[2], a.in[3], a.out, lds}
#if MK_ONE_LAUNCH
    { XcdBarrier b0 = xcd_barrier_post((unsigned*)((unsigned char*)kargs()->ws + WS_CTL) + CW_BAR, (volatile LAS unsigned*)(lds + MISC_OFF + 32)); (void)b0; }
#ifdef DBG_TIME
#define DBG_STAMP(i) do { if (threadIdx.x == 0) ((volatile LAS unsigned*)(lds + MISC_OFF + 512))[i] = (unsigned)__builtin_amdgcn_s_memrealtime(); } while (0)
#define DBG_PROBE(idx, ph) do { __syncthreads(); if (threadIdx.x == 0) { const unsigned dt_ = (unsigned)__builtin_amdgcn_s_memrealtime() - ((volatile LAS unsigned*)(lds + MISC_OFF + 512))[ph]; \
        unsigned* c_ = (unsigned*)((unsigned char*)kargs()->ws + WS_CTL) + 65536 + 32 * (idx); atomicMax(c_, dt_); atomicMax(c_ + 16, 1000000u - dt_); } } while (0)
#else
#define DBG_STAMP(i) do { } while (0)
#define DBG_PROBE(idx, ph) do { } while (0)
#endif
#define SEAM(k) do { if (IN(k) && IN((k) + 1)) { XcdBarrier b_; b_.bar = (unsigned*)((unsigned char*)kargs()->ws + WS_CTL) + CW_BAR; b_.x = xb_xcc_id(); b_.st = (volatile LAS unsigned*)(lds + MISC_OFF + 32); xcd_barrier(b_); DBG_STAMP((k) + 1); } } while (0)
#else
#define SEAM(k) do { } while (0)
#endif
    const int bid = (int)blockIdx.x, G = (int)gridDim.x;
    DBG_STAMP(0);

#define S_G1(jj, R) do { pg8::Gemm g{(const bf16_t*)(ws + WS_XBA) + (size_t)MP * DM, (const bf16_t*)(wl + W_IN), 256, DIN, DM}; PanelOrder S{jj, R, DIN / 256}; \
        fill_rstd_table(lds, (const float*)(ws + WS_SSQP + (size_t)(l == 0 ? 0 : 2) * SSQP_STRIDE) + (size_t)MP * 16, S); EpiG1 E{lds, ws, a.out, l, MP, true}; \
        pg8::gemm_phase<EpiG1, PanelOrder, true, true>(lds, g, S, E); } while (0)
#define S_G2(jj, R) do { pg8::Gemm g{(const bf16_t*)(ws + WS_MIX) + (size_t)MP * DM, (const bf16_t*)(wl + W_OUT), 256, DM, DM}; PanelOrder S{jj, R, DM / 256}; \
        EpiRes E{nullptr, nullptr, (const bf16_t*)(ws + WS_XBA), (bf16_t*)(ws + WS_XBB), (float*)(ws + WS_SSQP + (size_t)(l == 0 ? 1 : 3) * SSQP_STRIDE), MP, true}; \
        pg8::gemm_phase<EpiRes, PanelOrder, true, true>(lds, g, S, E); } while (0)
#define S_G3(jj, R) do { pg8::Gemm g{(const bf16_t*)(ws + WS_XBB) + (size_t)MP * DM, (const bf16_t*)(wl + W_GU), 256, NGU, DM}; PanelOrder S{jj, R, NGU / 256}; \
        fill_rstd_table(lds, (const float*)(ws + WS_SSQP + (size_t)(l == 0 ? 1 : 3) * SSQP_STRIDE) + (size_t)MP * 16, S); EpiG3 E{lds, (bf16_t*)(ws + WS_H), MP, true}; \
        pg8::gemm_phase<EpiG3, PanelOrder, true, true>(lds, g, S, E); } while (0)
#define S_G4(jj, R, LL) do { unsigned char* wl4_ = ws + WS_W + (size_t)(LL) * W_LAYER; pg8::Gemm g{(const bf16_t*)(ws + WS_H) + (size_t)MP * DFF, (const bf16_t*)(wl4_ + W_FD), 256, DM, DFF}; PanelOrder S{jj, R, DM / 256}; \
        EpiRes E{nullptr, nullptr, (const bf16_t*)(ws + WS_XBB), (bf16_t*)(ws + WS_XBA), (float*)(ws + WS_SSQP + (size_t)((LL) == 0 ? 2 : 4) * SSQP_STRIDE), MP, true}; \
        pg8::gemm_phase<EpiRes, PanelOrder, true, true>(lds, g, S, E); } while (0)

    if (IN(0)) for (int rep_ = 0; rep_ < NREP(0); ++rep_) { LOAD_ARGS(a); MAKE_BG(a); phase_prologue(a, lds); SEAM(0); }
#ifdef DBG_EXTRA_BARRIERS
    for (int eb_ = 0; eb_ < DBG_EXTRA_BARRIERS; ++eb_) { SEAM(0); }
#endif

    for (int l = 0; l < NLAYER; ++l) {
        const int pb = 1 + 6 * l;
        if (IN(pb)) for (int rep_ = 0; rep_ < NREP(1); ++rep_) {
            LOAD_ARGS(a); MAKE_BG(a); unsigned char* ws = a.ws; unsigned char* wl = ws + WS_W + (size_t)l * W_LAYER;
            const int jr = (bid >= G - 8) ? bid - (G - 8) : -1;
            const int NBG = (int)cpy::BG_G1_WGS, GP = G - 8 - NBG;
            if (bid < GP) {
                pg8::Gemm g{(const bf16_t*)(ws + WS_XBA), (const bf16_t*)(wl + W_IN), MP, DIN, DM}; pg8::StaticOrder S; S.init(MP, DIN, GP, bid);
#ifdef G1_STAGGER
                if (bid & 1) { const unsigned long long t0_ = __builtin_amdgcn_s_memrealtime(); while (__builtin_amdgcn_s_memrealtime() - t0_ < G1_STAGGER) __builtin_amdgcn_s_sleep(8); }
#endif
                fill_rstd_table(lds, (const float*)(ws + WS_SSQP + (size_t)(l == 0 ? 0 : 2) * SSQP_STRIDE), S);
                EpiG1 E{lds, ws, a.out, l, 0, false};
                pg8::gemm_phase<EpiG1, pg8::StaticOrder, true, true>(lds, g, S, E);
            }
            if (bid >= GP && bid < G - 8) {
                const int tb = pg8::opaque_tid(), wv = __builtin_amdgcn_readfirstlane(tb >> 6), bw = (bid - GP) * 8 + wv;
                if (l == 0) weight_convert_items(a, (LAS float*)(lds + wv * 16384), WCV_FIRST, WCV_TOTAL, bw, NBG * 8, tb & 63);
                if (l == 0) bg.stream((unsigned)bw * cpy::Q_G1A, cpy::Q_G1A); else bg.stream(cpy::C2 + (unsigned)bw * cpy::Q_G1B, cpy::Q_G1B);
                if (l == 0) DBG_PROBE(9, 1);
            }
            if (l == 0 && bid < GP) DBG_PROBE(10, 1);
#ifdef DBG_SHADOW_G1
            SEAM(pb);
            if (bid < GP) {
                pg8::Gemm g{(const bf16_t*)(ws + WS_XBA), (const bf16_t*)(wl + W_IN), MP, DIN, DM}; pg8::StaticOrder S; S.init(MP, DIN, GP, bid);
#if DBG_SHADOW_G1 == 1
                EpiNull E{};
                pg8::gemm_phase<EpiNull, pg8::StaticOrder, true, true>(lds, g, S, E);
#else
                fill_rstd_table(lds, (const float*)(ws + WS_SSQP + (size_t)(l == 0 ? 0 : 2) * SSQP_STRIDE), S);
                EpiG1T<DBG_SHADOW_G1 - 2> E{lds, ws + 560 * MiB, (float*)(ws + 840 * MiB), l, 0, false};
                pg8::gemm_phase<EpiG1T<DBG_SHADOW_G1 - 2>, pg8::StaticOrder, true, true>(lds, g, S, E);
#endif
            }
#endif
            if (l == 0) { S_G1(jr, 8); }
            if (l == 1) { S_G4(jr, 8, 0); }
            SEAM(pb);
        }
        if (IN(pb + 1)) for (int rep_ = 0; rep_ < NREP(2); ++rep_) {
            LOAD_ARGS(a); MAKE_BG(a); unsigned char* ws = a.ws; unsigned char* wl = ws + WS_W + (size_t)l * W_LAYER;
            const int R = (l == 0) ? 0 : 10, Gp = G - R;
            for (int r2_ = 0; r2_ < NREP(8); ++r2_) for (int t = bid; t < rg::NCHUNK; t += G) rg::task(lds, a, l, t);
            __syncthreads();
            if (l == 1) DBG_PROBE(0, 8);
            if (l == 0) DBG_PROBE(2, 2);
            if (bid < Gp) {
                if (l == 0) for (int t = bid; t < NB * 8; t += Gp) srglru_task(lds, a, l, t >> 3, t & 7);
                __syncthreads();
                for (int r2_ = 0; r2_ < NREP(10); ++r2_)
                    att::run(lds, (const bf16_t*)(ws + WS_Q), (const bf16_t*)(ws + WS_K), (const bf16_t*)(ws + WS_V), (bf16_t*)(ws + WS_OG), (float*)(ws + WS_LSE), bid, Gp, bg);
                __syncthreads();
                if (l == 1) DBG_PROBE(1, 8);
                if (l == 0) DBG_PROBE(3, 2);
                if (l == 0) for (int r2_ = 0; r2_ < NREP(11); ++r2_) for (int t = bid; t < NB * NH; t += Gp) sat::task(lds, a, l, t >> 3, t & 7);
                if (l == 0) DBG_PROBE(4, 2);
            }
            if (l == 1) { S_G1(bid >= Gp ? bid - Gp : -1, 10); }
            if (l == 1 && G == 256) {
                const int wv_ = __builtin_amdgcn_readfirstlane(pg8::opaque_tid() >> 6);
                if (bid >= (int)cpy::SM_FIRST && bid < Gp) bg.stream(cpy::C7 + (unsigned)((bid - (int)cpy::SM_FIRST) * 8 + wv_) * cpy::Q_SM, cpy::Q_SM);
                if (bid >= Gp) bg.stream(cpy::C8 + (unsigned)((bid - Gp) * 8 + wv_) * cpy::Q_SR, cpy::Q_SR);
            }
            if (l == 1 && bid >= Gp) bg.drain();
            SEAM(pb + 1);
        }
        if (IN(pb + 2)) for (int rep_ = 0; rep_ < NREP(3); ++rep_) {
            LOAD_ARGS(a); MAKE_BG(a); unsigned char* ws = a.ws; unsigned char* wl = ws + WS_W + (size_t)l * W_LAYER;
            const int R = (l == 0) ? 4 : 0, Gp = G - R;
            if (bid < Gp) {
                if (l == 1) { for (int t = bid; t < NB * 8; t += Gp) srglru_task(lds, a, l, t >> 3, t & 7); __syncthreads(); for (int t = bid; t < NB * NH; t += Gp) sat::task(lds, a, l, t >> 3, t & 7); }
                if (l == 1) DBG_PROBE(5, 9);
                phase_fin(a, l, bid, Gp);
                if (l == 1) DBG_PROBE(6, 9);
                if (l == 0) DBG_PROBE(7, 3);
                if (l == 0 && G == 256) { const int wv_ = __builtin_amdgcn_readfirstlane(pg8::opaque_tid() >> 6); bg.stream(cpy::C6 + (unsigned)(bid * 8 + wv_) * cpy::Q_SF, cpy::Q_SF); }
            }
            if (l == 0) { S_G2(bid >= Gp ? bid - Gp : -1, 4); }
            SEAM(pb + 2);
        }
        if (IN(pb + 3)) for (int rep_ = 0; rep_ < NREP(4); ++rep_) {
            LOAD_ARGS(a); MAKE_BG(a); unsigned char* ws = a.ws; unsigned char* wl = ws + WS_W + (size_t)l * W_LAYER;
            pg8::Gemm g{(const bf16_t*)(ws + WS_MIX), (const bf16_t*)(wl + W_OUT), MP, DM, DM}; pg8::StaticOrder S; S.init(MP, DM, G, bid);
            EpiRes E{nullptr, nullptr, (const bf16_t*)(ws + WS_XBA), (bf16_t*)(ws + WS_XBB), (float*)(ws + WS_SSQP + (size_t)(l == 0 ? 1 : 3) * SSQP_STRIDE), 0, false};
            pg8::gemm_phase<EpiRes, pg8::StaticOrder, true, true>(lds, g, S, E);
            SEAM(pb + 3);
        }
        if (IN(pb + 4)) for (int rep_ = 0; rep_ < NREP(5); ++rep_) {
            LOAD_ARGS(a); MAKE_BG(a); unsigned char* ws = a.ws; unsigned char* wl = ws + WS_W + (size_t)l * W_LAYER;
            const int jr = (bid >= G - 8) ? bid - (G - 8) : -1;
            const int NBG = (int)cpy::BG_G3_WGS, GP = G - 8 - NBG;
            if (bid < GP) {
                pg8::Gemm g{(const bf16_t*)(ws + WS_XBB), (const bf16_t*)(wl + W_GU), MP, NGU, DM}; pg8::StaticOrder S; S.init(MP, NGU, GP, bid);
                fill_rstd_table(lds, (const float*)(ws + WS_SSQP + (size_t)(l == 0 ? 1 : 3) * SSQP_STRIDE), S);
                EpiG3 E{lds, (bf16_t*)(ws + WS_H), 0, false};
#if CPY_EPI
                const cpy::BgE bge{a.in[2], a.in[3], a.out, l};
                pg8::gemm_phase<EpiG3, pg8::StaticOrder, true, true, cpy::BgE>(lds, g, S, E, bge);
#else
                pg8::gemm_phase<EpiG3, pg8::StaticOrder, true, true>(lds, g, S, E);
#endif
            }
            if (bid >= GP && bid < G - 8) {
                const int tb = pg8::opaque_tid(), wv = __builtin_amdgcn_readfirstlane(tb >> 6), bw = (bid - GP) * 8 + wv;
                bg.stream((l == 0 ? cpy::C1 : cpy::C3) + (unsigned)bw * cpy::Q_G3, cpy::Q_G3);
            }
            if (G == 256 && cpy::S3_WGS && bid >= (int)cpy::S3_FIRST && bid < GP) {
                const int wv_ = __builtin_amdgcn_readfirstlane(pg8::opaque_tid() >> 6);
                bg.stream((l == 0 ? cpy::C4 : cpy::C5) + (unsigned)((bid - (int)cpy::S3_FIRST) * 8 + wv_) * cpy::Q_S3, cpy::Q_S3);
            }
            if (l == 0) { S_G3(jr, 8); }
            if (l == 1) { S_G2(jr, 8); }
#ifdef DBG_SHADOW_G3
            SEAM(pb + 4);
            if (bid < GP) {
                pg8::Gemm g{(const bf16_t*)(ws + WS_XBB), (const bf16_t*)(wl + W_GU), MP, NGU, DM}; pg8::StaticOrder S; S.init(MP, NGU, GP, bid);
                EpiNull E{};
                pg8::gemm_phase<EpiNull, pg8::StaticOrder, true, true, pg8::NoBg, DBG_SHADOW_GLL>(lds, g, S, E);
            }
#endif
            SEAM(pb + 4);
        }
        if (IN(pb + 5)) for (int rep_ = 0; rep_ < NREP(6); ++rep_) {
            LOAD_ARGS(a); MAKE_BG(a); unsigned char* ws = a.ws; unsigned char* wl = ws + WS_W + (size_t)l * W_LAYER;
            pg8::Gemm g{(const bf16_t*)(ws + WS_H), (const bf16_t*)(wl + W_FD), MP, DM, DFF}; pg8::StaticOrder S; S.init(MP, DM, G, bid);
            EpiRes E{nullptr, nullptr, (const bf16_t*)(ws + WS_XBB), (bf16_t*)(ws + WS_XBA), (float*)(ws + WS_SSQP + (size_t)(l == 0 ? 2 : 4) * SSQP_STRIDE), 0, false};
            pg8::gemm_phase<EpiRes, pg8::StaticOrder, true, true>(lds, g, S, E);
            SEAM(pb + 5);
        }
    }
    if (IN(13)) {
        LOAD_ARGS(a); MAKE_BG(a); unsigned char* ws = a.ws; const int l = 1; unsigned char* wl = ws + WS_W + (size_t)l * W_LAYER;
        if (bid < G - 22) phase_final(a, bid, G - 22);
        { S_G3(bid >= G - 22 ? bid - (G - 22) : -1, 22); }
        SEAM(13);
    }
    if (IN(14)) { LOAD_ARGS(a); skinny_down(a, 1); SEAM(14); }
#ifdef DBG_TIME
    float dbg_scale;
    {
        __syncthreads();
        const volatile LAS unsigned* T_ = (const volatile LAS unsigned*)(lds + MISC_OFF + 512);
        unsigned ticks = 0;
        if (DBG_TIME < 6) ticks = (T_[1 + DBG_TIME + 1] - T_[1 + DBG_TIME]) + (T_[7 + DBG_TIME + 1] - T_[7 + DBG_TIME]);
        if (DBG_TIME == 6) ticks = T_[1] - T_[0];
        if (DBG_TIME == 7) ticks = T_[15] - T_[13];
        if (DBG_TIME == 8) ticks = T_[15] - T_[0];
        if (DBG_TIME >= 100 && DBG_TIME < 200) ticks = T_[DBG_TIME - 100 + 1] - T_[DBG_TIME - 100];
        if (DBG_TIME >= 300 && DBG_TIME < 400) ticks = __hip_atomic_load((unsigned*)((unsigned char*)kargs()->ws + WS_CTL) + 65536 + 32 * (DBG_TIME - 300), __ATOMIC_RELAXED, __HIP_MEMORY_SCOPE_AGENT);
        if (DBG_TIME >= 400 && DBG_TIME < 500) ticks = 1000000u - __hip_atomic_load((unsigned*)((unsigned char*)kargs()->ws + WS_CTL) + 65536 + 32 * (DBG_TIME - 400) + 16, __ATOMIC_RELAXED, __HIP_MEMORY_SCOPE_AGENT);
        dbg_scale = 1.0f + (float)ticks * 0.01f * 0.001f;
    }
    if (IN(15)) { LOAD_ARGS(a); MAKE_BG(a); sample_final(a, dbg_scale); bg.drain(); }
#else
    if (IN(15)) { LOAD_ARGS(a); MAKE_BG(a); sample_final(a); bg.drain(); }
#endif
#undef IN
#undef SEAM
}

extern "C" void kernel_launch(void* const* d_in, const int* in_sizes, int n_in, void* d_out, int out_size, void* d_ws, size_t ws_size, hipStream_t stream) {
    static int grid = 0;
    if (grid == 0) {
        if (n_in != 21 || (size_t)out_size != O_END || ws_size < WS_END) { fprintf(stderr, "kernel_launch: unexpected shapes (n_in %d, out %d, ws %zu); nothing launched\n", n_in, out_size, ws_size); grid = -1; return; }
        int dev = 0, cus = 0, per_cu = 0;
        if (hipGetDevice(&dev) != hipSuccess || hipDeviceGetAttribute(&cus, hipDeviceAttributeMultiprocessorCount, dev) != hipSuccess) { grid = -1; return; }
        if (hipFuncSetAttribute((const void*)mk_fwd, hipFuncAttributeMaxDynamicSharedMemorySize, LDS_BYTES) != hipSuccess) { fprintf(stderr, "kernel_launch: hipFuncSetAttribute failed\n"); grid = -1; return; }
        if (hipOccupancyMaxActiveBlocksPerMultiprocessor(&per_cu, (const void*)mk_fwd, 512, LDS_BYTES) != hipSuccess || per_cu < 1) { fprintf(stderr, "kernel_launch: occupancy query says %d blocks per CU\n", per_cu); }
        (void)hipGetLastError();
        grid = cus;
    }
    if (grid < 0) return;
    hipMemsetAsync((char*)d_ws + WS_CTL, 0, CTL_ZERO_BYTES, stream);
    Args a{};
    for (int i = 0; i < 21; ++i) a.in[i] = (const float*)d_in[i];
    a.out = (float*)d_out; a.ws = (unsigned char*)d_ws;
#if MK_ONE_LAUNCH
    a.ph_lo = 0; a.ph_hi = N_PHASES;
    hipLaunchKernelGGL(mk_fwd, dim3(grid), dim3(512), LDS_BYTES, stream, a);
#else
    for (int p = 0; p < N_PHASES; ++p) { a.ph_lo = p; a.ph_hi = p + 1; hipLaunchKernelGGL(mk_fwd, dim3(grid), dim3(512), LDS_BYTES, stream, a); }
#endif
}
```

```cpp
#define MK_ONE_LAUNCH 1
#define CPQ_G1A 2u
#include <hip/hip_runtime.h>
#include <cstdio>
#include <cstdint>

namespace pg8 {
#define PG8_LAS __attribute__((address_space(3)))
typedef unsigned short bf16_t;
typedef short bf16x8 __attribute__((ext_vector_type(8)));
typedef float f32x4 __attribute__((ext_vector_type(4)));
typedef unsigned u32x4 __attribute__((ext_vector_type(4)));
constexpr int BM = 256, BK = 64, HALF = 128, HTB = HALF * BK * 2  , STAGE_BYTES = 8 * HTB, NXCD = 8, WGM = 8;

__host__ __device__ __forceinline__ int lds_byte(int r, int c) { const int st = (r >> 4) * 2 + (c >> 5), rr = r & 15, cc = c & 31, ob = rr * 64 + cc * 2; return st * 1024 + (ob ^ (((ob >> 9) & 1) << 5)); }
__host__ __device__ __forceinline__ void stage_rc(int b, int& R, int& C) { const int st = b / 1024, sb = b % 1024, swz = sb ^ (((sb >> 9) & 1) << 5); R = (st >> 1) * 16 + swz / 64; C = (st & 1) * 32 + (swz % 64) / 2; }
__host__ __device__ __forceinline__ int perm32(int rho) { const int n = rho >> 4, i = rho & 15; return 8 * (i >> 2) + 4 * n + (i & 3); }

struct Unit { int pm, pn; };
struct Gemm { const bf16_t* A; const bf16_t* Bt; int M, N, K; };

struct StaticOrder {
    int nM, nN, nwg, G, c;
    __host__ __device__ void init(int M, int N, int G_, int c_) { nM = M / BM; nN = N / BM; nwg = nM * nN; G = G_; c = c_; }
    __host__ __device__ bool next(int i, Unit& u) const {
        const long L = (long)i * G + c; if (L >= nwg) return false;
        int wgid = (int)L; { const int q = nwg / NXCD, r = nwg % NXCD, xcd = wgid % NXCD, off = wgid / NXCD; wgid = (xcd < r ? xcd * (q + 1) : r * (q + 1) + (xcd - r) * q) + off; }
        const int nig = WGM * nN, gid = wgid / nig, fm = gid * WGM, gsz = (nM - fm) < WGM ? (nM - fm) : WGM;
        u.pm = fm + ((wgid % nig) % gsz); u.pn = (wgid % nig) / gsz; return true;
    }
    __device__ __forceinline__ void a_ready(const Unit&) const {}
    __device__ __forceinline__ void done(const Unit&) const {}
};

__device__ __forceinline__ int opaque_tid() { int t = threadIdx.x; asm volatile("" : "+v"(t)); return t; }
__device__ __forceinline__ unsigned cvt_pk_bf16(float lo, float hi) { unsigned r; asm volatile("v_cvt_pk_bf16_f32 %0, %1, %2" : "=v"(r) : "v"(lo), "v"(hi)); return r; }

struct NoBg { struct Regs {}; __device__ __forceinline__ void begin(Regs&) const {} __device__ __forceinline__ void begin(Regs&, const Unit&) const {} __device__ __forceinline__ void end(Regs&) const {} };
#ifndef PG8_GLL
#define PG8_GLL false
#endif
template <class Epi, class Sched, bool ALIGN_EPI = false, bool SP2 = false, class Bg = NoBg, bool GLL = PG8_GLL>
__device__ __forceinline__ void gemm_phase(PG8_LAS unsigned char* lds, const Gemm g, const Sched& S, const Epi& E, const Bg& B = Bg()) {
    const int tid = opaque_tid(), wid = __builtin_amdgcn_readfirstlane(tid >> 6), lane = tid & 63, wr = wid >> 2, wc = wid & 3, fr = lane & 15, fq = lane >> 4;
    const int K = g.K, nt = K / BK;
    unsigned voffA[2], voffB[2];
#pragma unroll
    for (int i = 0; i < 2; ++i) { int R, C; stage_rc(tid * 16 + i * 8192, R, C); const int Rb = Epi::PERM ? ((R & ~31) + perm32(R & 31)) : R;
        voffA[i] = (unsigned)(R * K + C) * 2u; voffB[i] = (unsigned)(Rb * K + C) * 2u; }
    const unsigned kstep = (unsigned)(BK * 2);
    const unsigned hstep = (unsigned)HALF * K * 2;
    const unsigned tstep = 2 * hstep;
    const __amdgpu_buffer_rsrc_t rsA = __builtin_amdgcn_make_buffer_rsrc((void*)g.A, 0, (int)((unsigned)g.M * (unsigned)K * 2u), 0x00020000);
    const __amdgpu_buffer_rsrc_t rsB = __builtin_amdgcn_make_buffer_rsrc((void*)g.Bt, 0, (int)((unsigned)g.N * (unsigned)K * 2u), 0x00020000);
    const unsigned ldsw = (unsigned)wid * 1024u;
    const int aoff = lds_byte(wr * 64 + fr, fq * 8), boff = lds_byte(wc * 32 + fr, fq * 8);
#define PG8_SA(b, h) (((b) * 2 + (h)) * HTB)
#define PG8_SB(b, h) ((4 + (b) * 2 + (h)) * HTB)
#define PG8_STAGE(bufoff, gbase, voff) do { _Pragma("unroll") for (int _i = 0; _i < 2; ++_i) \
        { if constexpr (GLL) __builtin_amdgcn_global_load_lds((const unsigned*)((const char*)(PG8_BASE_##voff) + (size_t)(gbase) + (voff)[_i]), (PG8_LAS unsigned*)(lds + (bufoff) + ldsw + _i * 8192), 16, 0, 0); \
          else __builtin_amdgcn_raw_ptr_buffer_load_lds(PG8_RSRC_##voff, (PG8_LAS void*)(lds + (bufoff) + ldsw + _i * 8192), 16, (int)(voff)[_i], (int)(gbase), 0, 0); } } while (0)
#define PG8_BASE_voffA g.A
#define PG8_BASE_voffB g.Bt
#define PG8_RSRC_voffA rsA
#define PG8_RSRC_voffB rsB
#define PG8_LDA(dst, b, h) do { _Pragma("unroll") for (int m = 0; m < 4; ++m) _Pragma("unroll") for (int k = 0; k < 2; ++k) dst[m][k] = *(const PG8_LAS bf16x8*)(lds + PG8_SA(b, h) + aoff + m * 2048 + k * 1024); } while (0)
#define PG8_LDB(dst, b, h) do { _Pragma("unroll") for (int n = 0; n < 2; ++n) _Pragma("unroll") for (int k = 0; k < 2; ++k) dst[n][k] = *(const PG8_LAS bf16x8*)(lds + PG8_SB(b, h) + boff + n * 2048 + k * 1024); } while (0)
#define PG8_MMA(ai, bj, At, Bt) do { __builtin_amdgcn_s_setprio(1); _Pragma("unroll") for (int m = 0; m < 4; ++m) _Pragma("unroll") for (int n = 0; n < 2; ++n) _Pragma("unroll") for (int k = 0; k < 2; ++k) \
        acc[ai][bj][m][n] = __builtin_amdgcn_mfma_f32_16x16x32_bf16(Bt[n][k], At[m][k], acc[ai][bj][m][n], 0, 0, 0); __builtin_amdgcn_s_setprio(0); } while (0)
#define PG8_WAIT_V(n) asm volatile("s_waitcnt vmcnt(" #n ")" ::: "memory")
#define PG8_WAIT_L(n) asm volatile("s_waitcnt lgkmcnt(" #n ")" ::: "memory")
#define PG8_BAR __builtin_amdgcn_s_barrier()
#define PG8_SCHED __builtin_amdgcn_sched_barrier(0)
    Unit cur, nxt; int ui = 0;
    if (!S.next(0, cur)) return;
    f32x4 acc[2][2][4][2];
#pragma unroll
    for (int a = 0; a < 2; ++a)
#pragma unroll
        for (int b = 0; b < 2; ++b)
#pragma unroll
            for (int m = 0; m < 4; ++m)
#pragma unroll
                for (int n = 0; n < 2; ++n) acc[a][b][m][n] = (f32x4){0.f, 0.f, 0.f, 0.f};
    bf16x8 At[4][2], B0[2][2], B1[2][2];
    unsigned cA = (unsigned)cur.pm * tstep, cB = (unsigned)cur.pn * tstep;
    S.a_ready(cur);
    if constexpr (SP2) {
        PG8_STAGE(PG8_SB(0, 0), cB, voffB); PG8_STAGE(PG8_SB(0, 1), cB + hstep, voffB); PG8_STAGE(PG8_SA(0, 0), cA, voffA); PG8_STAGE(PG8_SA(0, 1), cA + hstep, voffA);
        if (wr == 1) PG8_BAR;
        PG8_WAIT_V(2); PG8_BAR;
        PG8_STAGE(PG8_SB(1, 0), cB + kstep, voffB); PG8_STAGE(PG8_SA(1, 0), cA + kstep, voffA); PG8_STAGE(PG8_SB(1, 1), cB + hstep + kstep, voffB);
        PG8_WAIT_V(6); PG8_BAR;
    } else {
        PG8_STAGE(PG8_SB(0, 0), cB, voffB); PG8_STAGE(PG8_SA(0, 0), cA, voffA); PG8_STAGE(PG8_SB(0, 1), cB + hstep, voffB); PG8_STAGE(PG8_SA(0, 1), cA + hstep, voffA);
        if (wr == 1) PG8_BAR;
        PG8_WAIT_V(4); PG8_BAR;
        PG8_STAGE(PG8_SB(1, 0), cB + kstep, voffB); PG8_STAGE(PG8_SA(1, 0), cA + kstep, voffA); PG8_STAGE(PG8_SB(1, 1), cB + hstep + kstep, voffB);
        PG8_WAIT_V(6); PG8_BAR;
    }
    for (;;) {
        const bool has_next = S.next(ui + 1, nxt);
        const unsigned nA = has_next ? (unsigned)nxt.pm * tstep : cA, nB = has_next ? (unsigned)nxt.pn * tstep : cB;
        for (int t = 0; t < nt; t += 2) {
            const bool last = (t == nt - 2);
            const unsigned a1 = cA + (unsigned)(t + 1) * kstep;
            const unsigned a2 = last ? nA : cA + (unsigned)(t + 2) * kstep, b2 = last ? nB : cB + (unsigned)(t + 2) * kstep;
            const unsigned a3 = a2 + kstep, b3 = b2 + kstep;
            if (last && has_next) S.a_ready(nxt);
            if constexpr (SP2) {
            PG8_LDB(B0, 0, 0); PG8_LDB(B1, 0, 1); PG8_SCHED; PG8_LDA(At, 0, 0); PG8_STAGE(PG8_SA(1, 1), a1 + hstep, voffA);
            PG8_WAIT_V(8); PG8_WAIT_L(0); PG8_BAR; PG8_MMA(0, 0, At, B0); PG8_MMA(0, 1, At, B1); PG8_BAR; PG8_SCHED;
            PG8_LDA(At, 0, 1); PG8_STAGE(PG8_SB(0, 0), b2, voffB); PG8_STAGE(PG8_SB(0, 1), b2 + hstep, voffB); PG8_STAGE(PG8_SA(0, 0), a2, voffA);
            PG8_WAIT_V(8); PG8_WAIT_L(0); PG8_BAR; PG8_MMA(1, 0, At, B0); PG8_MMA(1, 1, At, B1); PG8_BAR; PG8_SCHED;
            PG8_LDB(B0, 1, 0); PG8_LDB(B1, 1, 1); PG8_SCHED; PG8_LDA(At, 1, 0); PG8_STAGE(PG8_SA(0, 1), a2 + hstep, voffA);
            PG8_WAIT_V(8); PG8_WAIT_L(0); PG8_BAR; PG8_MMA(0, 0, At, B0); PG8_MMA(0, 1, At, B1); PG8_BAR; PG8_SCHED;
            PG8_LDA(At, 1, 1); PG8_STAGE(PG8_SB(1, 0), b3, voffB); PG8_STAGE(PG8_SB(1, 1), b3 + hstep, voffB); PG8_STAGE(PG8_SA(1, 0), a3, voffA);
            PG8_WAIT_V(8); PG8_WAIT_L(0); PG8_BAR; PG8_MMA(1, 0, At, B0); PG8_MMA(1, 1, At, B1); PG8_BAR; PG8_SCHED;
            } else {
            PG8_LDB(B0, 0, 0); PG8_SCHED; PG8_LDA(At, 0, 0); PG8_STAGE(PG8_SA(1, 1), a1 + hstep, voffA);
            PG8_WAIT_L(8); PG8_BAR; PG8_WAIT_L(0); PG8_MMA(0, 0, At, B0); PG8_BAR; PG8_SCHED;
            PG8_LDB(B1, 0, 1); PG8_STAGE(PG8_SB(0, 0), b2, voffB);
            PG8_BAR; PG8_WAIT_L(0); PG8_MMA(0, 1, At, B1); PG8_BAR;
            PG8_LDA(At, 0, 1); PG8_STAGE(PG8_SA(0, 0), a2, voffA);
            PG8_BAR; PG8_WAIT_L(0); PG8_MMA(1, 0, At, B0); PG8_BAR; PG8_SCHED;
            PG8_STAGE(PG8_SB(0, 1), b2 + hstep, voffB);
            PG8_WAIT_V(6); PG8_BAR; PG8_MMA(1, 1, At, B1); PG8_BAR;
            PG8_LDB(B0, 1, 0); PG8_SCHED; PG8_LDA(At, 1, 0); PG8_STAGE(PG8_SA(0, 1), a2 + hstep, voffA);
            PG8_WAIT_L(8); PG8_BAR; PG8_WAIT_L(0); PG8_MMA(0, 0, At, B0); PG8_BAR; PG8_SCHED;
            PG8_LDB(B1, 1, 1); PG8_STAGE(PG8_SB(1, 0), b3, voffB);
            PG8_BAR; PG8_WAIT_L(0); PG8_MMA(0, 1, At, B1); PG8_BAR;
            PG8_LDA(At, 1, 1); PG8_STAGE(PG8_SA(1, 0), a3, voffA);
            PG8_BAR; PG8_WAIT_L(0); PG8_MMA(1, 0, At, B0); PG8_BAR; PG8_SCHED;
            PG8_STAGE(PG8_SB(1, 1), b3 + hstep, voffB);
            PG8_WAIT_V(6); PG8_BAR; PG8_MMA(1, 1, At, B1); PG8_BAR;
            }
        }
        if constexpr (ALIGN_EPI) { if (wr == 0) PG8_BAR; }
        if constexpr (!Epi::AFTER_DRAIN) { typename Bg::Regs bgr; E(acc, cur, wr, wc, fr, fq, ui, B, bgr); B.end(bgr); S.done(cur); }
        if (!has_next) break;
#pragma unroll
        for (int a = 0; a < 2; ++a)
#pragma unroll
            for (int b = 0; b < 2; ++b)
#pragma unroll
                for (int m = 0; m < 4; ++m)
#pragma unroll
                    for (int n = 0; n < 2; ++n) acc[a][b][m][n] = (f32x4){0.f, 0.f, 0.f, 0.f};
        cur = nxt; cA = nA; cB = nB; ++ui;
        if constexpr (ALIGN_EPI) { if (wr == 1) PG8_BAR; }
    }
    PG8_WAIT_V(0);
    if constexpr (!ALIGN_EPI) { if (wr == 0) PG8_BAR; }
    PG8_BAR;
#undef PG8_SA
#undef PG8_SB
#undef PG8_STAGE
#undef PG8_BASE_voffA
#undef PG8_BASE_voffB
#undef PG8_RSRC_voffA
#undef PG8_RSRC_voffB
#undef PG8_LDA
#undef PG8_LDB
#undef PG8_MMA
#undef PG8_WAIT_V
#undef PG8_WAIT_L
#undef PG8_BAR
#undef PG8_SCHED
}
}

#define LAS __attribute__((address_space(3)))
#define GAS __attribute__((address_space(1)))
typedef unsigned short bf16_t;
typedef short bf16x8 __attribute__((ext_vector_type(8)));
typedef short s16x4 __attribute__((ext_vector_type(4)));
typedef float f32x4 __attribute__((ext_vector_type(4)));
typedef float f32x16 __attribute__((ext_vector_type(16)));
typedef unsigned u32x4 __attribute__((ext_vector_type(4)));
typedef unsigned u32x2 __attribute__((ext_vector_type(2)));

constexpr int MP = 16384;
constexpr int MS = 128;
constexpr int MROWS = MP + MS;
constexpr int MTOT = 16640;
constexpr int DM = 1024, DIN = 2560, DA = 512, DR = 512, DFF = 2816, NGU = 2 * DFF;
constexpr int NH = 8, HD = 64, WBUF = 2048, NB = 32, NT = 4, NLAYER = 2;
constexpr int ROPE_ROWS = MP + NT;
constexpr float RMS_EPS = 1e-6f;
constexpr float QSCALE = 0.18033688011112042f;

constexpr size_t O_YP = 0, O_YS = 16777216, O_PK = 16908288, O_PV = 19005440, O_PC = 21102592, O_PH = 21105664,
                 O_SK = 21106688, O_SV = 88215552, O_SC = 155324416, O_SH = 155422720, O_END = 155455488;

constexpr size_t MiB = 1u << 20;
constexpr size_t WS_CTL = 0, CTL_ZERO_BYTES = 1 * MiB;
constexpr size_t WS_ROPE = 1 * MiB;
constexpr size_t WS_WGT = 3 * MiB;
constexpr size_t WS_SP = WS_WGT + 512 * 1024;
constexpr size_t WS_W = 5 * MiB, W_LAYER = 24 * MiB;
constexpr size_t W_IN = 0, W_OUT = 5242880, W_GU = 7340032, W_FD = 18874368;
constexpr size_t WS_SSQP = 53 * MiB, SSQP_STRIDE = 1114112;
constexpr size_t WS_QS = 59 * MiB;
constexpr size_t WS_XRS = WS_QS + 512 * 1024;
constexpr size_t WS_LSE = 60 * MiB;
constexpr size_t WS_XBA = 62 * MiB;
constexpr size_t WS_XBB = 95 * MiB;
constexpr size_t WS_X = 128 * MiB;
constexpr size_t WS_Q = 193 * MiB, WS_K = 210 * MiB, WS_V = 227 * MiB, WS_XR = 244 * MiB, WS_GY = 261 * MiB, WS_HL = 278 * MiB, WS_CA = 295 * MiB;
constexpr size_t WS_OG = 312 * MiB, OG_STRIDE = 16 * MiB;
constexpr size_t WS_MIX = 360 * MiB;
constexpr size_t WS_H = 393 * MiB;
constexpr size_t WS_AGGA = 483 * MiB, WS_AGGH = 484 * MiB, WS_CARRY = 485 * MiB;
constexpr size_t WS_ACC = 486 * MiB;
constexpr size_t WS_XP = 491 * MiB;
constexpr size_t WS_PREA = 556 * MiB;
constexpr size_t WS_GAGG = 557 * MiB;
constexpr size_t WS_END = 558 * MiB;

constexpr int CW_BAR = 4096;
constexpr int CW_SG = 12288;
constexpr int CW_RG = 16384;

constexpr int LDS_BYTES = 155648;
constexpr int MISC_OFF = 150 * 1024;

struct Args { const float* in[21]; float* out; unsigned char* ws; int ph_lo, ph_hi; };
typedef const volatile __attribute__((address_space(4))) Args* KArgsPtr;
__device__ __forceinline__ KArgsPtr kargs() { return (KArgsPtr)__builtin_amdgcn_kernarg_segment_ptr(); }
#define LOAD_ARGS(a) Args a; { KArgsPtr k_ = kargs(); _Pragma("unroll") for (int i_ = 0; i_ < 21; ++i_) a.in[i_] = (const float*)k_->in[i_]; a.out = (float*)k_->out; a.ws = (unsigned char*)k_->ws; a.ph_lo = 0; a.ph_hi = 0; }
__device__ __forceinline__ bool phase_on(int k) { KArgsPtr k_ = kargs(); const int lo = k_->ph_lo, hi = k_->ph_hi; return lo <= k && k < hi; }

__device__ __forceinline__ unsigned f2bf(float f) { unsigned u = __builtin_bit_cast(unsigned, f); return (u + 0x7fffu + ((u >> 16) & 1u)) >> 16; }
__device__ __forceinline__ unsigned pk2(float lo, float hi) { return f2bf(lo) | (f2bf(hi) << 16); }
__device__ __forceinline__ float bf2f(unsigned short b) { return __builtin_bit_cast(float, (unsigned)b << 16); }
__device__ __forceinline__ unsigned cvtpk(float lo, float hi) { return pg8::cvt_pk_bf16(lo, hi); }
__device__ __forceinline__ float fexp2(float x) { return __builtin_amdgcn_exp2f(x); }
__device__ __forceinline__ float frcp(float x) { return __builtin_amdgcn_rcpf(x); }
__device__ __forceinline__ float sigmoidf_(float x) { return frcp(1.0f + fexp2(-1.4426950408889634f * x)); }
__device__ __forceinline__ float gelu_tanh(float x) {
    const float u = x * (1.0f + 0.044715f * x * x);
    return x * frcp(1.0f + fexp2(-2.3022081565f * u));
}
#define LDS_WAIT() asm volatile("s_waitcnt lgkmcnt(0)" ::: "memory")
#define VM_WAIT() asm volatile("s_waitcnt vmcnt(0)" ::: "memory")

#ifndef EPI_FENCE_RES
#define EPI_FENCE_RES 1
#endif
#ifndef EPI_FENCE_G1
#define EPI_FENCE_G1 1
#endif
using pg8::Unit;
__device__ __forceinline__ float row_rstd(const float* ssqp, int row) {
    const f32x4* p = (const f32x4*)(ssqp + (size_t)row * 16);
    const f32x4 a = p[0], b = p[1], c = p[2], d = p[3];
    const f32x4 s = (a + b) + (c + d);
    const float ss = (s[0] + s[1]) + (s[2] + s[3]);
    return 1.0f / sqrtf(ss * (1.0f / DM) + RMS_EPS);
}

constexpr int RSTD_OFF = 131072, RSTD_MAX_UNITS = 8;
template <class Sched>
__device__ __forceinline__ void fill_rstd_table(LAS unsigned char* lds, const float* ssqp  , const Sched& S) {
    const int tid = pg8::opaque_tid();
    Unit u;
    for (int i = 0; i < RSTD_MAX_UNITS && S.next(i, u); ++i) {
        const int row = u.pm * 256 + (tid >> 1);
        const f32x4* p = (const f32x4*)(ssqp + (size_t)row * 16) + (tid & 1) * 2;
        const f32x4 s = p[0] + p[1];
        float ss = (s[0] + s[1]) + (s[2] + s[3]);
        ss += __shfl_xor(ss, 1);
        if ((tid & 1) == 0) ((LAS float*)(lds + RSTD_OFF))[i * 256 + (tid >> 1)] = 1.0f / sqrtf(ss * (1.0f / DM) + RMS_EPS);
    }
    LDS_WAIT();
    __syncthreads();
}

struct PanelOrder {
    int j, R, nN;
    __device__ __forceinline__ bool next(int i, Unit& u) const { const int id = j + i * R; if (j < 0 || id >= nN) return false; u.pm = 0; u.pn = id; return true; }
    __device__ __forceinline__ void a_ready(const Unit&) const {}
    __device__ __forceinline__ void done(const Unit&) const {}
};

template <int DBGV = 0> struct EpiG1T {
    static constexpr bool PERM = true, AFTER_DRAIN = false;
    LAS unsigned char* lds; unsigned char* ws; float* out; int l; int row0; bool samp;
    template <class Bg> __device__ __forceinline__ void operator()(const f32x4 (&acc)[2][2][4][2], const Unit& u, int wr, int wc, int fr, int fq, int ui, const Bg& B, typename Bg::Regs& bgr) const {
        const int sect = u.pn >> 1;
        const LAS float* rtab = (const LAS float*)(lds + RSTD_OFF) + ui * 256;
        const bool dorope = (sect <= 1) && ((wc & 1) == 0);
        const bool rl = dorope && (fq < 2);
        const int cbase = (u.pn & 1) * 256 + wc * 32;
        const int ca0 = cbase + (rl ? 4 * fq : 8 * fq), ca1 = cbase + (rl ? 8 + 4 * fq : 8 * fq + 4);
        const float* rope = (const float*)(ws + WS_ROPE) + 4 * (fq & 1);
        bf16_t* bdst = (bf16_t*)(ws + (sect == 0 ? WS_Q : sect == 1 ? WS_K : sect == 2 ? WS_V : sect == 3 ? WS_XR : WS_GY));
        float* pdst = out + (sect == 1 ? O_PK + (size_t)l * WBUF * 512 : sect == 2 ? O_PV + (size_t)l * WBUF * 512 : O_PC + (size_t)l * 3 * 512);
        const int prow0 = (sect == 3) ? (MP - 3) : (MP - WBUF);
        const bool has_p = (sect >= 1 && sect <= 3);
        float* sdst = (sect == 0) ? (float*)(ws + WS_QS) : (sect == 3) ? (float*)(ws + WS_XRS) : out + (sect == 1 ? O_SK : O_SV) + (size_t)l * NB * WBUF * 512;
        const float qs_ = (sect == 0) ? QSCALE : 1.0f;
#pragma unroll
        for (int ai = 0; ai < 2; ++ai) {
            if (ai == 1) { asm volatile("" ::: "memory"); B.begin(bgr, u); }
            if (samp && ai == 1) continue;
#pragma unroll
            for (int m = 0; m < 4; ++m) {
                const int rloc = ai * 128 + wr * 64 + m * 16 + fr, row = row0 + u.pm * 256 + rloc;
                const float rs = rtab[rloc];
                f32x4 cs = {1.f, 1.f, 1.f, 1.f}, sn = {0.f, 0.f, 0.f, 0.f};
                if (dorope) {
                    const int pos = samp ? (MP + (row & 3)) : row;
                    const float* rp = rope + (size_t)pos * 16;
                    cs = *(const f32x4*)rp; sn = *(const f32x4*)(rp + 8);
                }
#pragma unroll
                for (int bj = 0; bj < 2; ++bj) {
                    f32x4 v0 = acc[ai][bj][m][0] * rs, v1 = acc[ai][bj][m][1] * rs;
                    if (rl) { const f32x4 x1 = v0, x2 = v1; v0 = x1 * cs - x2 * sn; v1 = x2 * cs + x1 * sn; }
                    if (sect == 4) {
#pragma unroll
                        for (int e = 0; e < 4; ++e) { v0[e] = gelu_tanh(v0[e]); v1[e] = gelu_tanh(v1[e]); }
                    }
                    if (!samp || sect == 4) {
                        u32x2 w0, w1; w0.x = cvtpk(v0[0] * qs_, v0[1] * qs_); w0.y = cvtpk(v0[2] * qs_, v0[3] * qs_); w1.x = cvtpk(v1[0] * qs_, v1[1] * qs_); w1.y = cvtpk(v1[2] * qs_, v1[3] * qs_);
                        bf16_t* bp = bdst + (size_t)row * 512 + 128 * bj;
                        if (DBGV == 1) { asm volatile("" :: "v"(w0), "v"(w1)); }
                        else if (dorope) { *(u32x2*)(bp + ca0) = w0; *(u32x2*)(bp + ca1) = w1; }
                        else { *(u32x4*)(bp + ca0) = (u32x4){w0.x, w0.y, w1.x, w1.y}; }
                        if (has_p && row >= prow0) { float* o = pdst + (size_t)(row - prow0) * 512 + 128 * bj; *(f32x4*)(o + ca0) = v0; *(f32x4*)(o + ca1) = v1; }
                    } else {
                        const int s = row - MP;
                        const size_t srow = (sect == 1 || sect == 2) ? ((size_t)(s >> 2) * WBUF + (WBUF - NT) + (s & 3)) : (size_t)s;
                        float* o = sdst + srow * 512 + 128 * bj; *(f32x4*)(o + ca0) = v0; *(f32x4*)(o + ca1) = v1;
                    }
                }
                if (EPI_FENCE_G1 && (m & 1)) asm volatile("" ::: "memory");
            }
        }
    }
};

typedef EpiG1T<0> EpiG1;

struct EpiRes {
    static constexpr bool PERM = true, AFTER_DRAIN = false;
    const float* xin_p; const float* xin_s;
    const bf16_t* XBin; bf16_t* XBout; float* ssqp_out; int row0; bool samp;
    template <class Bg> __device__ __forceinline__ void operator()(const f32x4 (&acc)[2][2][4][2], const Unit& u, int wr, int wc, int fr, int fq, int ui, const Bg& B, typename Bg::Regs& bgr) const {
        const int cb = u.pn * 256 + wc * 32 + 8 * fq;
#pragma unroll
        for (int ai = 0; ai < 2; ++ai) {
            if (ai == 1) { B.begin(bgr, u); }
            if (samp && ai == 1) continue;
            u32x4 xw[4][2];
#pragma unroll
            for (int m = 0; m < 4; ++m) {
                const int row = row0 + u.pm * 256 + ai * 128 + wr * 64 + m * 16 + fr;
#pragma unroll
                for (int bj = 0; bj < 2; ++bj) xw[m][bj] = *(const u32x4*)(XBin + (size_t)row * DM + cb + 128 * bj);
            }
#pragma unroll
            for (int m = 0; m < 4; ++m) {
                const int row = row0 + u.pm * 256 + ai * 128 + wr * 64 + m * 16 + fr;
                float ss = 0.f;
#pragma unroll
                for (int bj = 0; bj < 2; ++bj) {
                    const int c0 = cb + 128 * bj;
                    const u32x4 w_ = xw[m][bj];
                    const f32x4 a0 = {__builtin_bit_cast(float, w_.x << 16), __builtin_bit_cast(float, w_.x & 0xffff0000u), __builtin_bit_cast(float, w_.y << 16), __builtin_bit_cast(float, w_.y & 0xffff0000u)};
                    const f32x4 a1 = {__builtin_bit_cast(float, w_.z << 16), __builtin_bit_cast(float, w_.z & 0xffff0000u), __builtin_bit_cast(float, w_.w << 16), __builtin_bit_cast(float, w_.w & 0xffff0000u)};
                    const f32x4 v0 = acc[ai][bj][m][0] + a0, v1 = acc[ai][bj][m][1] + a1;
                    u32x4 w; w.x = cvtpk(v0[0], v0[1]); w.y = cvtpk(v0[2], v0[3]); w.z = cvtpk(v1[0], v1[1]); w.w = cvtpk(v1[2], v1[3]);
                    *(u32x4*)(XBout + (size_t)row * DM + c0) = w;
                    ss += (v0[0] * v0[0] + v0[1] * v0[1]) + (v0[2] * v0[2] + v0[3] * v0[3]) + (v1[0] * v1[0] + v1[1] * v1[1]) + (v1[2] * v1[2] + v1[3] * v1[3]);
                }
                ss += __shfl_xor(ss, 16); ss += __shfl_xor(ss, 32);
                if (fq == 0) ssqp_out[(size_t)row * 16 + u.pn * 4 + wc] = ss;
            }
        }
    }
};

#ifndef EPI_RIDER_AT
#define EPI_RIDER_AT 0
#endif
struct EpiG3 {
    static constexpr bool PERM = true, AFTER_DRAIN = false;
    LAS unsigned char* lds; bf16_t* H; int row0; bool samp;
    template <class Bg> __device__ __forceinline__ void operator()(const f32x4 (&acc)[2][2][4][2], const Unit& u, int wr, int wc, int fr, int fq, int ui, const Bg& B, typename Bg::Regs& bgr) const {
        const int c0 = u.pn * 128 + wc * 32 + 8 * fq;
        const LAS float* rtab = (const LAS float*)(lds + RSTD_OFF) + ui * 256;
#pragma unroll
        for (int ai = 0; ai < 2; ++ai) {
            if (ai == EPI_RIDER_AT) { asm volatile("" ::: "memory"); B.begin(bgr, u); }
            if (samp && ai == 1) continue;
#pragma unroll
            for (int m = 0; m < 4; ++m) {
                const int row = row0 + u.pm * 256 + ai * 128 + wr * 64 + m * 16 + fr;
                const float rs = rtab[ai * 128 + wr * 64 + m * 16 + fr];
                float hv[8];
#pragma unroll
                for (int n = 0; n < 2; ++n)
#pragma unroll
                    for (int e = 0; e < 4; ++e) { const float g = acc[ai][0][m][n][e] * rs, up = acc[ai][1][m][n][e] * rs; hv[4 * n + e] = g * up * sigmoidf_(g); }
                u32x4 w; w.x = cvtpk(hv[0], hv[1]); w.y = cvtpk(hv[2], hv[3]); w.z = cvtpk(hv[4], hv[5]); w.w = cvtpk(hv[6], hv[7]);
                *(u32x4*)(H + (size_t)row * DFF + c0) = w;
                asm volatile("" ::: "memory");
            }
        }
    }
};

struct EpiNull {
    static constexpr bool PERM = true, AFTER_DRAIN = false;
    template <class Bg> __device__ __forceinline__ void operator()(const f32x4 (&acc)[2][2][4][2], const Unit& u, int wr, int wc, int fr, int fq, int ui, const Bg& B, typename Bg::Regs& bgr) const {
#pragma unroll
        for (int ai = 0; ai < 2; ++ai)
#pragma unroll
            for (int bj = 0; bj < 2; ++bj)
#pragma unroll
                for (int m = 0; m < 4; ++m)
#pragma unroll
                    for (int n = 0; n < 2; ++n) asm volatile("" :: "v"(acc[ai][bj][m][n]));
    }
};

#define XB_TMO      128
#define XB_XCNT(j)  (256  + 64 * (j))
#define XB_XSUB(j)  (1280 + 64 * (j))
#define XB_XGEN(j)  (2304 + 64 * (j))
#define XB_TOP      3328
#define XB_TOPGEN   3392
#define XCD_BAR_WORDS 3456
#define XB_SPIN_CAP (1u << 18)
__device__ __forceinline__ unsigned xb_ld(unsigned* p)              { return __hip_atomic_load(p, __ATOMIC_RELAXED, __HIP_MEMORY_SCOPE_AGENT); }
__device__ __forceinline__ unsigned xb_add(unsigned* p, unsigned v) { return __hip_atomic_fetch_add(p, v, __ATOMIC_RELAXED, __HIP_MEMORY_SCOPE_AGENT); }
__device__ __forceinline__ unsigned xb_xcc_id() { return (unsigned)__builtin_amdgcn_s_getreg((3 << 11) | 20) & 0xFu; }
#define XB_SPIN(cond, bar) do { unsigned _sp = 0; while (cond) { __builtin_amdgcn_s_sleep(1); \
    if ((++_sp & 255u) == 0u) { if (xb_ld(&(bar)[XB_TMO])) break; if (_sp > XB_SPIN_CAP) { atomicAdd(&(bar)[XB_TMO], 1u); break; } } } } while (0)
struct XcdBarrier { unsigned* bar; unsigned x; volatile LAS unsigned* st; };
__device__ __forceinline__ XcdBarrier xcd_barrier_post(unsigned* bar, volatile LAS unsigned* st) {
    XcdBarrier b; b.bar = bar; b.x = xb_xcc_id(); b.st = st;
    if (threadIdx.x == 0) (void)xb_add(&bar[XB_XCNT(b.x)], 1u);
    return b;
}
__device__ __forceinline__ void xcd_barrier_complete(unsigned* bar, unsigned x, unsigned& nloc, unsigned& nx) {
    const unsigned G = gridDim.x * gridDim.y * gridDim.z;
    unsigned sum, cnt, mine, sp = 0u;
    for (;;) {
        sum = 0u; cnt = 0u; mine = 0u;
#pragma unroll
        for (unsigned j = 0; j < 16; ++j) { const unsigned c = xb_ld(&bar[XB_XCNT(j)]); sum += c; cnt += (c > 0u) ? 1u : 0u; mine = (j == x) ? c : mine; }
        if (sum == G) break;
        __builtin_amdgcn_s_sleep(1);
        if ((++sp & 255u) == 0u) { if (xb_ld(&bar[XB_TMO])) break; if (sp > XB_SPIN_CAP) { atomicAdd(&bar[XB_TMO], 1u); break; } }
    }
    nloc = mine > 0u ? mine : 1u; nx = cnt > 0u ? cnt : 1u;
}
__device__ __forceinline__ void xcd_barrier(const XcdBarrier& b) {
    asm volatile("s_waitcnt vmcnt(0)" ::: "memory");
    __syncthreads();
    if (threadIdx.x == 0) {
        unsigned* bar = b.bar;
        __builtin_amdgcn_s_waitcnt(0);
        unsigned nloc = b.st[0], nx = b.st[1];
        if (nloc == 0u) { xcd_barrier_complete(bar, b.x, nloc, nx); b.st[0] = nloc; b.st[1] = nx; }
        const unsigned old = xb_add(&bar[XB_XSUB(b.x)], 1u);
        const unsigned gen = old / nloc;
        if (old + 1u == (gen + 1u) * nloc) {
            __builtin_amdgcn_fence(__ATOMIC_RELEASE, "agent");
            asm volatile("s_waitcnt vmcnt(0)" ::: "memory");
            const unsigned og = xb_add(&bar[XB_TOP], 1u);
            const unsigned tg = og / nx;
            if (og + 1u == (tg + 1u) * nx) xb_add(&bar[XB_TOPGEN], 1u);
            else XB_SPIN(xb_ld(&bar[XB_TOPGEN]) == tg, bar);
            __builtin_amdgcn_fence(__ATOMIC_ACQUIRE, "agent");
            xb_add(&bar[XB_XGEN(b.x)], 1u);
            asm volatile("s_waitcnt vmcnt(0)" ::: "memory");
        } else {
            XB_SPIN(xb_ld(&bar[XB_XGEN(b.x)]) == gen, bar);
            __builtin_amdgcn_fence(__ATOMIC_ACQUIRE, "agent");
            asm volatile("s_waitcnt vmcnt(0)" ::: "memory");
        }
    }
    __syncthreads();
}

__device__ __forceinline__ float wave_sum(float v) {
#pragma unroll
    for (int o = 1; o < 64; o <<= 1) v += __shfl_xor(v, o);
    return v;
}
__device__ __forceinline__ float wave_max(float v) {
#pragma unroll
    for (int o = 1; o < 64; o <<= 1) v = fmaxf(v, __shfl_xor(v, o));
    return v;
}
struct WItem { const float* W; int K, N; bf16_t* WT; int item; const float* g; int rowmode; };
__device__ __forceinline__ void ti_load(const WItem& t, int lane, f32x4 (&v)[8], float (&gk)[8]) {
    const int nblk = t.N / 32, kb = t.item / nblk, nb = t.item % nblk, k0 = 64 * kb, n0 = 32 * nb;
#pragma unroll
    for (int i = 0; i < 8; ++i) { const int kk = (lane >> 3) + 8 * i; v[i] = *(const f32x4*)(t.W + (size_t)(k0 + kk) * t.N + n0 + 4 * (lane & 7)); gk[i] = t.g ? t.g[k0 + kk] : 1.0f; }
}
__device__ __forceinline__ void ti_store(const WItem& t, LAS float* scr, int lane, const f32x4 (&v)[8], const float (&gk)[8]) {
    const int nblk = t.N / 32, kb = t.item / nblk, nb = t.item % nblk, k0 = 64 * kb, n0 = 32 * nb;
#pragma unroll
    for (int i = 0; i < 8; ++i) { const int kk = (lane >> 3) + 8 * i; LAS float* d = scr + kk * 33 + 4 * (lane & 7); d[0] = v[i][0] * gk[i]; d[1] = v[i][1] * gk[i]; d[2] = v[i][2] * gk[i]; d[3] = v[i][3] * gk[i]; }
    LDS_WAIT(); asm volatile("" ::: "memory");
    const int c = lane & 7;
#pragma unroll
    for (int j = 0; j < 4; ++j) { const int n = (lane >> 3) + 8 * j; const LAS float* s = scr + (8 * c) * 33 + n;
        u32x4 o; o.x = pk2(s[0 * 33], s[1 * 33]); o.y = pk2(s[2 * 33], s[3 * 33]); o.z = pk2(s[4 * 33], s[5 * 33]); o.w = pk2(s[6 * 33], s[7 * 33]);
        const int nn = n0 + n; int row;
        if (t.rowmode == 0) row = nn;
        else if (t.rowmode == 3) { const int d = nn & 63; row = (nn < 1024 && d < 16) ? ((nn & ~15) + 8 * ((d >> 2) & 1) + 4 * (d >> 3) + (d & 3)) : nn; }
        else row = 256 * (nn >> 7) + (nn & 127) + (t.rowmode == 2 ? 128 : 0);
        *(u32x4*)(t.WT + (size_t)row * t.K + k0 + 8 * c) = o; }
    LDS_WAIT(); asm volatile("" ::: "memory");
}
__device__ __forceinline__ void xrow_to_bf16(const float* xrow, bf16_t* orow, float* ssq16, int lane) {
    f32x4 v[4]; float s = 0.f;
    if (xrow) {
        const f32x4* xr = (const f32x4*)xrow + lane;
#pragma unroll
        for (int j = 0; j < 4; ++j) { v[j] = xr[64 * j]; s += (v[j].x * v[j].x + v[j].y * v[j].y) + (v[j].z * v[j].z + v[j].w * v[j].w); }
    } else {
#pragma unroll
        for (int j = 0; j < 4; ++j) v[j] = (f32x4){0.f, 0.f, 0.f, 0.f};
    }
    s = wave_sum(s);
    unsigned long long* o8 = (unsigned long long*)orow + lane;
#pragma unroll
    for (int j = 0; j < 4; ++j) o8[64 * j] = (unsigned long long)pk2(v[j].x, v[j].y) | ((unsigned long long)pk2(v[j].z, v[j].w) << 32);
    if (lane < 16) ssq16[lane] = (lane == 0) ? s : 0.f;
}
__device__ __forceinline__ void sincos_d(double x, float& c, float& s) {
    const double k = __builtin_rint(x * 0.6366197723675814);
    double r = __builtin_fma(-k, 1.5707963267948966, x); r = __builtin_fma(-k, 6.123233995736766e-17, r);
    const int q = ((int)k) & 3;
    const double r2 = r * r;
    double sp = -7.6471637318198164759e-13; sp = sp * r2 + 1.6059043836821614599e-10; sp = sp * r2 - 2.5052108385441718775e-08; sp = sp * r2 + 2.7557319223985890653e-06;
    sp = sp * r2 - 1.9841269841269841270e-04; sp = sp * r2 + 8.3333333333333333333e-03; sp = sp * r2 - 1.6666666666666666667e-01; const double sn = r + r * r2 * sp;
    double cp = 4.7794773323873852974e-14; cp = cp * r2 - 1.1470745597729724714e-11; cp = cp * r2 + 2.0876756987868098979e-09; cp = cp * r2 - 2.7557319223985890653e-07;
    cp = cp * r2 + 2.4801587301587301587e-05; cp = cp * r2 - 1.3888888888888888889e-03; cp = cp * r2 + 4.1666666666666666667e-02; cp = cp * r2 - 0.5; const double cn = 1.0 + r2 * cp;
    const double sv = (q == 0) ? sn : (q == 1) ? cn : (q == 2) ? -sn : -cn;
    const double cv = (q == 0) ? cn : (q == 1) ? -sn : (q == 2) ? -cn : sn;
    c = (float)cv; s = (float)sv;
}

constexpr int WCV_I_IN = (DM / 64) * (DIN / 32), WCV_I_OUT = (DM / 64) * (DM / 32), WCV_I_F = (DM / 64) * (DFF / 32), WCV_I_D = (DFF / 64) * (DM / 32);
constexpr int WCV_I_LAYER = WCV_I_IN + WCV_I_OUT + 2 * WCV_I_F + WCV_I_D, WCV_TOTAL = NLAYER * WCV_I_LAYER, WCV_FIRST = WCV_I_LAYER;
__device__ __forceinline__ WItem witem_decode(const Args& a, int it) {
    unsigned char* ws = a.ws;
    const int l = it / WCV_I_LAYER; int r = it % WCV_I_LAYER;
    unsigned char* wl = ws + WS_W + (size_t)l * W_LAYER;
    if (r < WCV_I_IN) return WItem{a.in[7] + (size_t)l * DM * DIN, DM, DIN, (bf16_t*)(wl + W_IN), r, a.in[6] + l * DM, 3};
    r -= WCV_I_IN;
    if (r < WCV_I_OUT) return WItem{a.in[15] + (size_t)l * DM * DM, DM, DM, (bf16_t*)(wl + W_OUT), r, nullptr, 0};
    r -= WCV_I_OUT;
    if (r < WCV_I_F) return WItem{a.in[17] + (size_t)l * DM * DFF, DM, DFF, (bf16_t*)(wl + W_GU), r, a.in[16] + l * DM, 1};
    r -= WCV_I_F;
    if (r < WCV_I_F) return WItem{a.in[18] + (size_t)l * DM * DFF, DM, DFF, (bf16_t*)(wl + W_GU), r, a.in[16] + l * DM, 2};
    r -= WCV_I_F;
    return WItem{a.in[19] + (size_t)l * DFF * DM, DFF, DM, (bf16_t*)(wl + W_FD), r, nullptr, 0};
}
__device__ __forceinline__ void weight_convert_items(const Args& a, LAS float* scr, int it0, int it1, int gw, int ngw, int lane) {
    for (int it = it0 + gw; it < it1; it += 2 * ngw) {
        const bool has2 = it + ngw < it1;
        const WItem ta = witem_decode(a, it), tb = witem_decode(a, has2 ? it + ngw : it);
        f32x4 va[8], vb[8]; float ga[8], gb[8];
        ti_load(ta, lane, va, ga);
        ti_load(tb, lane, vb, gb);
        ti_store(ta, scr, lane, va, ga);
        if (has2) ti_store(tb, scr, lane, vb, gb);
    }
}
__device__ __forceinline__ void phase_prologue(const Args& a, LAS unsigned char* lds) {
    const int tid = pg8::opaque_tid(), lane = tid & 63, wave = __builtin_amdgcn_readfirstlane(tid >> 6);
    const int G = gridDim.x, gw = blockIdx.x * 8 + wave, NGW = G * 8;
    LAS float* scr = (LAS float*)(lds + wave * 16384);
    unsigned char* ws = a.ws;
    weight_convert_items(a, scr, 0, WCV_FIRST, gw, NGW, lane);
    {
        bf16_t* XBA = (bf16_t*)(ws + WS_XBA); float* ssq0 = (float*)(ws + WS_SSQP);
        for (int m = gw; m < MTOT; m += NGW) {
            const float* xr = (m < MP) ? (a.in[0] + (size_t)m * DM) : (m < MROWS) ? (a.in[1] + (size_t)(m - MP) * DM) : nullptr;
            xrow_to_bf16(xr, XBA + (size_t)m * DM, ssq0 + (size_t)m * 16, lane);
        }
    }
    const int gt = blockIdx.x * 512 + tid, NGT = G * 512;
    {
        float* rope = (float*)(ws + WS_ROPE);
        for (int e = gt; e < ROPE_ROWS * 8; e += NGT) {
            const int pos = e >> 3, i = e & 7;
            const double inv = (i == 0) ? 1.0 : (i == 1) ? 0.19392274474868576 : (i == 2) ? 0.03760603093086393 : (i == 3) ? 0.007292664737217109 :
                               (i == 4) ? 0.001414213562373095 : (i == 5) ? 0.0002742481756762073 : (i == 6) ? 5.318295896944988e-05 : 1.031338537721246e-05;
            float c, s; sincos_d((double)pos * inv, c, s);
            rope[(size_t)pos * 16 + i] = c; rope[(size_t)pos * 16 + 8 + i] = s;
        }
    }
    {
        bf16_t* wgt = (bf16_t*)(ws + WS_WGT);
        for (int e = gt; e < NLAYER * 2 * 8 * 64 * 64; e += NGT) {
            const int c = e & 63, d = (e >> 6) & 63, n = (e >> 12) & 7, gate = (e >> 15) & 1, l = e >> 16;
            const float* src = a.in[gate ? 12 : 10] + (size_t)((l * 8 + n) * 64 + c) * 64 + d;
            wgt[e] = (bf16_t)f2bf(*src);
        }
        float* sp = (float*)(ws + WS_SP);
        for (int e = gt; e < NLAYER * DR; e += NGT) { const float lam = a.in[14][e]; const float y = expf(-lam); sp[e] = (y < 0.03f) ? y * (1.0f - y * (0.5f - y * (0.33333333f - y * (0.25f - 0.2f * y)))) : logf(1.0f + y); }
    }
}

namespace cpy {
constexpr unsigned CR = 14, CPB = (unsigned)(WBUF - NT) * 2u / CR;
static_assert((WBUF - NT) * 2 % CR == 0, "copy chunking");
constexpr unsigned NCHUNKS = 2u * NLAYER * NB * CPB;
constexpr int LDS_NEXT = MISC_OFF + 128;
#ifndef CPQ_G1A
#define CPQ_G1A 8u
#endif
#ifndef CPQ_G1B
#define CPQ_G1B 18u
#endif
#ifndef CPQ_G3
#define CPQ_G3 32u
#endif
#ifndef CPQ_G3W
#define CPQ_G3W 8
#endif
constexpr unsigned BG_G1_WGS = 32, BG_G3_WGS = CPQ_G3W;
constexpr unsigned Q_G1A = CPQ_G1A, Q_G1B = CPQ_G1B, Q_G3 = CPQ_G3;
constexpr unsigned C1 = BG_G1_WGS * 8u * Q_G1A, C2 = C1 + BG_G3_WGS * 8u * Q_G3, C3 = C2 + BG_G1_WGS * 8u * Q_G1B, C4 = C3 + BG_G3_WGS * 8u * Q_G3;
#ifndef CPQ_S3
#define CPQ_S3 6u
#endif
#ifndef CPQ_SF
#define CPQ_SF 2u
#endif
#ifndef CPQ_SM
#define CPQ_SM 2u
#endif
#ifndef CPQ_SR
#define CPQ_SR 8u
#endif
constexpr unsigned G3_UNITS = (MP / 256) * (NGU / 256), GP3 = 256u - 8u - BG_G3_WGS, S3_FIRST = G3_UNITS % GP3, S3_WGS = S3_FIRST ? GP3 - S3_FIRST : 0u;
constexpr unsigned SF_WGS = 252u, MIX1_GP = 246u, SM_FIRST = 1536u % MIX1_GP, SM_WGS = MIX1_GP - SM_FIRST, SR_WGS = 256u - MIX1_GP;
constexpr unsigned Q_S3 = CPQ_S3, Q_SF = CPQ_SF, Q_SM = CPQ_SM, Q_SR = CPQ_SR;
constexpr unsigned C5 = C4 + S3_WGS * 8u * Q_S3, C6 = C5 + S3_WGS * 8u * Q_S3, C7 = C6 + SF_WGS * 8u * Q_SF, C8 = C7 + SM_WGS * 8u * Q_SM, C9 = C8 + SR_WGS * 8u * Q_SR;
#ifndef CPY_EPI
#define CPY_EPI 1
#endif
constexpr unsigned PR = 7u, EPI_PIECES = CPY_EPI ? 2u * G3_UNITS * 8u : 0u, PIGGY0 = C9 + EPI_PIECES / 2u;
static_assert(PIGGY0 <= NCHUNKS, "copy quotas");
struct BgE {
    const float* ck; const float* cv; float* out; int l;
    struct Regs { f32x4 v[PR]; unsigned pc; };
    __device__ __forceinline__ void addr(unsigned pc, const char*& src, char*& dst) const {
        const unsigned c = C9 + (pc >> 1), half = pc & 1u;
        const unsigned t = c / (NLAYER * NB * CPB), rr = c - t * (NLAYER * NB * CPB), blk = rr / CPB, k = rr - blk * CPB;
        src = (const char*)(t ? cv : ck) + (size_t)blk * (WBUF * 2048u) + NT * 2048u + (size_t)k * (CR * 1024u) + half * (PR * 1024u);
        dst = (char*)(out + (t ? O_SV : O_SK)) + (size_t)blk * (WBUF * 2048u) + (size_t)k * (CR * 1024u) + half * (PR * 1024u);
    }
    __device__ __forceinline__ void begin(Regs& r, const pg8::Unit& u) const {
        const int tid = pg8::opaque_tid(), lane = tid & 63, w = __builtin_amdgcn_readfirstlane(tid >> 6);
        r.pc = (((unsigned)l * G3_UNITS + (unsigned)u.pm * (NGU / 256) + (unsigned)u.pn) << 3) + (unsigned)w;
        const char* s; char* d; addr(r.pc, s, d);
#pragma unroll
        for (int i = 0; i < (int)PR; ++i) r.v[i] = __builtin_nontemporal_load((const f32x4*)(s + i * 1024) + lane);
    }
    __device__ __forceinline__ void end(Regs& r) const {
        const int lane = pg8::opaque_tid() & 63;
        const char* s; char* d; addr(r.pc, s, d);
#pragma unroll
        for (int i = 0; i < (int)PR; ++i) __builtin_nontemporal_store(r.v[i], (f32x4*)(d + i * 1024) + lane);
    }
};
struct Bg {
    const float* ck; const float* cv; float* out; LAS unsigned char* lds;
#ifndef CPY_PGR
#define CPY_PGR 7u
#endif
    static constexpr unsigned PGR = CPY_PGR, PGP = CR / PGR, PG_FIRST = PGP * PIGGY0, PG_END = PGP * NCHUNKS;
    static_assert(CR % PGR == 0, "piggyback piece size");
    struct Regs { f32x4 v[PGR]; unsigned id, nxt; };
    __device__ __forceinline__ void addr(unsigned c, const char*& src, char*& dst) const {
        const unsigned t = c / (NLAYER * NB * CPB), rr = c - t * (NLAYER * NB * CPB), blk = rr / CPB, k = rr - blk * CPB;
        src = (const char*)(t ? cv : ck) + (size_t)blk * (WBUF * 2048u) + NT * 2048u + (size_t)k * (CR * 1024u);
        dst = (char*)(out + (t ? O_SV : O_SK)) + (size_t)blk * (WBUF * 2048u) + (size_t)k * (CR * 1024u);
    }
    __device__ __forceinline__ void paddr(unsigned pc, const char*& src, char*& dst) const { addr(pc / PGP, src, dst); const unsigned o = (pc % PGP) * (PGR * 1024u); src += o; dst += o; }
    __device__ __forceinline__ void begin(Regs& r) const {
        const int tid = pg8::opaque_tid(), lane = tid & 63, w = __builtin_amdgcn_readfirstlane(tid >> 6);
        const unsigned k = (unsigned)__builtin_amdgcn_readfirstlane(((volatile LAS unsigned*)(lds + LDS_NEXT))[w]);
        const unsigned id = PG_FIRST + (blockIdx.x * 8u + (unsigned)w) + k * (gridDim.x * 8u);
        r.id = id < PG_END ? id : PG_END - 1u; r.nxt = id < PG_END ? 1u : 0u;
        if (r.nxt) {
            const char* s; char* d; paddr(r.id, s, d);
#pragma unroll
            for (int i = 0; i < (int)PGR; ++i) r.v[i] = __builtin_nontemporal_load((const f32x4*)(s + i * 1024) + lane);
        }
        if (lane == 0) ((LAS unsigned*)(lds + LDS_NEXT))[w] = k + 1u;
    }
    __device__ __forceinline__ void end(Regs& r) const {
        const int lane = pg8::opaque_tid() & 63;
        if (r.nxt) {
            const char* s; char* d; paddr(r.id, s, d);
#pragma unroll
            for (int i = 0; i < (int)PGR; ++i) __builtin_nontemporal_store(r.v[i], (f32x4*)(d + i * 1024) + lane);
        }
    }
    __device__ __forceinline__ void prime(Regs& r) const { begin(r); }
    __device__ __forceinline__ void rotate(Regs& r) const { end(r); begin(r); }
    __device__ __forceinline__ void stream(unsigned c0, unsigned n) const {
        const int lane = pg8::opaque_tid() & 63;
        for (unsigned c = c0; c < c0 + n; c += 2) {
            f32x4 va[CR], vb[CR];
            const char *sa, *sb; char *da, *db; addr(c, sa, da); addr(c + 1, sb, db);
#pragma unroll
            for (int i = 0; i < (int)CR; ++i) va[i] = __builtin_nontemporal_load((const f32x4*)(sa + i * 1024) + lane);
#pragma unroll
            for (int i = 0; i < (int)CR; ++i) vb[i] = __builtin_nontemporal_load((const f32x4*)(sb + i * 1024) + lane);
#pragma unroll
            for (int i = 0; i < (int)CR; ++i) __builtin_nontemporal_store(va[i], (f32x4*)(da + i * 1024) + lane);
#pragma unroll
            for (int i = 0; i < (int)CR; ++i) __builtin_nontemporal_store(vb[i], (f32x4*)(db + i * 1024) + lane);
        }
    }
    __device__ __forceinline__ void drain() const {
        const int w = __builtin_amdgcn_readfirstlane(pg8::opaque_tid() >> 6);
        for (;;) {
            const unsigned k = (unsigned)__builtin_amdgcn_readfirstlane(((volatile LAS unsigned*)(lds + LDS_NEXT))[w]);
            if (PG_FIRST + (blockIdx.x * 8u + (unsigned)w) + k * (gridDim.x * 8u) >= PG_END) break;
            Regs r; begin(r); end(r); LDS_WAIT();
        }
    }
};
}

namespace att {
constexpr int KCH = 6144;
constexpr int K_OFF = 0, V_OFF = 8 * KCH, VHALF = 384 * 64, WS_OFF = V_OFF + 2 * VHALF, OST_OFF = WS_OFF + 8 * 256, LDS_END = OST_OFF + 8 * 4096;
static_assert(LDS_END <= MISC_OFF, "attention LDS map");
typedef short v4i16_t __attribute__((ext_vector_type(4)));
__device__ __forceinline__ s16x4 vtr(const LAS unsigned char* p) { return __builtin_bit_cast(s16x4, __builtin_amdgcn_ds_read_tr16_b64_v4i16((LAS v4i16_t*)p)); }
__device__ __forceinline__ int crow(int r, int hi) { return (r & 3) + 8 * (r >> 2) + 4 * hi; }

struct UnitP { int dsh, r, jb, h, g; };
__device__ __forceinline__ UnitP decode(int u) { UnitP p; p.g = u >> 9; const int rem = u & 511; p.h = rem & 7; const int rj = rem >> 3; p.dsh = 2 * p.g; p.r = rj >> (6 - p.dsh); p.jb = rj & ((64 >> p.dsh) - 1); return p; }
template <class Bg> __device__ __forceinline__ void run(LAS unsigned char* lds, const bf16_t* Q, const bf16_t* K, const bf16_t* V, bf16_t* OG, float* LSEB, int u0, int stride, const Bg& B) {
    const int tid = pg8::opaque_tid(), lane = tid & 63, r32 = lane & 31, hi = lane >> 5;
    const int w = __builtin_amdgcn_readfirstlane(tid >> 6);
    if (u0 >= 1536) return;
    const float NEG = -INFINITY;
    bf16x8 qr[4];
#define ATT_ISSUE(P) do { const int kb_ = (P).jb * 256 - 128; \
        _Pragma("unroll") for (int t = 0; t < 6; ++t) { int idx = kb_ + 64 * t + lane; idx = idx < 0 ? 0 : idx; const size_t tok = ((size_t)idx << (P).dsh) + (P).r; \
            __builtin_amdgcn_global_load_lds((const unsigned*)(K + tok * 512 + (P).h * 64 + w * 8), (LAS unsigned*)(lds + K_OFF + w * KCH + t * 1024), 16, 0, 0); } \
        _Pragma("unroll") for (int t = 0; t < 6; ++t) { const int p_ = w * 6 + t, dh = p_ / 24, rg_ = p_ % 24; int idx = kb_ + 16 * rg_ + (lane >> 2); idx = idx < 0 ? 0 : idx; const size_t tok = ((size_t)idx << (P).dsh) + (P).r; \
            __builtin_amdgcn_global_load_lds((const unsigned*)(V + tok * 512 + (P).h * 64 + dh * 32 + (lane & 3) * 8), (LAS unsigned*)(lds + V_OFF + dh * VHALF + rg_ * 1024), 16, 0, 0); } \
        { const size_t qtok_ = ((size_t)((P).jb * 256 + 32 * w + r32) << (P).dsh) + (P).r; \
          _Pragma("unroll") for (int d0 = 0; d0 < 4; ++d0) qr[d0] = *(const bf16x8*)(Q + qtok_ * 512 + (P).h * 64 + d0 * 16 + hi * 8); } } while (0)
#define ATT_LOADK(dst, s) do { const LAS unsigned char* kp_ = lds + K_OFF + hi * KCH + (32 * (w + (s)) + r32) * 16; \
        _Pragma("unroll") for (int d0 = 0; d0 < 4; ++d0) dst[d0] = *(const LAS bf16x8*)(kp_ + d0 * 2 * KCH); } while (0)
#define ATT_QK(acc, kf, s) do { acc = (f32x16){0.f, 0.f, 0.f, 0.f, 0.f, 0.f, 0.f, 0.f, 0.f, 0.f, 0.f, 0.f, 0.f, 0.f, 0.f, 0.f}; \
        _Pragma("unroll") for (int d0 = 0; d0 < 4; ++d0) acc = __builtin_amdgcn_mfma_f32_32x32x16_bf16(kf[d0], qr[d0], acc, 0, 0, 0); \
          \
          \
        if ((s) == 0) { int q_ = r32 - 4 * hi; asm volatile("" : "+v"(q_)); _Pragma("unroll") for (int rr = 0; rr < 16; ++rr) if (((rr & 3) + 8 * (rr >> 2)) < q_) acc[rr] = NEG; } \
        if ((s) == 4) { int q_ = r32 - 4 * hi; asm volatile("" : "+v"(q_)); _Pragma("unroll") for (int rr = 0; rr < 16; ++rr) if (((rr & 3) + 8 * (rr >> 2)) > q_) acc[rr] = NEG; } } while (0)
    UnitP cur = decode(u0);
    ATT_ISSUE(cur);
    typename Bg::Regs bgr; B.prime(bgr);
    const LAS unsigned char* vb = lds + V_OFF + ((lane >> 4) & 1) * 32 + (lane & 3) * 8 + (4 * hi + ((lane & 15) >> 2)) * 64;
#define ATT_EPI() do { \
            bf16_t* O = OG + (size_t)done.g * (OG_STRIDE / 2); float* LSE = LSEB + (size_t)done.g * MP * 8; \
            const int i0 = done.jb * 256; \
            LAS float* wsf = (LAS float*)(lds + WS_OFF) + w * 64; \
            if (hi == 0) wsf[r32] = ls; \
            LDS_WAIT(); \
            LAS bf16_t* stg = (LAS bf16_t*)(lds + OST_OFF) + w * 2048; \
            f32x4 lsv_[4]; \
            _Pragma("unroll") \
            for (int k_ = 0; k_ < 4; ++k_) lsv_[k_] = *(const LAS f32x4*)(wsf + 8 * k_ + 4 * hi); \
            _Pragma("unroll") \
            for (int rr = 0; rr < 16; ++rr) { \
                const int orow = crow(rr, hi); const float rl = frcp(lsv_[rr >> 2][rr & 3]); \
                const unsigned pk = cvtpk(o[0][rr] * rl, o[1][rr] * rl); \
                stg[orow * 64 + r32] = (bf16_t)(pk & 0xffffu); stg[orow * 64 + 32 + r32] = (bf16_t)(pk >> 16); \
            } \
            LDS_WAIT(); \
            _Pragma("unroll") \
            for (int i = 0; i < 4; ++i) { \
                const int row = i * 8 + (lane >> 3), ch = lane & 7; \
                const u32x4 v = *(const LAS u32x4*)(stg + row * 64 + ch * 8); \
                const size_t tok = ((size_t)(i0 + 32 * w + row) << done.dsh) + done.r; \
                *(u32x4*)(O + tok * 512 + done.h * 64 + ch * 8) = v; \
            } \
            const size_t qtok = ((size_t)(i0 + 32 * w + r32) << done.dsh) + done.r; \
            if (hi == 0) LSE[qtok * 8 + done.h] = mx + __builtin_amdgcn_logf(ls); \
            LDS_WAIT(); \
        } while (0)
    float mx = 0.f, ls = 0.f; f32x16 o[2]; UnitP done = cur; bool pend = false;
    for (int u = u0;;) {
        VM_WAIT();
        __syncthreads();
        if (pend) { ATT_EPI(); pend = false; }
        B.rotate(bgr);
        const int s_lo = (cur.jb == 0 && w < 4) ? 4 - w : 0;
        mx = 0.f; ls = 0.f;
        o[0] = (f32x16){0.f, 0.f, 0.f, 0.f, 0.f, 0.f, 0.f, 0.f, 0.f, 0.f, 0.f, 0.f, 0.f, 0.f, 0.f, 0.f}; o[1] = o[0];
        {
            LAS float* wsr = (LAS float*)(lds + WS_OFF) + w * 64;
            bf16x8 kf[4]; ATT_LOADK(kf, 4);
            for (int s = 4; s >= s_lo; --s) {
                const LAS unsigned char* vrow = vb + (32 * (w + s)) * 64;
                s16x4 vl[2][2], vh[2][2];
#pragma unroll
                for (int ks = 0; ks < 2; ++ks)
#pragma unroll
                    for (int d0 = 0; d0 < 2; ++d0) { vl[ks][d0] = vtr(vrow + ks * 1024 + d0 * VHALF); vh[ks][d0] = vtr(vrow + ks * 1024 + d0 * VHALF + 512); }
                bf16x8 kn[4];
                if (s > s_lo) ATT_LOADK(kn, s - 1);
                f32x16 p; ATT_QK(p, kf, s);
                if (s == 4) {
                    float ml = p[0];
#pragma unroll
                    for (int rr = 1; rr < 16; ++rr) ml = fmaxf(ml, p[rr]);
                    mx = fmaxf(ml, __shfl_xor(ml, 32));
                }
                float se = 0.f;
#pragma unroll
                for (int rr = 0; rr < 16; ++rr) { const float e = fexp2(p[rr] - mx); p[rr] = e; se += e; }
                if (__builtin_amdgcn_ballot_w64(!(se <= 1.8446744e19f)) != 0ull) {
                    ATT_QK(p, kf, s);
                    float ml = p[0];
#pragma unroll
                    for (int rr = 1; rr < 16; ++rr) ml = fmaxf(ml, p[rr]);
                    const float mn = fmaxf(mx, fmaxf(ml, __shfl_xor(ml, 32)));
                    const float al = fexp2(mx - mn);
                    if (hi == 0) wsr[r32] = al;
                    LDS_WAIT();
#pragma unroll
                    for (int rr = 0; rr < 16; ++rr) { const float a_ = wsr[crow(rr, hi)]; o[0][rr] *= a_; o[1][rr] *= a_; }
                    LDS_WAIT();
                    ls *= al; mx = mn;
                    se = 0.f;
#pragma unroll
                    for (int rr = 0; rr < 16; ++rr) { const float e = fexp2(p[rr] - mx); p[rr] = e; se += e; }
                }
                ls += se;
#pragma unroll
                for (int ks = 0; ks < 2; ++ks) {
                    u32x4 pw; pw.x = cvtpk(p[8 * ks + 0], p[8 * ks + 1]); pw.y = cvtpk(p[8 * ks + 2], p[8 * ks + 3]); pw.z = cvtpk(p[8 * ks + 4], p[8 * ks + 5]); pw.w = cvtpk(p[8 * ks + 6], p[8 * ks + 7]);
                    const bf16x8 pa = __builtin_bit_cast(bf16x8, pw);
#pragma unroll
                    for (int d0 = 0; d0 < 2; ++d0) {
                        const bf16x8 vf = {vl[ks][d0][0], vl[ks][d0][1], vl[ks][d0][2], vl[ks][d0][3], vh[ks][d0][0], vh[ks][d0][1], vh[ks][d0][2], vh[ks][d0][3]};
                        o[d0] = __builtin_amdgcn_mfma_f32_32x32x16_bf16(pa, vf, o[d0], 0, 0, 0);
                    }
                }
                if (s > s_lo) {
#pragma unroll
                    for (int d0 = 0; d0 < 4; ++d0) kf[d0] = kn[d0];
                }
            }
        }
        ls += __shfl_xor(ls, 32);
        LDS_WAIT();
        __syncthreads();
        done = cur;
        const int un = u + stride; const bool has_next = un < 1536;
        if (has_next) { cur = decode(un); ATT_ISSUE(cur); }
        if (w < 4) { ATT_EPI(); }
        if (w >= 4) pend = true;
        if (!has_next) break;
        u = un;
    }
    if (pend) { ATT_EPI(); }
#undef ATT_EPI
    B.end(bgr);
    __syncthreads();
#undef ATT_ISSUE
#undef ATT_LOADK
#undef ATT_QK
}
}

namespace rg {
constexpr int XC_STRIDE = 1040;
constexpr int XC_BYTES = 64 * XC_STRIDE;
constexpr int NCHUNK = MP / 64;
__device__ __forceinline__ int crow(int r, int hi) { return (r & 3) + 8 * (r >> 2) + 4 * hi; }
__device__ __forceinline__ float expm1_(float x) {
    const float p = x * (1.0f + x * (0.5f + x * (0.16666667f + x * (0.041666668f + x * (0.008333334f + x * 0.0013888889f)))));
    return (x > -0.25f) ? p : (expf(x) - 1.0f);
}
__device__ __forceinline__ void task(LAS unsigned char* lds, const Args& a, int l, int tk) {
    const int tid = pg8::opaque_tid(), lane = tid & 63, r32 = lane & 31, hi = lane >> 5;
    const int w = __builtin_amdgcn_readfirstlane(tid >> 6);
    unsigned char* ws = a.ws;
    const bf16_t* XR = (const bf16_t*)(ws + WS_XR);
    bf16_t* HL = (bf16_t*)(ws + WS_HL); bf16_t* CA = (bf16_t*)(ws + WS_CA);
    const bf16_t* WT = (const bf16_t*)(ws + WS_WGT) + (size_t)l * (2 * 8 * 64 * 64);
    const float* cw = a.in[8] + l * 4 * DR; const float* cbias = a.in[9] + l * DR;
    const float* bga = a.in[11] + l * DR; const float* bgx = a.in[13] + l * DR; const float* sp = (const float*)(ws + WS_SP) + l * DR;
    float* AGGA = (float*)(ws + WS_AGGA) + (size_t)l * NCHUNK * DR; float* AGGH = (float*)(ws + WS_AGGH) + (size_t)l * NCHUNK * DR; float* CARRY = (float*)(ws + WS_CARRY) + (size_t)l * NCHUNK * DR;
    const int tg = tid >> 6, cg = tid & 63;
    const int t0 = tk * 64;
    bf16x8 wba[2][4], wbx[2][4]; float cbga[2], cbgx[2], csp2[2];
#pragma unroll
    for (int nt = 0; nt < 2; ++nt) {
#pragma unroll
        for (int ks = 0; ks < 4; ++ks) {
            wba[nt][ks] = *(const bf16x8*)(WT + ((size_t)(0 * 8 + w) * 64 + 32 * nt + r32) * 64 + 16 * ks + 8 * hi);
            wbx[nt][ks] = *(const bf16x8*)(WT + ((size_t)(1 * 8 + w) * 64 + 32 * nt + r32) * 64 + 16 * ks + 8 * hi);
        }
        const int c = 64 * w + 32 * nt + r32;
        cbga[nt] = bga[c] * -1.4426950408889634f; cbgx[nt] = bgx[c] * -1.4426950408889634f; csp2[nt] = sp[c] * (-8.0f * 1.4426950408889634f);
    }
    {
        float cwj[4][8], cbv[8];
#pragma unroll
        for (int j = 0; j < 4; ++j) { const f32x4 x0 = *(const f32x4*)(cw + j * DR + cg * 8), x1 = *(const f32x4*)(cw + j * DR + cg * 8 + 4);
#pragma unroll
            for (int e = 0; e < 4; ++e) { cwj[j][e] = x0[e]; cwj[j][4 + e] = x1[e]; } }
        { const f32x4 x0 = *(const f32x4*)(cbias + cg * 8), x1 = *(const f32x4*)(cbias + cg * 8 + 4);
#pragma unroll
            for (int e = 0; e < 4; ++e) { cbv[e] = x0[e]; cbv[4 + e] = x1[e]; } }
        u32x4 raw[11];
#pragma unroll
        for (int j = 0; j < 11; ++j) { const int t = t0 + 8 * tg - 3 + j; raw[j] = (t >= 0) ? *(const u32x4*)(XR + (size_t)t * 512 + cg * 8) : (u32x4){0u, 0u, 0u, 0u}; }
#pragma unroll
        for (int tt = 0; tt < 8; ++tt) {
            float xc[8];
#pragma unroll
            for (int e = 0; e < 8; ++e) xc[e] = cbv[e];
#pragma unroll
            for (int j = 0; j < 4; ++j) {
                const u32x4 rw = raw[tt + j];
#pragma unroll
                for (int e2 = 0; e2 < 4; ++e2) { const unsigned wv = rw[e2]; xc[2 * e2] += cwj[j][2 * e2] * __builtin_bit_cast(float, wv << 16); xc[2 * e2 + 1] += cwj[j][2 * e2 + 1] * __builtin_bit_cast(float, wv & 0xffff0000u); }
            }
            u32x4 o; o.x = cvtpk(xc[0], xc[1]); o.y = cvtpk(xc[2], xc[3]); o.z = cvtpk(xc[4], xc[5]); o.w = cvtpk(xc[6], xc[7]);
            *(LAS u32x4*)(lds + (8 * tg + tt) * XC_STRIDE + cg * 16) = o;
        }
    }
    LDS_WAIT();
    __syncthreads();
#pragma unroll
    for (int nt = 0; nt < 2; ++nt) {
        const int c = 64 * w + 32 * nt + r32;
        f32x16 ar[2], ab[2];
#pragma unroll
        for (int mt = 0; mt < 2; ++mt) { ar[mt] = (f32x16){0.f, 0.f, 0.f, 0.f, 0.f, 0.f, 0.f, 0.f, 0.f, 0.f, 0.f, 0.f, 0.f, 0.f, 0.f, 0.f}; ab[mt] = ar[mt]; }
#pragma unroll
        for (int ks = 0; ks < 4; ++ks) {
            const bf16x8 ba = wba[nt][ks], bx = wbx[nt][ks];
#pragma unroll
            for (int mt = 0; mt < 2; ++mt) {
                const bf16x8 af = *(const LAS bf16x8*)(lds + (32 * mt + r32) * XC_STRIDE + (64 * w + 16 * ks + 8 * hi) * 2);
                ar[mt] = __builtin_amdgcn_mfma_f32_32x32x16_bf16(af, ba, ar[mt], 0, 0, 0);
                ab[mt] = __builtin_amdgcn_mfma_f32_32x32x16_bf16(af, bx, ab[mt], 0, 0, 0);
            }
        }
        const float vbga = cbga[nt], vbgx = cbgx[nt], vsp2 = csp2[nt];
        LAS bf16_t* stg = (LAS bf16_t*)(lds + XC_BYTES) + w * 4096;
        LAS bf16_t* stgw = stg + 4 * hi * 32 + r32;
#pragma unroll
        for (int mt = 0; mt < 2; ++mt)
#pragma unroll
            for (int rr = 0; rr < 16; ++rr) {
                const int tkn = 32 * mt + crow(rr, hi);
                const float xcv = bf2f(*(const LAS bf16_t*)(lds + tkn * XC_STRIDE + c * 2));
                const float rg_ = frcp(1.0f + fexp2(ar[mt][rr] * -1.4426950408889634f + vbga)), ig_ = frcp(1.0f + fexp2(ab[mt][rr] * -1.4426950408889634f + vbgx));
                const float av = fexp2(rg_ * vsp2);
                const float bv = sqrtf(fmaxf(1.0f - av * av, 0.f)) * (ig_ * xcv);
                ar[mt][rr] = av; ab[mt][rr] = bv;
            }
        float GA[8], GH[8];
#pragma unroll
        for (int mt = 0; mt < 2; ++mt)
#pragma unroll
            for (int k = 0; k < 4; ++k) {
                float A = 1.f, H = 0.f;
#pragma unroll
                for (int e = 0; e < 4; ++e) { const float av = ar[mt][4 * k + e], bv = ab[mt][4 * k + e]; H = av * H + bv; A = A * av; ar[mt][4 * k + e] = A; ab[mt][4 * k + e] = H; }
                GA[mt * 4 + k] = A; GH[mt * 4 + k] = H;
            }
        float OA[8], OH[8];
#pragma unroll
        for (int q = 0; q < 8; ++q) { OA[q] = __shfl_xor(GA[q], 32); OH[q] = __shfl_xor(GH[q], 32); }
        float curH = 0.f, curA = 1.f;
#pragma unroll
        for (int mt = 0; mt < 2; ++mt)
#pragma unroll
            for (int k = 0; k < 4; ++k) {
                const int q = mt * 4 + k;
                const float ga0 = hi ? OA[q] : GA[q], gh0 = hi ? OH[q] : GH[q];
                const float ga1 = hi ? GA[q] : OA[q], gh1 = hi ? GH[q] : OH[q];
                const float midH = gh0 + ga0 * curH, midA = curA * ga0;
                const float cinH = hi ? midH : curH, cinA = hi ? midA : curA;
#pragma unroll
                for (int e = 0; e < 4; ++e) {
                    const float Al = ar[mt][4 * k + e], Hl = ab[mt][4 * k + e];
                    const float hv = Hl + Al * cinH, cav = Al * cinA;
                    stgw[(32 * mt + 8 * k + e) * 32] = (bf16_t)f2bf(hv); stgw[2048 + (32 * mt + 8 * k + e) * 32] = (bf16_t)f2bf(cav);
                }
                curH = gh1 + ga1 * midH; curA = midA * ga1;
            }
        if (hi == 0) {
            __hip_atomic_store(AGGA + (size_t)tk * DR + c, curA, __ATOMIC_RELAXED, __HIP_MEMORY_SCOPE_AGENT); __hip_atomic_store(AGGH + (size_t)tk * DR + c, curH, __ATOMIC_RELAXED, __HIP_MEMORY_SCOPE_AGENT); }
        LDS_WAIT();
#pragma unroll
        for (int i = 0; i < 4; ++i) {
            const int row = i * 16 + (lane >> 2), seg = lane & 3;
            const u32x4 vh = *(const LAS u32x4*)(stg + row * 32 + seg * 8), vc = *(const LAS u32x4*)(stg + 2048 + row * 32 + seg * 8);
            const size_t off = (size_t)(t0 + row) * 512 + 64 * w + 32 * nt + seg * 8;
            *(u32x4*)(HL + off) = vh; *(u32x4*)(CA + off) = vc;
        }
        LDS_WAIT();
    }
    float* PREA = (float*)(ws + WS_PREA) + (size_t)l * NCHUNK * DR; float* PREH = CARRY;
    float* GA_ = (float*)(ws + WS_GAGG) + (size_t)l * 3 * 16 * DR; float* GH_ = GA_ + 16 * DR; float* GC_ = GA_ + 32 * DR;
    unsigned* ctr = (unsigned*)(ws + WS_CTL) + CW_RG;
    const int grp = tk >> 4;
    VM_WAIT();
    __syncthreads();
    volatile LAS unsigned* flag = (volatile LAS unsigned*)(lds + MISC_OFF + 64);
    if (tid == 0) {
        const unsigned old = __hip_atomic_fetch_add(ctr + 128 + 64 * (16 * l + grp), 1u, __ATOMIC_RELAXED, __HIP_MEMORY_SCOPE_AGENT);
        const unsigned last = (old == 15u) ? 1u : 0u;
        if (last) { __builtin_amdgcn_fence(__ATOMIC_ACQUIRE, "agent"); asm volatile("s_waitcnt vmcnt(0)" ::: "memory"); }
        flag[0] = last;
    }
    LDS_WAIT();
    __syncthreads();
    if (flag[0]) {
        float va[16], vh[16];
#pragma unroll
        for (int j = 0; j < 16; ++j) { va[j] = AGGA[(size_t)(16 * grp + j) * DR + tid]; vh[j] = AGGH[(size_t)(16 * grp + j) * DR + tid]; }
        float A = 1.f, H = 0.f;
#pragma unroll
        for (int j = 0; j < 16; ++j) { PREA[(size_t)(16 * grp + j) * DR + tid] = A; PREH[(size_t)(16 * grp + j) * DR + tid] = H; H = vh[j] + va[j] * H; A = A * va[j]; }
        __hip_atomic_store(GA_ + grp * DR + tid, A, __ATOMIC_RELAXED, __HIP_MEMORY_SCOPE_AGENT); __hip_atomic_store(GH_ + grp * DR + tid, H, __ATOMIC_RELAXED, __HIP_MEMORY_SCOPE_AGENT);
        VM_WAIT();
        __syncthreads();
        if (tid == 0) {
            const unsigned old = __hip_atomic_fetch_add(ctr + 64 * l, 1u, __ATOMIC_RELAXED, __HIP_MEMORY_SCOPE_AGENT);
            const unsigned last = (old == 15u) ? 1u : 0u;
            if (last) { __builtin_amdgcn_fence(__ATOMIC_ACQUIRE, "agent"); asm volatile("s_waitcnt vmcnt(0)" ::: "memory"); }
            flag[1] = last;
        }
        LDS_WAIT();
        __syncthreads();
        if (flag[1]) {
            float ga[16], gh[16];
#pragma unroll
            for (int j = 0; j < 16; ++j) { ga[j] = GA_[j * DR + tid]; gh[j] = GH_[j * DR + tid]; }
            float h = 0.f;
#pragma unroll
            for (int j = 0; j < 16; ++j) { GC_[j * DR + tid] = h; h = gh[j] + ga[j] * h; }
            a.out[O_PH + (size_t)l * DR + tid] = h;
        }
    }
    __syncthreads();
}
}

__device__ __forceinline__ void phase_fin(const Args& a, int l, int wg, int nwg) {
    unsigned char* ws = a.ws;
    const bf16_t* OG = (const bf16_t*)(ws + WS_OG); const float* LSE = (const float*)(ws + WS_LSE);
    const bf16_t* HL = (const bf16_t*)(ws + WS_HL); const bf16_t* CA = (const bf16_t*)(ws + WS_CA); const bf16_t* GY = (const bf16_t*)(ws + WS_GY);
    const float* CARRY = (const float*)(ws + WS_CARRY) + (size_t)l * rg::NCHUNK * DR;
    const float* PREA = (const float*)(ws + WS_PREA) + (size_t)l * rg::NCHUNK * DR; const float* GC = (const float*)(ws + WS_GAGG) + (size_t)l * 3 * 16 * DR + 32 * DR;
    bf16_t* MIX = (bf16_t*)(ws + WS_MIX);
    const size_t gt = (size_t)wg * 512 + pg8::opaque_tid(), NGT = (size_t)nwg * 512;
    constexpr int FU = 4;
    const int grp = (int)(gt & 127);
    const size_t NIT = (size_t)MP * 128;
    if (grp < 64) {
        const int h = grp >> 3;
        for (size_t it0 = gt; it0 < NIT; it0 += FU * NGT) {
            float lse[FU][3]; u32x4 og[FU][3];
#pragma unroll
            for (int u = 0; u < FU; ++u) {
                const size_t it = it0 + u * NGT; const size_t tok = (it < NIT ? it : gt) >> 7;
                const size_t off = tok * 512 + grp * 8;
#pragma unroll
                for (int g = 0; g < 3; ++g) { lse[u][g] = LSE[(size_t)g * MP * 8 + tok * 8 + h]; og[u][g] = *(const u32x4*)(OG + g * (OG_STRIDE / 2) + off); }
            }
#pragma unroll
            for (int u = 0; u < FU; ++u) {
                const size_t it = it0 + u * NGT; const size_t tok = it >> 7;
                const float m = fmaxf(lse[u][0], fmaxf(lse[u][1], lse[u][2]));
                float w0 = fexp2(lse[u][0] - m), w1 = fexp2(lse[u][1] - m), w2 = fexp2(lse[u][2] - m);
                const float inv = frcp(w0 + w1 + w2); w0 *= inv; w1 *= inv; w2 *= inv;
                u32x4 r;
#pragma unroll
                for (int e = 0; e < 4; ++e) {
                    const float lo = w0 * __builtin_bit_cast(float, og[u][0][e] << 16) + w1 * __builtin_bit_cast(float, og[u][1][e] << 16) + w2 * __builtin_bit_cast(float, og[u][2][e] << 16);
                    const float hh = w0 * __builtin_bit_cast(float, og[u][0][e] & 0xffff0000u) + w1 * __builtin_bit_cast(float, og[u][1][e] & 0xffff0000u) + w2 * __builtin_bit_cast(float, og[u][2][e] & 0xffff0000u);
                    r[e] = cvtpk(lo, hh);
                }
                if (it < NIT) *(u32x4*)(MIX + tok * DM + grp * 8) = r;
            }
        }
    } else {
        const int cg = grp - 64;
        for (size_t it0 = gt; it0 < NIT; it0 += FU * NGT) {
            u32x4 hl[FU], ca[FU], gy[FU]; f32x4 c0[FU], c1[FU];
#pragma unroll
            for (int u = 0; u < FU; ++u) {
                const size_t it = it0 + u * NGT; const size_t tok = (it < NIT ? it : gt) >> 7;
                const size_t off = tok * 512 + cg * 8;
                hl[u] = *(const u32x4*)(HL + off); ca[u] = *(const u32x4*)(CA + off); gy[u] = *(const u32x4*)(GY + off);
                const float* ph_ = CARRY + (tok >> 6) * DR + cg * 8; const float* pa_ = PREA + (tok >> 6) * DR + cg * 8; const float* gc_ = GC + (tok >> 10) * DR + cg * 8;
                c0[u] = *(const f32x4*)ph_ + *(const f32x4*)pa_ * *(const f32x4*)gc_; c1[u] = *(const f32x4*)(ph_ + 4) + *(const f32x4*)(pa_ + 4) * *(const f32x4*)(gc_ + 4);
            }
#pragma unroll
            for (int u = 0; u < FU; ++u) {
                const size_t it = it0 + u * NGT; const size_t tok = it >> 7;
                u32x4 r;
#pragma unroll
                for (int e = 0; e < 4; ++e) {
                    const float clo = (e < 2) ? c0[u][2 * e] : c1[u][2 * e - 4], chi = (e < 2) ? c0[u][2 * e + 1] : c1[u][2 * e - 3];
                    const float lo = (__builtin_bit_cast(float, hl[u][e] << 16) + __builtin_bit_cast(float, ca[u][e] << 16) * clo) * __builtin_bit_cast(float, gy[u][e] << 16);
                    const float hh = (__builtin_bit_cast(float, hl[u][e] & 0xffff0000u) + __builtin_bit_cast(float, ca[u][e] & 0xffff0000u) * chi) * __builtin_bit_cast(float, gy[u][e] & 0xffff0000u);
                    r[e] = cvtpk(lo, hh);
                }
                if (it < NIT) *(u32x4*)(MIX + tok * DM + 512 + cg * 8) = r;
            }
        }
    }
}

__device__ __forceinline__ void dbg_zero_sample_mix(const Args& a, int lo_col, int hi_col) {
    bf16_t* MIX = (bf16_t*)(a.ws + WS_MIX);
    for (size_t i = (size_t)blockIdx.x * 512 + threadIdx.x; i < (size_t)MS * DM; i += (size_t)gridDim.x * 512) { const int c = (int)(i & 1023); if (c >= lo_col && c < hi_col) MIX[(size_t)MP * DM + i] = 0; }
}
namespace sat {
constexpr int NE = 388, NG = 97;
__device__ __forceinline__ const float* row_ptr(const float* cache, const float* fresh, int t, int e) {
    const int ee = e < 387 ? e : 0, g = ee / 129, m = ee - g * 129;
    const int j = WBUF + t - (m << (2 * g));
    return (j >= WBUF) ? (fresh + (size_t)(j - WBUF) * 512) : (cache + (size_t)j * 512);
}
__device__ __forceinline__ void task(LAS unsigned char* lds, const Args& a, int l, int b, int h) {
    const int tid = pg8::opaque_tid(), lane = tid & 63, slot = lane >> 4, d4 = lane & 15;
    const int w = __builtin_amdgcn_readfirstlane(tid >> 6), t = w >> 1, half = w & 1;
    unsigned char* ws = a.ws;
    LAS float* sc = (LAS float*)lds + 256;
    LAS float* sums = sc + 4 * NE;
    LAS float* part = sums + 16;
#ifndef SAT_BD
#define SAT_BD 17
#endif
    constexpr int BD = SAT_BD, NBT = (49 + BD - 1) / BD;
    const size_t cbase = ((size_t)(l * NB + b) * WBUF) * 512 + h * 64;
    const float* ck = a.in[2] + cbase; const float* cv = a.in[3] + cbase;
    const float* nk = a.out + O_SK + cbase + (size_t)(WBUF - NT) * 512; const float* nv = a.out + O_SV + cbase + (size_t)(WBUF - NT) * 512;
    f32x4 qv = *(const f32x4*)((const float*)(ws + WS_QS) + (size_t)(b * 4 + t) * 512 + h * 64 + 4 * d4);
    qv = qv * 0.125f;
#pragma unroll 1
    for (int k = 0; k < NBT; ++k) {
        const int g0 = half + 2 * BD * k;
        f32x4 kv[BD];
#pragma unroll
        for (int i = 0; i < BD; ++i) { const int grp = g0 + 2 * i; const int e = 4 * (grp < NG ? grp : 0) + slot; kv[i] = *(const f32x4*)(row_ptr(ck, nk, t, e) + 4 * d4); }
#pragma unroll
        for (int i = 0; i < BD; ++i) {
            const int grp = g0 + 2 * i;
            float s = (kv[i][0] * qv[0] + kv[i][1] * qv[1]) + (kv[i][2] * qv[2] + kv[i][3] * qv[3]);
            s += __shfl_xor(s, 1); s += __shfl_xor(s, 2); s += __shfl_xor(s, 4); s += __shfl_xor(s, 8);
            const int e = 4 * grp + slot;
            if (grp < NG && d4 == 0) sc[t * NE + e] = (e < 387) ? s : -INFINITY;
        }
    }
    f32x4 vv[BD];
#pragma unroll
    for (int i = 0; i < BD; ++i) { const int e = 4 * (half + 2 * i) + slot; vv[i] = *(const f32x4*)(row_ptr(cv, nv, t, e) + 4 * d4); }
    LDS_WAIT();
    __builtin_amdgcn_s_barrier();
    asm volatile("" ::: "memory");
    if (w < 4) {
        float mx = -INFINITY;
        for (int e = lane; e < NE; e += 64) mx = fmaxf(mx, sc[w * NE + e]);
        mx = wave_max(mx);
        float sum = 0.f;
        for (int e = lane; e < NE; e += 64) { const float pe = expf(sc[w * NE + e] - mx); sc[w * NE + e] = pe; sum += pe; }
        sum = wave_sum(sum);
        if (lane == 0) sums[w] = sum;
    }
    LDS_WAIT();
    __builtin_amdgcn_s_barrier();
    asm volatile("" ::: "memory");
    f32x4 acc = {0.f, 0.f, 0.f, 0.f};
#pragma unroll
    for (int i = 0; i < BD; ++i) { const int e = 4 * (half + 2 * i) + slot; acc += vv[i] * sc[t * NE + e]; }
#pragma unroll 1
    for (int k = 1; k < NBT; ++k) {
        const int g0 = half + 2 * BD * k;
#pragma unroll
        for (int i = 0; i < BD; ++i) { const int grp = g0 + 2 * i; const int e = 4 * (grp < NG ? grp : 0) + slot; vv[i] = *(const f32x4*)(row_ptr(cv, nv, t, e) + 4 * d4); }
#pragma unroll
        for (int i = 0; i < BD; ++i) { const int grp = g0 + 2 * i; const int e = 4 * (grp < NG ? grp : 0) + slot; const float pe = (grp < NG) ? sc[t * NE + e] : 0.f; acc += vv[i] * pe; }
    }
#pragma unroll
    for (int c = 0; c < 4; ++c) { acc[c] += __shfl_xor(acc[c], 16); acc[c] += __shfl_xor(acc[c], 32); }
    if (lane < 16) *(LAS f32x4*)(part + w * 64 + 4 * lane) = acc;
    LDS_WAIT();
    __syncthreads();
    if (tid < 256) {
        const int tt = tid >> 6, d = tid & 63;
        const float o = (part[(2 * tt) * 64 + d] + part[(2 * tt + 1) * 64 + d]) / sums[tt];
        ((bf16_t*)(ws + WS_MIX))[(size_t)(MP + b * 4 + tt) * DM + h * 64 + d] = (bf16_t)f2bf(o);
    }
    __syncthreads();
}
}

#ifndef SRG_UNROLL
#define SRG_UNROLL 64
#endif
__device__ __forceinline__ void srglru_task(LAS unsigned char* lds, const Args& a, int l, int b, int n) {
    const int tid = pg8::opaque_tid(), d = tid & 63;
    const int wv = __builtin_amdgcn_readfirstlane(tid >> 6);
    unsigned char* ws = a.ws;
    const int c = n * 64 + d;
    __syncthreads();
    const float* xrs = (const float*)(ws + WS_XRS) + (size_t)b * 4 * DR;
    const float* sconv = a.in[4] + (size_t)(l * NB + b) * 3 * DR;
    float xp[7];
#pragma unroll
    for (int j = 0; j < 3; ++j) xp[j] = sconv[j * DR + c];
#pragma unroll
    for (int j = 0; j < 4; ++j) xp[3 + j] = xrs[j * DR + c];
    const float* cw = a.in[8] + l * 4 * DR;
    const float w0 = cw[c], w1 = cw[DR + c], w2 = cw[2 * DR + c], w3 = cw[3 * DR + c], cb = a.in[9][l * DR + c];
    const float* wa = a.in[10] + (size_t)(l * 8 + n) * 4096 + (size_t)(8 * wv) * 64 + d; const float* wx = a.in[12] + (size_t)(l * 8 + n) * 4096 + (size_t)(8 * wv) * 64 + d;
    float va[8], vx[8];
#pragma unroll
    for (int j = 0; j < 8; ++j) { va[j] = wa[j * 64]; vx[j] = wx[j * 64]; }
    float vbga = 0.f, vbgx = 0.f, vsp = 0.f, h = 0.f, gy[4] = {0.f, 0.f, 0.f, 0.f};
    const bf16_t* GY = (const bf16_t*)(ws + WS_GY); bf16_t* MIX = (bf16_t*)(ws + WS_MIX);
    if (wv == 0) {
        vbga = a.in[11][l * DR + c]; vbgx = a.in[13][l * DR + c]; vsp = ((const float*)(ws + WS_SP))[l * DR + c];
        h = a.in[5][(size_t)(l * NB + b) * DR + c];
#pragma unroll
        for (int t = 0; t < 4; ++t) gy[t] = bf2f(GY[((size_t)MP + b * 4 + t) * 512 + c]);
    }
    float xc[4];
#pragma unroll
    for (int t = 0; t < 4; ++t) xc[t] = w0 * xp[t] + w1 * xp[t + 1] + w2 * xp[t + 2] + w3 * xp[t + 3] + cb;
    float pa[4] = {0.f, 0.f, 0.f, 0.f}, px[4] = {0.f, 0.f, 0.f, 0.f};
#pragma unroll
    for (int j = 0; j < 8; ++j) {
#pragma unroll
        for (int t = 0; t < 4; ++t) { const float xv = __builtin_bit_cast(float, __builtin_amdgcn_readlane(__builtin_bit_cast(int, xc[t]), 8 * wv + j)); pa[t] += xv * va[j]; px[t] += xv * vx[j]; }
    }
    LAS float* part = (LAS float*)lds;
#pragma unroll
    for (int t = 0; t < 4; ++t) { part[(wv * 8 + t) * 64 + d] = pa[t]; part[(wv * 8 + 4 + t) * 64 + d] = px[t]; }
    LDS_WAIT();
    __syncthreads();
    if (wv == 0) {
#pragma unroll
        for (int t = 0; t < 4; ++t) {
            float sa = 0.f, sx = 0.f;
#pragma unroll
            for (int q = 0; q < 8; ++q) { sa += part[(q * 8 + t) * 64 + d]; sx += part[(q * 8 + 4 + t) * 64 + d]; }
            pa[t] = sa; px[t] = sx;
        }
#pragma unroll
        for (int t = 0; t < 4; ++t) {
            const float rg_ = 1.0f / (1.0f + expf(-(pa[t] + vbga))), ig_ = 1.0f / (1.0f + expf(-(px[t] + vbgx)));
            const float la = -8.0f * rg_ * vsp;
            const float av = expf(la), bv = sqrtf(-rg::expm1_(2.0f * la)) * (ig_ * xc[t]);
            h = av * h + bv;
            const size_t row = (size_t)MP + b * 4 + t;
            MIX[row * DM + 512 + c] = (bf16_t)f2bf(h * gy[t]);
        }
        a.out[O_SH + (size_t)(l * NB + b) * DR + c] = h;
#pragma unroll
        for (int j = 0; j < 3; ++j) a.out[O_SC + ((size_t)(l * NB + b) * 3 + j) * DR + c] = xp[4 + j];
    }
    __syncthreads();
}

__device__ __forceinline__ void phase_final(const Args& a, int wg, int nwg) {
    unsigned char* ws = a.ws;
    const int tid = pg8::opaque_tid(), lane = tid & 63, wave = tid >> 6;
    const int gw = wg * 8 + wave, NGW = nwg * 8;
    const bf16_t* XB = (const bf16_t*)(ws + WS_XBA); const float* ssqp = (const float*)(ws + WS_SSQP + 4 * SSQP_STRIDE);
    const float* gf = a.in[20];
    f32x4 g0[2], g1[2];
#pragma unroll
    for (int j = 0; j < 2; ++j) { g0[j] = *((const f32x4*)gf + 2 * lane + 128 * j); g1[j] = *((const f32x4*)gf + 2 * lane + 128 * j + 1); }
    for (int m = gw; m < MP; m += NGW) {
        const float rs = row_rstd(ssqp, m);
        f32x4* o = (f32x4*)(a.out + O_YP + (size_t)m * DM);
#pragma unroll
        for (int j = 0; j < 2; ++j) {
            const u32x4 xw = *((const u32x4*)(XB + (size_t)m * DM) + lane + 64 * j);
            const f32x4 a0 = {__builtin_bit_cast(float, xw.x << 16), __builtin_bit_cast(float, xw.x & 0xffff0000u), __builtin_bit_cast(float, xw.y << 16), __builtin_bit_cast(float, xw.y & 0xffff0000u)};
            const f32x4 a1 = {__builtin_bit_cast(float, xw.z << 16), __builtin_bit_cast(float, xw.z & 0xffff0000u), __builtin_bit_cast(float, xw.w << 16), __builtin_bit_cast(float, xw.w & 0xffff0000u)};
            o[2 * lane + 128 * j] = a0 * rs * g0[j]; o[2 * lane + 128 * j + 1] = a1 * rs * g1[j];
        }
    }
}
__device__ __forceinline__ void skinny_down(const Args& a, int l) {
    unsigned char* ws = a.ws;
    const int tid = pg8::opaque_tid(), lane = tid & 63, i = lane & 15, kq = lane >> 4;
    const int w = __builtin_amdgcn_readfirstlane(tid >> 6);
    const bf16_t* Hs = (const bf16_t*)(ws + WS_H) + (size_t)MP * DFF;
    const bf16_t* Wt = (const bf16_t*)(ws + WS_W + (size_t)l * W_LAYER + W_FD);
    float* ACC = (float*)(ws + WS_ACC);
    for (int it = blockIdx.x; it < 256; it += gridDim.x) {
        const int ns = it & 31, ks = it >> 5;
        const bf16_t* ap = Hs + (size_t)(16 * w + i) * DFF + ks * 352 + 8 * kq;
        const bf16_t* bp = Wt + (size_t)(32 * ns + i) * DFF + ks * 352 + 8 * kq;
        bf16x8 af[11], b0[11], b1[11];
#pragma unroll
        for (int s = 0; s < 11; ++s) { af[s] = *(const bf16x8*)(ap + 32 * s); b0[s] = *(const bf16x8*)(bp + 32 * s); b1[s] = *(const bf16x8*)(bp + (size_t)16 * DFF + 32 * s); }
        f32x4 c0 = {0.f, 0.f, 0.f, 0.f}, c1 = c0;
#pragma unroll
        for (int s = 0; s < 11; ++s) { c0 = __builtin_amdgcn_mfma_f32_16x16x32_bf16(af[s], b0[s], c0, 0, 0, 0); c1 = __builtin_amdgcn_mfma_f32_16x16x32_bf16(af[s], b1[s], c1, 0, 0, 0); }
        float* o = ACC + (size_t)ks * MS * DM + (size_t)(16 * w + 4 * kq) * DM + 32 * ns + i;
#pragma unroll
        for (int r = 0; r < 4; ++r) { o[(size_t)r * DM] = c0[r]; o[(size_t)r * DM + 16] = c1[r]; }
    }
}
__device__ __forceinline__ void sample_final(const Args& a, const float oscale = 1.0f) {
    unsigned char* ws = a.ws;
    const int tid = pg8::opaque_tid(), lane = tid & 63, wave = tid >> 6;
    const bf16_t* XB = (const bf16_t*)(ws + WS_XBB) + (size_t)MP * DM; const float* ACC = (const float*)(ws + WS_ACC);
    const float* gf = a.in[20];
    for (int s = blockIdx.x * 8 + wave; s < MS; s += gridDim.x * 8) {
        f32x4 v[4]; float ss = 0.f;
#pragma unroll
        for (int j = 0; j < 2; ++j) {
            const u32x4 xw = *((const u32x4*)(XB + (size_t)s * DM) + lane + 64 * j);
            v[2 * j] = (f32x4){__builtin_bit_cast(float, xw.x << 16), __builtin_bit_cast(float, xw.x & 0xffff0000u), __builtin_bit_cast(float, xw.y << 16), __builtin_bit_cast(float, xw.y & 0xffff0000u)};
            v[2 * j + 1] = (f32x4){__builtin_bit_cast(float, xw.z << 16), __builtin_bit_cast(float, xw.z & 0xffff0000u), __builtin_bit_cast(float, xw.w << 16), __builtin_bit_cast(float, xw.w & 0xffff0000u)};
#pragma unroll
            for (int ks = 0; ks < 8; ++ks) { const f32x4* ap = (const f32x4*)(ACC + (size_t)ks * MS * DM + (size_t)s * DM) + 2 * lane + 128 * j; v[2 * j] += ap[0]; v[2 * j + 1] += ap[1]; }
            ss += (v[2 * j].x * v[2 * j].x + v[2 * j].y * v[2 * j].y) + (v[2 * j].z * v[2 * j].z + v[2 * j].w * v[2 * j].w) + (v[2 * j + 1].x * v[2 * j + 1].x + v[2 * j + 1].y * v[2 * j + 1].y) + (v[2 * j + 1].z * v[2 * j + 1].z + v[2 * j + 1].w * v[2 * j + 1].w);
        }
        ss = wave_sum(ss);
        const float rs = 1.0f / sqrtf(ss * (1.0f / DM) + RMS_EPS);
#pragma unroll
        for (int j = 0; j < 2; ++j) { f32x4* o = (f32x4*)(a.out + O_YS + (size_t)s * DM) + 2 * lane + 128 * j; const f32x4* gp = (const f32x4*)gf + 2 * lane + 128 * j; o[0] = v[2 * j] * (rs * oscale) * gp[0]; o[1] = v[2 * j + 1] * (rs * oscale) * gp[1]; }
    }
}

constexpr int N_PHASES = 16;
#ifndef BG_SD
#define BG_SD 2
#endif
#ifndef MK_ONE_LAUNCH
#define MK_ONE_LAUNCH 1
#endif

__global__ void __launch_bounds__(512, 2) mk_fwd(Args a_unused) {
    extern __shared__ __attribute__((aligned(16))) unsigned char lds_raw[];
    LAS unsigned char* lds = (LAS unsigned char*)lds_raw;
    { const int tid0 = threadIdx.x; for (int u = tid0; u < (LDS_BYTES - MISC_OFF) / 4; u += 512) ((LAS unsigned*)(lds + MISC_OFF))[u] = 0u; }
    __syncthreads();
#ifndef REPM
#define REPM 0
#endif
#define NREP(b) (((REPM >> (b)) & 1) ? 2 : 1)
#define IN(k) phase_on(k)
#define MAKE_BG(a) const cpy::Bg bg{a.in[2], a.in[3], a.out, lds}
#if MK_ONE_LAUNCH
    { XcdBarrier b0 = xcd_barrier_post((unsigned*)((unsigned char*)kargs()->ws + WS_CTL) + CW_BAR, (volatile LAS unsigned*)(lds + MISC_OFF + 32)); (void)b0; }
#ifdef DBG_TIME
#define DBG_STAMP(i) do { if (threadIdx.x == 0) ((volatile LAS unsigned*)(lds + MISC_OFF + 512))[i] = (unsigned)__builtin_amdgcn_s_memrealtime(); } while (0)
#define DBG_PROBE(idx, ph) do { __syncthreads(); if (threadIdx.x == 0) { const unsigned dt_ = (unsigned)__builtin_amdgcn_s_memrealtime() - ((volatile LAS unsigned*)(lds + MISC_OFF + 512))[ph]; \
        unsigned* c_ = (unsigned*)((unsigned char*)kargs()->ws + WS_CTL) + 65536 + 32 * (idx); atomicMax(c_, dt_); atomicMax(c_ + 16, 1000000u - dt_); } } while (0)
#else
#define DBG_STAMP(i) do { } while (0)
#define DBG_PROBE(idx, ph) do { } while (0)
#endif
#define SEAM(k) do { if (IN(k) && IN((k) + 1)) { XcdBarrier b_; b_.bar = (unsigned*)((unsigned char*)kargs()->ws + WS_CTL) + CW_BAR; b_.x = xb_xcc_id(); b_.st = (volatile LAS unsigned*)(lds + MISC_OFF + 32); xcd_barrier(b_); DBG_STAMP((k) + 1); } } while (0)
#else
#define SEAM(k) do { } while (0)
#endif
    const int bid = (int)blockIdx.x, G = (int)gridDim.x;
    DBG_STAMP(0);

#define S_G1(jj, R) do { pg8::Gemm g{(const bf16_t*)(ws + WS_XBA) + (size_t)MP * DM, (const bf16_t*)(wl + W_IN), 256, DIN, DM}; PanelOrder S{jj, R, DIN / 256}; \
        fill_rstd_table(lds, (const float*)(ws + WS_SSQP + (size_t)(l == 0 ? 0 : 2) * SSQP_STRIDE) + (size_t)MP * 16, S); EpiG1 E{lds, ws, a.out, l, MP, true}; \
        pg8::gemm_phase<EpiG1, PanelOrder, true, true>(lds, g, S, E); } while (0)
#define S_G2(jj, R) do { pg8::Gemm g{(const bf16_t*)(ws + WS_MIX) + (size_t)MP * DM, (const bf16_t*)(wl + W_OUT), 256, DM, DM}; PanelOrder S{jj, R, DM / 256}; \
        EpiRes E{nullptr, nullptr, (const bf16_t*)(ws + WS_XBA), (bf16_t*)(ws + WS_XBB), (float*)(ws + WS_SSQP + (size_t)(l == 0 ? 1 : 3) * SSQP_STRIDE), MP, true}; \
        pg8::gemm_phase<EpiRes, PanelOrder, true, true>(lds, g, S, E); } while (0)
#define S_G3(jj, R) do { pg8::Gemm g{(const bf16_t*)(ws + WS_XBB) + (size_t)MP * DM, (const bf16_t*)(wl + W_GU), 256, NGU, DM}; PanelOrder S{jj, R, NGU / 256}; \
        fill_rstd_table(lds, (const float*)(ws + WS_SSQP + (size_t)(l == 0 ? 1 : 3) * SSQP_STRIDE) + (size_t)MP * 16, S); EpiG3 E{lds, (bf16_t*)(ws + WS_H), MP, true}; \
        pg8::gemm_phase<EpiG3, PanelOrder, true, true>(lds, g, S, E); } while (0)
#define S_G4(jj, R, LL) do { unsigned char* wl4_ = ws + WS_W + (size_t)(LL) * W_LAYER; pg8::Gemm g{(const bf16_t*)(ws + WS_H) + (size_t)MP * DFF, (const bf16_t*)(wl4_ + W_FD), 256, DM, DFF}; PanelOrder S{jj, R, DM / 256}; \
        EpiRes E{nullptr, nullptr, (const bf16_t*)(ws + WS_XBB), (bf16_t*)(ws + WS_XBA), (float*)(ws + WS_SSQP + (size_t)((LL) == 0 ? 2 : 4) * SSQP_STRIDE), MP, true}; \
        pg8::gemm_phase<EpiRes, PanelOrder, true, true>(lds, g, S, E); } while (0)

    if (IN(0)) for (int rep_ = 0; rep_ < NREP(0); ++rep_) { LOAD_ARGS(a); MAKE_BG(a); phase_prologue(a, lds); SEAM(0); }
#ifdef DBG_EXTRA_BARRIERS
    for (int eb_ = 0; eb_ < DBG_EXTRA_BARRIERS; ++eb_) { SEAM(0); }
#endif

    for (int l = 0; l < NLAYER; ++l) {
        const int pb = 1 + 6 * l;
        if (IN(pb)) for (int rep_ = 0; rep_ < NREP(1); ++rep_) {
            LOAD_ARGS(a); MAKE_BG(a); unsigned char* ws = a.ws; unsigned char* wl = ws + WS_W + (size_t)l * W_LAYER;
            const int jr = (bid >= G - 8) ? bid - (G - 8) : -1;
            const int NBG = (int)cpy::BG_G1_WGS, GP = G - 8 - NBG;
            if (bid < GP) {
                pg8::Gemm g{(const bf16_t*)(ws + WS_XBA), (const bf16_t*)(wl + W_IN), MP, DIN, DM}; pg8::StaticOrder S; S.init(MP, DIN, GP, bid);
#ifdef G1_STAGGER
                if (bid & 1) { const unsigned long long t0_ = __builtin_amdgcn_s_memrealtime(); while (__builtin_amdgcn_s_memrealtime() - t0_ < G1_STAGGER) __builtin_amdgcn_s_sleep(8); }
#endif
                fill_rstd_table(lds, (const float*)(ws + WS_SSQP + (size_t)(l == 0 ? 0 : 2) * SSQP_STRIDE), S);
                EpiG1 E{lds, ws, a.out, l, 0, false};
                pg8::gemm_phase<EpiG1, pg8::StaticOrder, true, true>(lds, g, S, E);
            }
            if (bid >= GP && bid < G - 8) {
                const int tb = pg8::opaque_tid(), wv = __builtin_amdgcn_readfirstlane(tb >> 6), bw = (bid - GP) * 8 + wv;
                if (l == 0) weight_convert_items(a, (LAS float*)(lds + wv * 16384), WCV_FIRST, WCV_TOTAL, bw, NBG * 8, tb & 63);
                if (l == 0) bg.stream((unsigned)bw * cpy::Q_G1A, cpy::Q_G1A); else bg.stream(cpy::C2 + (unsigned)bw * cpy::Q_G1B, cpy::Q_G1B);
                if (l == 0) DBG_PROBE(9, 1);
            }
            if (l == 0 && bid < GP) DBG_PROBE(10, 1);
#ifdef DBG_SHADOW_G1
            SEAM(pb);
            if (bid < GP) {
                pg8::Gemm g{(const bf16_t*)(ws + WS_XBA), (const bf16_t*)(wl + W_IN), MP, DIN, DM}; pg8::StaticOrder S; S.init(MP, DIN, GP, bid);
#if DBG_SHADOW_G1 == 1
                EpiNull E{};
                pg8::gemm_phase<EpiNull, pg8::StaticOrder, true, true>(lds, g, S, E);
#else
                fill_rstd_table(lds, (const float*)(ws + WS_SSQP + (size_t)(l == 0 ? 0 : 2) * SSQP_STRIDE), S);
                EpiG1T<DBG_SHADOW_G1 - 2> E{lds, ws + 560 * MiB, (float*)(ws + 840 * MiB), l, 0, false};
                pg8::gemm_phase<EpiG1T<DBG_SHADOW_G1 - 2>, pg8::StaticOrder, true, true>(lds, g, S, E);
#endif
            }
#endif
            if (l == 0) { S_G1(jr, 8); }
            if (l == 1) { S_G4(jr, 8, 0); }
            SEAM(pb);
        }
        if (IN(pb + 1)) for (int rep_ = 0; rep_ < NREP(2); ++rep_) {
            LOAD_ARGS(a); MAKE_BG(a); unsigned char* ws = a.ws; unsigned char* wl = ws + WS_W + (size_t)l * W_LAYER;
            const int R = (l == 0) ? 0 : 10, Gp = G - R;
            for (int r2_ = 0; r2_ < NREP(8); ++r2_) for (int t = bid; t < rg::NCHUNK; t += G) rg::task(lds, a, l, t);
            __syncthreads();
            if (l == 1) DBG_PROBE(0, 8);
            if (l == 0) DBG_PROBE(2, 2);
            if (bid < Gp) {
                if (l == 0) for (int t = bid; t < NB * 8; t += Gp) srglru_task(lds, a, l, t >> 3, t & 7);
                __syncthreads();
                for (int r2_ = 0; r2_ < NREP(10); ++r2_)
                    att::run(lds, (const bf16_t*)(ws + WS_Q), (const bf16_t*)(ws + WS_K), (const bf16_t*)(ws + WS_V), (bf16_t*)(ws + WS_OG), (float*)(ws + WS_LSE), bid, Gp, bg);
                __syncthreads();
                if (l == 1) DBG_PROBE(1, 8);
                if (l == 0) DBG_PROBE(3, 2);
                if (l == 0) for (int r2_ = 0; r2_ < NREP(11); ++r2_) for (int t = bid; t < NB * NH; t += Gp) sat::task(lds, a, l, t >> 3, t & 7);
                if (l == 0) DBG_PROBE(4, 2);
            }
            if (l == 1) { S_G1(bid >= Gp ? bid - Gp : -1, 10); }
            if (l == 1 && G == 256) {
                const int wv_ = __builtin_amdgcn_readfirstlane(pg8::opaque_tid() >> 6);
                if (bid >= (int)cpy::SM_FIRST && bid < Gp) bg.stream(cpy::C7 + (unsigned)((bid - (int)cpy::SM_FIRST) * 8 + wv_) * cpy::Q_SM, cpy::Q_SM);
                if (bid >= Gp) bg.stream(cpy::C8 + (unsigned)((bid - Gp) * 8 + wv_) * cpy::Q_SR, cpy::Q_SR);
            }
            if (l == 1 && bid >= Gp) bg.drain();
            SEAM(pb + 1);
        }
        if (IN(pb + 2)) for (int rep_ = 0; rep_ < NREP(3); ++rep_) {
            LOAD_ARGS(a); MAKE_BG(a); unsigned char* ws = a.ws; unsigned char* wl = ws + WS_W + (size_t)l * W_LAYER;
            const int R = (l == 0) ? 4 : 0, Gp = G - R;
            if (bid < Gp) {
                if (l == 1) { for (int t = bid; t < NB * 8; t += Gp) srglru_task(lds, a, l, t >> 3, t & 7); __syncthreads(); for (int t = bid; t < NB * NH; t += Gp) sat::task(lds, a, l, t >> 3, t & 7); }
                if (l == 1) DBG_PROBE(5, 9);
                phase_fin(a, l, bid, Gp);
                if (l == 1) DBG_PROBE(6, 9);
                if (l == 0) DBG_PROBE(7, 3);
                if (l == 0 && G == 256) { const int wv_ = __builtin_amdgcn_readfirstlane(pg8::opaque_tid() >> 6); bg.stream(cpy::C6 + (unsigned)(bid * 8 + wv_) * cpy::Q_SF, cpy::Q_SF); }
            }
            if (l == 0) { S_G2(bid >= Gp ? bid - Gp : -1, 4); }
            SEAM(pb + 2);
        }
        if (IN(pb + 3)) for (int rep_ = 0; rep_ < NREP(4); ++rep_) {
            LOAD_ARGS(a); MAKE_BG(a); unsigned char* ws = a.ws; unsigned char* wl = ws + WS_W + (size_t)l * W_LAYER;
            pg8::Gemm g{(const bf16_t*)(ws + WS_MIX), (const bf16_t*)(wl + W_OUT), MP, DM, DM}; pg8::StaticOrder S; S.init(MP, DM, G, bid);
            EpiRes E{nullptr, nullptr, (const bf16_t*)(ws + WS_XBA), (bf16_t*)(ws + WS_XBB), (float*)(ws + WS_SSQP + (size_t)(l == 0 ? 1 : 3) * SSQP_STRIDE), 0, false};
            pg8::gemm_phase<EpiRes, pg8::StaticOrder, true, true>(lds, g, S, E);
            SEAM(pb + 3);
        }
        if (IN(pb + 4)) for (int rep_ = 0; rep_ < NREP(5); ++rep_) {
            LOAD_ARGS(a); MAKE_BG(a); unsigned char* ws = a.ws; unsigned char* wl = ws + WS_W + (size_t)l * W_LAYER;
            const int jr = (bid >= G - 8) ? bid - (G - 8) : -1;
            const int NBG = (int)cpy::BG_G3_WGS, GP = G - 8 - NBG;
            if (bid < GP) {
                pg8::Gemm g{(const bf16_t*)(ws + WS_XBB), (const bf16_t*)(wl + W_GU), MP, NGU, DM}; pg8::StaticOrder S; S.init(MP, NGU, GP, bid);
                fill_rstd_table(lds, (const float*)(ws + WS_SSQP + (size_t)(l == 0 ? 1 : 3) * SSQP_STRIDE), S);
                EpiG3 E{lds, (bf16_t*)(ws + WS_H), 0, false};
#if CPY_EPI
                const cpy::BgE bge{a.in[2], a.in[3], a.out, l};
                pg8::gemm_phase<EpiG3, pg8::StaticOrder, true, true, cpy::BgE>(lds, g, S, E, bge);
#else
                pg8::gemm_phase<EpiG3, pg8::StaticOrder, true, true>(lds, g, S, E);
#endif
            }
            if (bid >= GP && bid < G - 8) {
                const int tb = pg8::opaque_tid(), wv = __builtin_amdgcn_readfirstlane(tb >> 6), bw = (bid - GP) * 8 + wv;
                bg.stream((l == 0 ? cpy::C1 : cpy::C3) + (unsigned)bw * cpy::Q_G3, cpy::Q_G3);
            }
            if (G == 256 && cpy::S3_WGS && bid >= (int)cpy::S3_FIRST && bid < GP) {
                const int wv_ = __builtin_amdgcn_readfirstlane(pg8::opaque_tid() >> 6);
                bg.stream((l == 0 ? cpy::C4 : cpy::C5) + (unsigned)((bid - (int)cpy::S3_FIRST) * 8 + wv_) * cpy::Q_S3, cpy::Q_S3);
            }
            if (l == 0) { S_G3(jr, 8); }
            if (l == 1) { S_G2(jr, 8); }
#ifdef DBG_SHADOW_G3
            SEAM(pb + 4);
            if (bid < GP) {
                pg8::Gemm g{(const bf16_t*)(ws + WS_XBB), (const bf16_t*)(wl + W_GU), MP, NGU, DM}; pg8::StaticOrder S; S.init(MP, NGU, GP, bid);
                EpiNull E{};
                pg8::gemm_phase<EpiNull, pg8::StaticOrder, true, true, pg8::NoBg, DBG_SHADOW_GLL>(lds, g, S, E);
            }
#endif
            SEAM(pb + 4);
        }
        if (IN(pb + 5)) for (int rep_ = 0; rep_ < NREP(6); ++rep_) {
            LOAD_ARGS(a); MAKE_BG(a); unsigned char* ws = a.ws; unsigned char* wl = ws + WS_W + (size_t)l * W_LAYER;
            pg8::Gemm g{(const bf16_t*)(ws + WS_H), (const bf16_t*)(wl + W_FD), MP, DM, DFF}; pg8::StaticOrder S; S.init(MP, DM, G, bid);
            EpiRes E{nullptr, nullptr, (const bf16_t*)(ws + WS_XBB), (bf16_t*)(ws + WS_XBA), (float*)(ws + WS_SSQP + (size_t)(l == 0 ? 2 : 4) * SSQP_STRIDE), 0, false};
            pg8::gemm_phase<EpiRes, pg8::StaticOrder, true, true>(lds, g, S, E);
            SEAM(pb + 5);
        }
    }
    if (IN(13)) {
        LOAD_ARGS(a); MAKE_BG(a); unsigned char* ws = a.ws; const int l = 1; unsigned char* wl = ws + WS_W + (size_t)l * W_LAYER;
        if (bid < G - 22) phase_final(a, bid, G - 22);
        { S_G3(bid >= G - 22 ? bid - (G - 22) : -1, 22); }
        SEAM(13);
    }
    if (IN(14)) { LOAD_ARGS(a); skinny_down(a, 1); SEAM(14); }
#ifdef DBG_TIME
    float dbg_scale;
    {
        __syncthreads();
        const volatile LAS unsigned* T_ = (const volatile LAS unsigned*)(lds + MISC_OFF + 512);
        unsigned ticks = 0;
        if (DBG_TIME < 6) ticks = (T_[1 + DBG_TIME + 1] - T_[1 + DBG_TIME]) + (T_[7 + DBG_TIME + 1] - T_[7 + DBG_TIME]);
        if (DBG_TIME == 6) ticks = T_[1] - T_[0];
        if (DBG_TIME == 7) ticks = T_[15] - T_[13];
        if (DBG_TIME == 8) ticks = T_[15] - T_[0];
        if (DBG_TIME >= 100 && DBG_TIME < 200) ticks = T_[DBG_TIME - 100 + 1] - T_[DBG_TIME - 100];
        if (DBG_TIME >= 300 && DBG_TIME < 400) ticks = __hip_atomic_load((unsigned*)((unsigned char*)kargs()->ws + WS_CTL) + 65536 + 32 * (DBG_TIME - 300), __ATOMIC_RELAXED, __HIP_MEMORY_SCOPE_AGENT);
        if (DBG_TIME >= 400 && DBG_TIME < 500) ticks = 1000000u - __hip_atomic_load((unsigned*)((unsigned char*)kargs()->ws + WS_CTL) + 65536 + 32 * (DBG_TIME - 400) + 16, __ATOMIC_RELAXED, __HIP_MEMORY_SCOPE_AGENT);
        dbg_scale = 1.0f + (float)ticks * 0.01f * 0.001f;
    }
    if (IN(15)) { LOAD_ARGS(a); MAKE_BG(a); sample_final(a, dbg_scale); bg.drain(); }
#else
    if (IN(15)) { LOAD_ARGS(a); MAKE_BG(a); sample_final(a); bg.drain(); }
#endif
#undef IN
#undef SEAM
}

extern "C" void kernel_launch(void* const* d_in, const int* in_sizes, int n_in, void* d_out, int out_size, void* d_ws, size_t ws_size, hipStream_t stream) {
    static int grid = 0;
    if (grid == 0) {
        if (n_in != 21 || (size_t)out_size != O_END || ws_size < WS_END) { fprintf(stderr, "kernel_launch: unexpected shapes (n_in %d, out %d, ws %zu); nothing launched\n", n_in, out_size, ws_size); grid = -1; return; }
        int dev = 0, cus = 0, per_cu = 0;
        if (hipGetDevice(&dev) != hipSuccess || hipDeviceGetAttribute(&cus, hipDeviceAttributeMultiprocessorCount, dev) != hipSuccess) { grid = -1; return; }
        if (hipFuncSetAttribute((const void*)mk_fwd, hipFuncAttributeMaxDynamicSharedMemorySize, LDS_BYTES) != hipSuccess) { fprintf(stderr, "kernel_launch: hipFuncSetAttribute failed\n"); grid = -1; return; }
        if (hipOccupancyMaxActiveBlocksPerMultiprocessor(&per_cu, (const void*)mk_fwd, 512, LDS_BYTES) != hipSuccess || per_cu < 1) { fprintf(stderr, "kernel_launch: occupancy query says %d blocks per CU\n", per_cu); }
        (void)hipGetLastError();
        grid = cus;
    }
    if (grid < 0) return;
    hipMemsetAsync((char*)d_ws + WS_CTL, 0, CTL_ZERO_BYTES, stream);
    Args a{};
    for (int i = 0; i < 21; ++i) a.in[i] = (const float*)d_in[i];
    a.out = (float*)d_out; a.ws = (unsigned char*)d_ws;
#if MK_ONE_LAUNCH
    a.ph_lo = 0; a.ph_hi = N_PHASES;
    hipLaunchKernelGGL(mk_fwd, dim3(grid), dim3(512), LDS_BYTES, stream, a);
#else
    for (int p = 0; p < N_PHASES; ++p) { a.ph_lo = p; a.ph_hi = p + 1; hipLaunchKernelGGL(mk_fwd, dim3(grid), dim3(512), LDS_BYTES, stream, a); }
#endif
}
```
